# Optimizing an MI355X kernel written in HIP

```python
import jax, jax.numpy as jnp
from jax import lax
import numpy as np

D_MODEL = 2048
BATCH = 2
SEQ = 8192
DEPTH = 4
DEC_BATCH = 2
DEC_SEQ = 16384
PAST_LEN = 128

N_MIXERS = 4
N_HEADS = 16
N_KV_HEADS = 4
HEAD_DIM = D_MODEL // N_HEADS
GQA_GROUP = N_HEADS // N_KV_HEADS
Q_DIM = N_HEADS * HEAD_DIM
KV_DIM = N_KV_HEADS * HEAD_DIM
QKV_DIM = Q_DIM + 2 * KV_DIM
Q_BLOCK = 128
WINDOW = 128
ROPE_THETA = 10000.0
GRID_W = 64
N_FOURIER_GROUPS = 8
FOURIER_GROUP_CH = D_MODEL // N_FOURIER_GROUPS
CONV_W = 3
D_FF = -(-8 * D_MODEL // (3 * 256)) * 256
N_META = 16
EPS = 1e-6
NEG_INF = -1e30
N_A = len(range(0, DEPTH, N_MIXERS))
N_B = len(range(1, DEPTH, N_MIXERS))
N_C = len(range(2, DEPTH, N_MIXERS))
N_D = len(range(3, DEPTH, N_MIXERS))

kernel_name = "hybrid_bidir_encoder_interleaved"


def rms_norm(x, g):
    xf = x.astype(jnp.float32)
    y = xf * lax.rsqrt(jnp.mean(xf * xf, axis=-1, keepdims=True) + EPS)
    return (y * g.astype(jnp.float32)).astype(x.dtype)


def alibi_slopes():
    return 2.0 ** (-8.0 * jnp.arange(1, N_HEADS + 1, dtype=jnp.float32) / N_HEADS)


def qkv_heads(hn, wqkv, q_gain, k_gain):
    B, L, _ = hn.shape
    q, k, v = jnp.split(hn @ wqkv, [Q_DIM, Q_DIM + KV_DIM], axis=-1)
    q = rms_norm(q.reshape(B, L, N_HEADS, HEAD_DIM), q_gain)
    k = rms_norm(k.reshape(B, L, N_KV_HEADS, HEAD_DIM), k_gain)
    v = v.reshape(B, L, N_KV_HEADS, HEAD_DIM)
    return q, k, v


def attend(q, k, v, bias, sink):
    s = jnp.einsum('bqhgd,bkhd->bhgqk', q, k).astype(jnp.float32) * (HEAD_DIM ** -0.5)
    if bias is not None:
        s = s + bias
    if sink is None:
        p = jax.nn.softmax(s, axis=-1)
    else:
        snk = sink.astype(jnp.float32).reshape(N_KV_HEADS, GQA_GROUP)[None, :, :, None, None]
        m = jnp.maximum(jnp.max(s, axis=-1, keepdims=True), snk)
        e = jnp.exp(s - m)
        p = e / (jnp.sum(e, axis=-1, keepdims=True) + jnp.exp(snk - m))
    return jnp.einsum('bhgqk,bkhd->bqhgd', p.astype(v.dtype), v)


def axial_rope(x, row, col):
    half, quarter = HEAD_DIM // 2, HEAD_DIM // 4
    inv = ROPE_THETA ** (-jnp.arange(quarter, dtype=jnp.float32) / quarter)
    xf = x.astype(jnp.float32)

    def rot(seg, pos):
        ang = pos[:, None] * inv[None, :]
        c = jnp.cos(ang)[None, :, None, :]
        s = jnp.sin(ang)[None, :, None, :]
        s1, s2 = seg[..., :quarter], seg[..., quarter:]
        return jnp.concatenate([s1 * c - s2 * s, s1 * s + s2 * c], axis=-1)

    return jnp.concatenate([rot(xf[..., :half], row), rot(xf[..., half:], col)], axis=-1).astype(x.dtype)


def mixer_a(hn, wqkv, q_gain, k_gain, wo):
    B, L, _ = hn.shape
    S = L - N_META
    rows = S // GRID_W
    zeros = jnp.zeros((N_META,), jnp.float32)
    row = jnp.concatenate([zeros, jnp.broadcast_to(jnp.arange(rows, dtype=jnp.float32)[:, None], (rows, GRID_W)).reshape(-1)])
    col = jnp.concatenate([zeros, jnp.broadcast_to(jnp.arange(GRID_W, dtype=jnp.float32)[None, :], (rows, GRID_W)).reshape(-1)])
    q, k, v = qkv_heads(hn, wqkv, q_gain, k_gain)
    q = axial_rope(q, row, col).reshape(B, L, N_KV_HEADS, GQA_GROUP, HEAD_DIM)
    k = axial_rope(k, row, col)
    o_meta = attend(q[:, :N_META], k, v, None, None)
    n_blk = S // Q_BLOCK
    q_blk = jnp.moveaxis(q[:, N_META:].reshape(B, n_blk, Q_BLOCK, N_KV_HEADS, GQA_GROUP, HEAD_DIM), 1, 0)
    o_real = lax.map(lambda qb: attend(qb, k, v, None, None), q_blk)
    o_real = jnp.moveaxis(o_real, 0, 1).reshape(B, S, N_KV_HEADS, GQA_GROUP, HEAD_DIM)
    o = jnp.concatenate([o_meta, o_real], axis=1).reshape(B, L, Q_DIM)
    return o @ wo


def mixer_b(hn, w):
    B, L, _ = hn.shape
    hf = hn.astype(jnp.float32).reshape(B, L, N_FOURIER_GROUPS, FOURIER_GROUP_CH)
    mixed = jnp.fft.fft2(hf, axes=(1, 3), norm="ortho").real
    return mixed.reshape(B, L, D_MODEL).astype(hn.dtype) @ w


def mixer_c(hn, w_in, conv_w, w_out):
    L = hn.shape[1]
    b_gate, c_gate, u = jnp.split(hn @ w_in, 3, axis=-1)
    g = c_gate * u
    pad = CONV_W // 2
    gp = jnp.pad(g, ((0, 0), (pad, pad), (0, 0)))
    conv = sum(gp[:, i:i + L] * conv_w[i] for i in range(CONV_W))
    return (b_gate * conv) @ w_out


def mixer_d(hn, wqkv, q_gain, k_gain, sink, wo):
    B, L, _ = hn.shape
    S = L - N_META
    q, k, v = qkv_heads(hn, wqkv, q_gain, k_gain)
    q = q.reshape(B, L, N_KV_HEADS, GQA_GROUP, HEAD_DIM)
    slopes = alibi_slopes().reshape(N_KV_HEADS, GQA_GROUP)[:, :, None, None]
    k_meta, v_meta = k[:, :N_META], v[:, :N_META]
    pos_k = jnp.arange(N_META + WINDOW)
    pos_q = jnp.arange(N_META)
    ok_meta = (pos_k[None, :] < N_META) | (pos_k[None, :] - pos_q[:, None] <= WINDOW)
    bias_meta = jnp.where(ok_meta, 0.0, NEG_INF).astype(jnp.float32)
    o_meta = attend(q[:, :N_META], k[:, :N_META + WINDOW], v[:, :N_META + WINDOW], bias_meta, sink)
    band = Q_BLOCK + 2 * WINDOW
    padw = ((0, 0), (WINDOW, WINDOW), (0, 0), (0, 0))
    k_pad = jnp.pad(k[:, N_META:], padw)
    v_pad = jnp.pad(v[:, N_META:], padw)
    n_blk = S // Q_BLOCK
    qi = jnp.arange(Q_BLOCK)
    kj = jnp.arange(band)
    dist = jnp.abs(qi[:, None] - kj[None, :] + WINDOW)
    alibi = -slopes * dist.astype(jnp.float32)
    meta_bias = jnp.zeros((N_KV_HEADS, GQA_GROUP, Q_BLOCK, N_META), jnp.float32)
    q_blk = jnp.moveaxis(q[:, N_META:].reshape(B, n_blk, Q_BLOCK, N_KV_HEADS, GQA_GROUP, HEAD_DIM), 1, 0)

    def blk(args):
        qb, b = args
        start = b * Q_BLOCK
        kb = lax.dynamic_slice_in_dim(k_pad, start, band, axis=1)
        vb = lax.dynamic_slice_in_dim(v_pad, start, band, axis=1)
        j = start - WINDOW + kj
        ok = (dist <= WINDOW) & ((j >= 0) & (j < S))[None, :]
        bias = jnp.concatenate([meta_bias, jnp.where(ok, alibi, NEG_INF)], axis=-1)
        return attend(qb, jnp.concatenate([k_meta, kb], axis=1), jnp.concatenate([v_meta, vb], axis=1), bias, sink)

    o_real = lax.map(blk, (q_blk, jnp.arange(n_blk)))
    o_real = jnp.moveaxis(o_real, 0, 1).reshape(B, S, N_KV_HEADS, GQA_GROUP, HEAD_DIM)
    o = jnp.concatenate([o_meta, o_real], axis=1).reshape(B, L, Q_DIM)
    return o @ wo


def swiglu(hn, w_in, w_out):
    g, u = jnp.split(hn @ w_in, 2, axis=-1)
    return (jax.nn.silu(g) * u) @ w_out


def encode(x, meta_tokens, ln_mix, ln_ffn, a_wqkv, a_q_norm, a_k_norm, a_wo, b_w,
           c_w_in, c_conv, c_w_out, d_wqkv, d_q_norm, d_k_norm, d_sink, d_wo, ffn_w_in, ffn_w_out):
    B = x.shape[0]
    meta = jnp.broadcast_to(meta_tokens.astype(x.dtype)[None], (B, N_META, D_MODEL))
    h = jnp.concatenate([meta, x], axis=1)
    for i in range(DEPTH):
        kind, j = i % N_MIXERS, i // N_MIXERS
        hn = rms_norm(h, ln_mix[i])
        if kind == 0:
            mix = mixer_a(hn, a_wqkv[j], a_q_norm[j], a_k_norm[j], a_wo[j])
        elif kind == 1:
            mix = mixer_b(hn, b_w[j])
        elif kind == 2:
            mix = mixer_c(hn, c_w_in[j], c_conv[j], c_w_out[j])
        else:
            mix = mixer_d(hn, d_wqkv[j], d_q_norm[j], d_k_norm[j], d_sink[j], d_wo[j])
        h = h + mix
        h = h + swiglu(rms_norm(h, ln_ffn[i]), ffn_w_in[i], ffn_w_out[i])
    return h[:, N_META:]


def setup_inputs(seed: int = 0) -> dict:
    key = jax.random.key(seed)
    ks = jax.random.split(key, 24)
    f32 = jnp.float32

    def nrm(k, shape, scale):
        return jax.random.normal(k, shape, f32) * scale

    def gain(k, shape):
        return 1.0 + 0.02 * jax.random.normal(k, shape, f32)

    return {
        "x_prompt": nrm(ks[0], (BATCH, SEQ, D_MODEL), 1.0),
        "x_sample": nrm(ks[1], (DEC_BATCH, DEC_SEQ, D_MODEL), 1.0),
        "meta_tokens": nrm(ks[2], (N_META, D_MODEL), 1.0),
        "ln_mix": gain(ks[3], (DEPTH, D_MODEL)),
        "ln_ffn": gain(ks[4], (DEPTH, D_MODEL)),
        "a_wqkv": nrm(ks[5], (N_A, D_MODEL, QKV_DIM), D_MODEL ** -0.5),
        "a_q_norm": gain(ks[6], (N_A, HEAD_DIM)),
        "a_k_norm": gain(ks[7], (N_A, HEAD_DIM)),
        "a_wo": nrm(ks[8], (N_A, Q_DIM, D_MODEL), Q_DIM ** -0.5),
        "b_w": nrm(ks[9], (N_B, D_MODEL, D_MODEL), D_MODEL ** -0.5),
        "c_w_in": nrm(ks[10], (N_C, D_MODEL, 3 * D_MODEL), D_MODEL ** -0.5),
        "c_conv": nrm(ks[11], (N_C, CONV_W, D_MODEL), CONV_W ** -0.5),
        "c_w_out": nrm(ks[12], (N_C, D_MODEL, D_MODEL), D_MODEL ** -0.5),
        "d_wqkv": nrm(ks[13], (N_D, D_MODEL, QKV_DIM), D_MODEL ** -0.5),
        "d_q_norm": gain(ks[14], (N_D, HEAD_DIM)),
        "d_k_norm": gain(ks[15], (N_D, HEAD_DIM)),
        "d_sink": nrm(ks[16], (N_D, N_HEADS), 0.5),
        "d_wo": nrm(ks[17], (N_D, Q_DIM, D_MODEL), Q_DIM ** -0.5),
        "ffn_w_in": nrm(ks[18], (DEPTH, D_MODEL, 2 * D_FF), D_MODEL ** -0.5),
        "ffn_w_out": nrm(ks[19], (DEPTH, D_FF, D_MODEL), D_FF ** -0.5),
    }


def reference(x_prompt, x_sample, meta_tokens, ln_mix, ln_ffn, a_wqkv, a_q_norm, a_k_norm, a_wo, b_w,
              c_w_in, c_conv, c_w_out, d_wqkv, d_q_norm, d_k_norm, d_sink, d_wo, ffn_w_in, ffn_w_out):
    y_prompt = encode(x_prompt, meta_tokens, ln_mix, ln_ffn, a_wqkv, a_q_norm, a_k_norm, a_wo, b_w,
                      c_w_in, c_conv, c_w_out, d_wqkv, d_q_norm, d_k_norm, d_sink, d_wo, ffn_w_in, ffn_w_out)
    y_sample = encode(x_sample, meta_tokens, ln_mix, ln_ffn, a_wqkv, a_q_norm, a_k_norm, a_wo, b_w,
                      c_w_in, c_conv, c_w_out, d_wqkv, d_q_norm, d_k_norm, d_sink, d_wo, ffn_w_in, ffn_w_out)
    return (y_prompt, y_sample)
```

```cpp
#include <hip/hip_runtime.h>
#include <cstdio>
#include <cstdint>
#include <cstring>
namespace pg8 {
#define PG8_LAS __attribute__((address_space(3)))
typedef unsigned short bf16_t;
typedef short bf16x8 __attribute__((ext_vector_type(8)));
typedef float f32x4 __attribute__((ext_vector_type(4)));
typedef unsigned u32x4 __attribute__((ext_vector_type(4)));
constexpr int BM = 256, BK = 64, HALF = 128, HTB = HALF * BK * 2  , STAGE_BYTES = 8 * HTB, NXCD = 8, WGM = 4;

__host__ __device__ __forceinline__ int lds_byte(int r, int c) { const int st = (r >> 4) * 2 + (c >> 5), rr = r & 15, cc = c & 31, ob = rr * 64 + cc * 2; return st * 1024 + (ob ^ (((ob >> 9) & 1) << 5)); }
__host__ __device__ __forceinline__ void stage_rc(int b, int& R, int& C) { const int st = b / 1024, sb = b % 1024, swz = sb ^ (((sb >> 9) & 1) << 5); R = (st >> 1) * 16 + swz / 64; C = (st & 1) * 32 + (swz % 64) / 2; }
__host__ __device__ __forceinline__ int perm32(int rho) { const int n = rho >> 4, i = rho & 15; return 8 * (i >> 2) + 4 * n + (i & 3); }

struct Unit { int pm, pn, ko, kt; };
struct Gemm { const bf16_t* A; const bf16_t* Bt; int M, N, K, ld; };

struct StaticOrder {
    int nM, nN, nwg, G, c, kt;
    __host__ __device__ void init(int M, int N, int G_, int c_, int K_) { nM = M / BM; nN = N / BM; nwg = nM * nN; G = G_; c = c_; kt = K_ / BK; }
    __host__ __device__ bool next(int i, Unit& u) const {
        const long L = (long)i * G + c; if (L >= nwg) return false;
        int wgid = (int)L; { const int q = nwg / NXCD, r = nwg % NXCD, xcd = wgid % NXCD, off = wgid / NXCD; wgid = (xcd < r ? xcd * (q + 1) : r * (q + 1) + (xcd - r) * q) + off; }
        const int nig = WGM * nN, gid = wgid / nig, fm = gid * WGM, gsz = (nM - fm) < WGM ? (nM - fm) : WGM;
        u.pm = fm + ((wgid % nig) % gsz); u.pn = (wgid % nig) / gsz; u.ko = 0; u.kt = kt; return true;
    }
    __device__ __forceinline__ void a_ready(const Unit&) const {}
    __device__ __forceinline__ void done(const Unit&) const {}
};
__device__ __forceinline__ unsigned cvt_pk_bf16(float lo, float hi) { unsigned r; asm volatile("v_cvt_pk_bf16_f32 %0, %1, %2" : "=v"(r) : "v"(lo), "v"(hi)); return r; }
typedef unsigned u32x2 __attribute__((ext_vector_type(2)));
struct EpiPlain {
    static constexpr bool PERM = true, AFTER_DRAIN = false, PRE = false, TBL = false; static constexpr int NVM = 0;
    bf16_t* O; int ldc; const float* rstd;
    __device__ __forceinline__ void prefetch(const Unit& u, int wr, int fr, float (&pre)[8]) const {
#pragma unroll
        for (int i = 0; i < 8; ++i) pre[i] = rstd ? rstd[u.pm * BM + wr * 64 + fr + (i >> 2) * HALF + (i & 3) * 16] : 1.0f; }
    __device__ __forceinline__ void operator()(const f32x4 (&acc)[2][2][4][2], const Unit& u, int wr, int wc, int fr, int fq) const {
        const int row0 = u.pm * BM + wr * 64 + fr, col0 = u.pn * BM + wc * 32 + 8 * fq;
        float rsv[8];
#pragma unroll
        for (int i = 0; i < 8; ++i) rsv[i] = rstd ? rstd[row0 + (i >> 2) * HALF + (i & 3) * 16] : 1.0f;
        __builtin_amdgcn_sched_barrier(0);
#pragma unroll
        for (int ai = 0; ai < 2; ++ai)
#pragma unroll
            for (int m = 0; m < 4; ++m) { bf16_t* rowp = O + (size_t)(row0 + ai * HALF + m * 16) * ldc + col0; const float rs = rsv[ai * 4 + m];
#pragma unroll
                for (int bj = 0; bj < 2; ++bj) { const f32x4 v0 = acc[ai][bj][m][0] * rs, v1 = acc[ai][bj][m][1] * rs;
                    u32x4 w; w.x = cvt_pk_bf16(v0[0], v0[1]); w.y = cvt_pk_bf16(v0[2], v0[3]); w.z = cvt_pk_bf16(v1[0], v1[1]); w.w = cvt_pk_bf16(v1[2], v1[3]);
                    *(u32x4*)(rowp + bj * HALF) = w; } }
    }
};
struct EpiResid {
    static constexpr bool PERM = false, AFTER_DRAIN = false, PRE = false, TBL = false; static constexpr int NVM = 0;
    float* hreal; float* hmeta; int nreal; float scale;
    __device__ __forceinline__ void operator()(const f32x4 (&acc)[2][2][4][2], const Unit& u, int wr, int wc, int fr, int fq) const {
        float* base = (u.pm < nreal) ? hreal + (size_t)u.pm * BM * 2048 : hmeta;
        const int row0 = wr * 64 + fr, col0 = u.pn * BM + wc * 32 + 4 * fq;
#pragma unroll
        for (int ai = 0; ai < 2; ++ai) {
            f32x4 t[4][2][2];
#pragma unroll
            for (int m = 0; m < 4; ++m) { const float* rowp = base + (size_t)(row0 + ai * HALF + m * 16) * 2048 + col0;
#pragma unroll
                for (int bj = 0; bj < 2; ++bj)
#pragma unroll
                    for (int n = 0; n < 2; ++n) t[m][bj][n] = *(const f32x4*)(rowp + bj * HALF + n * 16); }
            __builtin_amdgcn_sched_barrier(0);
#pragma unroll
            for (int m = 0; m < 4; ++m) { float* rowp = base + (size_t)(row0 + ai * HALF + m * 16) * 2048 + col0;
#pragma unroll
                for (int bj = 0; bj < 2; ++bj)
#pragma unroll
                    for (int n = 0; n < 2; ++n) *(f32x4*)(rowp + bj * HALF + n * 16) = t[m][bj][n] + acc[ai][bj][m][n] * scale; }
            __builtin_amdgcn_sched_barrier(0);
        }
    }
};
constexpr int SS_PLANE = 49152;
struct EpiResidB {
    static constexpr bool PERM = true, AFTER_DRAIN = false, PRE = false, TBL = false; static constexpr int NVM = 16;
    bf16_t* hb; float* ss;
    __device__ __forceinline__ void operator()(const f32x4 (&acc)[2][2][4][2], const Unit& u, int wr, int wc, int fr, int fq) const {
        const int row0 = u.pm * BM + wr * 64 + fr, col0 = u.pn * BM + wc * 32 + 8 * fq;
#pragma unroll
        for (int ai = 0; ai < 2; ++ai) {
            u32x4 t[4][2];
#pragma unroll
            for (int m = 0; m < 4; ++m)
#pragma unroll
                for (int bj = 0; bj < 2; ++bj) t[m][bj] = *(const u32x4*)(hb + (size_t)(row0 + ai * HALF + m * 16) * 2048 + col0 + bj * HALF);
            __builtin_amdgcn_sched_barrier(0);
            float q[4] = {0.f, 0.f, 0.f, 0.f};
#pragma unroll
            for (int m = 0; m < 4; ++m)
#pragma unroll
                for (int bj = 0; bj < 2; ++bj) { const u32x4 h = t[m][bj]; const f32x4 a0 = acc[ai][bj][m][0], a1 = acc[ai][bj][m][1];
                    const f32x4 v0 = {__uint_as_float(h.x << 16) + a0[0], __uint_as_float(h.x & 0xffff0000u) + a0[1], __uint_as_float(h.y << 16) + a0[2], __uint_as_float(h.y & 0xffff0000u) + a0[3]};
                    const f32x4 v1 = {__uint_as_float(h.z << 16) + a1[0], __uint_as_float(h.z & 0xffff0000u) + a1[1], __uint_as_float(h.w << 16) + a1[2], __uint_as_float(h.w & 0xffff0000u) + a1[3]};
                    q[m] += (v0[0] * v0[0] + v0[1] * v0[1]) + (v0[2] * v0[2] + v0[3] * v0[3]) + (v1[0] * v1[0] + v1[1] * v1[1]) + (v1[2] * v1[2] + v1[3] * v1[3]);
                    u32x4 w; w.x = cvt_pk_bf16(v0[0], v0[1]); w.y = cvt_pk_bf16(v0[2], v0[3]); w.z = cvt_pk_bf16(v1[0], v1[1]); w.w = cvt_pk_bf16(v1[2], v1[3]);
                    *(u32x4*)(hb + (size_t)(row0 + ai * HALF + m * 16) * 2048 + col0 + bj * HALF) = w; }
            if (ss) {
#pragma unroll
                for (int m = 0; m < 4; ++m) { float s = q[m];
                    s += __int_as_float(__builtin_amdgcn_ds_swizzle(__float_as_int(s), 0x1f | (16 << 10)));
                    const auto rr = __builtin_amdgcn_permlane32_swap(__float_as_uint(s), __float_as_uint(s), false, false); s = __uint_as_float(rr[0]) + __uint_as_float(rr[1]);
                    if (fq == 0) ss[(size_t)(4 * u.pn + wc) * SS_PLANE + row0 + ai * HALF + m * 16] = s; }
            }
            __builtin_amdgcn_sched_barrier(0);
        }
    }
};
struct EpiResidFinal {
    static constexpr bool PERM = true, AFTER_DRAIN = false, PRE = false, TBL = false; static constexpr int NVM = 16;
    const bf16_t* hb; float* out;
    __device__ __forceinline__ void operator()(const f32x4 (&acc)[2][2][4][2], const Unit& u, int wr, int wc, int fr, int fq) const {
        const int row0 = u.pm * BM + wr * 64 + fr, col0 = u.pn * BM + wc * 32 + 8 * fq;
#pragma unroll
        for (int ai = 0; ai < 2; ++ai) {
            u32x4 t[4][2];
#pragma unroll
            for (int m = 0; m < 4; ++m)
#pragma unroll
                for (int bj = 0; bj < 2; ++bj) t[m][bj] = *(const u32x4*)(hb + (size_t)(row0 + ai * HALF + m * 16) * 2048 + col0 + bj * HALF);
            __builtin_amdgcn_sched_barrier(0);
#pragma unroll
            for (int m = 0; m < 4; ++m)
#pragma unroll
                for (int bj = 0; bj < 2; ++bj) { const u32x4 h = t[m][bj]; const f32x4 v0 = acc[ai][bj][m][0], v1 = acc[ai][bj][m][1]; float* op = out + (size_t)(row0 + ai * HALF + m * 16) * 2048 + col0 + bj * HALF;
                    *(f32x4*)op = (f32x4){__uint_as_float(h.x << 16) + v0[0], __uint_as_float(h.x & 0xffff0000u) + v0[1], __uint_as_float(h.y << 16) + v0[2], __uint_as_float(h.y & 0xffff0000u) + v0[3]};
                    *(f32x4*)(op + 4) = (f32x4){__uint_as_float(h.z << 16) + v1[0], __uint_as_float(h.z & 0xffff0000u) + v1[1], __uint_as_float(h.w << 16) + v1[2], __uint_as_float(h.w & 0xffff0000u) + v1[3]}; }
            __builtin_amdgcn_sched_barrier(0);
        }
    }
};
__device__ __forceinline__ float silu_mul(float g, float u) { return g * u * __builtin_amdgcn_rcpf(1.0f + __builtin_amdgcn_exp2f(-1.4426950408889634f * g)); }
struct EpiSwiglu {
    static constexpr bool PERM = true, AFTER_DRAIN = false, PRE = false, TBL = true; static constexpr int NVM = 8;
    bf16_t* O; int ldc; const float* rstd;
    __device__ __forceinline__ void table_load(const Unit& u, PG8_LAS unsigned char* t, int wid) const {
        int l2; asm volatile("v_mbcnt_lo_u32_b32 %0, -1, 0\n\tv_mbcnt_hi_u32_b32 %0, -1, %0" : "=v"(l2));
        if (wid < 4) __builtin_amdgcn_global_load_lds((const unsigned*)(rstd + u.pm * BM + wid * 64 + l2), (PG8_LAS unsigned*)(t + wid * 256), 4, 0, 0); }
    __device__ __forceinline__ void operator()(const f32x4 (&acc)[2][2][4][2], const Unit& u, int wr, int wc, int fr, int fq, const PG8_LAS float* tb) const {
        const int row0 = u.pm * BM + wr * 64 + fr, col0 = u.pn * (BM / 2) + wc * 32 + 8 * fq;
        float rsv[8];
#pragma unroll
        for (int i = 0; i < 8; ++i) rsv[i] = tb[wr * 64 + fr + (i >> 2) * HALF + (i & 3) * 16];
        __builtin_amdgcn_sched_barrier(0);
#pragma unroll
        for (int ai = 0; ai < 2; ++ai)
#pragma unroll
            for (int m = 0; m < 4; ++m) { bf16_t* rowp = O + (size_t)(row0 + ai * HALF + m * 16) * ldc + col0; const float rs = rsv[ai * 4 + m];
                const float c1 = -1.4426950408889634f * rs, irs2 = __builtin_amdgcn_rcpf(rs * rs);
                const f32x4 a0 = acc[ai][0][m][0], a1 = acc[ai][0][m][1], b0 = acc[ai][1][m][0], b1 = acc[ai][1][m][1];
#define SWG(G_, U_) ((G_) * (U_) * __builtin_amdgcn_rcpf(__builtin_fmaf(__builtin_amdgcn_exp2f((G_) * c1), irs2, irs2)))
                u32x4 w; w.x = cvt_pk_bf16(SWG(a0[0], a0[1]), SWG(a0[2], a0[3])); w.y = cvt_pk_bf16(SWG(a1[0], a1[1]), SWG(a1[2], a1[3]));
                w.z = cvt_pk_bf16(SWG(b0[0], b0[1]), SWG(b0[2], b0[3])); w.w = cvt_pk_bf16(SWG(b1[0], b1[1]), SWG(b1[2], b1[3]));
#undef SWG
                *(u32x4*)rowp = w; }
    }
};
struct EpiCin {
    static constexpr bool PERM = true, AFTER_DRAIN = false, PRE = false, TBL = false; static constexpr int NVM = 0;
    bf16_t* Bb; bf16_t* Gb; const float* rstd;
    __device__ __forceinline__ void prefetch(const Unit& u, int wr, int fr, float (&pre)[8]) const {
#pragma unroll
        for (int i = 0; i < 8; ++i) pre[i] = rstd ? rstd[u.pm * BM + wr * 64 + fr + (i >> 2) * HALF + (i & 3) * 16] : 1.0f; }
    __device__ __forceinline__ void operator()(const f32x4 (&acc)[2][2][4][2], const Unit& u, int wr, int wc, int fr, int fq) const {
        const int row0 = u.pm * BM + wr * 64 + fr;
        float rsv[8];
#pragma unroll
        for (int i = 0; i < 8; ++i) rsv[i] = rstd ? rstd[row0 + (i >> 2) * HALF + (i & 3) * 16] : 1.0f;
        __builtin_amdgcn_sched_barrier(0);
        if (u.pn < 8) {
            const int col0 = u.pn * BM + wc * 32 + 8 * fq;
#pragma unroll
            for (int ai = 0; ai < 2; ++ai)
#pragma unroll
                for (int m = 0; m < 4; ++m) { bf16_t* rowp = Bb + (size_t)(row0 + ai * HALF + m * 16) * 2048 + col0; const float rs = rsv[ai * 4 + m];
#pragma unroll
                    for (int bj = 0; bj < 2; ++bj) { const f32x4 v0 = acc[ai][bj][m][0] * rs, v1 = acc[ai][bj][m][1] * rs;
                        u32x4 w; w.x = cvt_pk_bf16(v0[0], v0[1]); w.y = cvt_pk_bf16(v0[2], v0[3]); w.z = cvt_pk_bf16(v1[0], v1[1]); w.w = cvt_pk_bf16(v1[2], v1[3]);
                        *(u32x4*)(rowp + bj * HALF) = w; } }
        } else {
            const int col0 = (u.pn - 8) * (BM / 2) + wc * 32 + 8 * fq;
#pragma unroll
            for (int ai = 0; ai < 2; ++ai)
#pragma unroll
                for (int m = 0; m < 4; ++m) { bf16_t* rowp = Gb + (size_t)(row0 + ai * HALF + m * 16) * 2048 + col0; const float rs = rsv[ai * 4 + m]; const float rs2 = rs * rs;
                    const f32x4 a0 = acc[ai][0][m][0], a1 = acc[ai][0][m][1], b0 = acc[ai][1][m][0], b1 = acc[ai][1][m][1];
                    u32x4 w; w.x = cvt_pk_bf16(a0[0] * a0[1] * rs2, a0[2] * a0[3] * rs2); w.y = cvt_pk_bf16(a1[0] * a1[1] * rs2, a1[2] * a1[3] * rs2);
                    w.z = cvt_pk_bf16(b0[0] * b0[1] * rs2, b0[2] * b0[3] * rs2); w.w = cvt_pk_bf16(b1[0] * b1[1] * rs2, b1[2] * b1[3] * rs2);
                    *(u32x4*)rowp = w; }
        }
    }
};
struct TailOrder {
    int nunits, c, pm, kchunk;
    __device__ __forceinline__ bool next(int i, Unit& u) const { if (i > 0 || c >= nunits) return false; u.pm = pm; u.pn = c & 7; u.ko = (c >> 3) * kchunk; u.kt = kchunk / BK; return true; }
    __device__ __forceinline__ void a_ready(const Unit&) const {}
    __device__ __forceinline__ void done(const Unit&) const {}
};
struct EpiTailStore {
    static constexpr bool PERM = false, AFTER_DRAIN = false, PRE = false, TBL = false; static constexpr int NVM = 0;
    float* tailp; int kchunk;
    __device__ __forceinline__ void operator()(const f32x4 (&acc)[2][2][4][2], const Unit& u, int wr, int wc, int fr, int fq) const {
        if (wr != 0) return;
        const int col0 = u.pn * BM + wc * 32 + 4 * fq; float* base = tailp + (size_t)(u.ko / kchunk) * 64 * 2048;
#pragma unroll
        for (int m = 0; m < 4; ++m) { float* rowp = base + (size_t)(m * 16 + fr) * 2048 + col0;
#pragma unroll
            for (int bj = 0; bj < 2; ++bj)
#pragma unroll
                for (int n = 0; n < 2; ++n) *(f32x4*)(rowp + bj * HALF + n * 16) = acc[0][bj][m][n]; }
    }
};
struct StaggerOrder : StaticOrder {
    int rounds, kcut;
    __device__ __forceinline__ void init2(int M, int N, int G_, int c_, int K_) {
        init(M, N, G_, c_, K_); rounds = nwg / G; const int sg = (c_ >> 3) & 7; int kc = ((kt * sg / 8) + 1) & ~1; if (kc < 4 || kt - kc < 4 || nwg % G != 0) kc = 0; kcut = kc; }
    __device__ __forceinline__ bool next(int i, Unit& u) const {
        if (kcut == 0) return StaticOrder::next(i, u);
        if (i > rounds) return false;
        if (i == rounds) { StaticOrder::next(0, u); u.ko = kcut * BK; u.kt = kt - kcut; return true; }
        StaticOrder::next(i, u); if (i == 0) u.kt = kcut; return true;
    }
};
struct EpiNone {
    static constexpr bool PERM = true, AFTER_DRAIN = false, PRE = false, TBL = false; static constexpr int NVM = 0;
    __device__ __forceinline__ void operator()(const f32x4 (&acc)[2][2][4][2], const Unit&, int, int, int, int) const {
#pragma unroll
        for (int a = 0; a < 2; ++a)
#pragma unroll
            for (int b = 0; b < 2; ++b)
#pragma unroll
                for (int m = 0; m < 4; ++m) asm volatile("" :: "v"(acc[a][b][m][0]), "v"(acc[a][b][m][1]));
    }
};
template <class Epi, class Sched, bool ALIGN_EPI = false, bool SP2 = false>
__device__ __forceinline__ void gemm_phase(PG8_LAS unsigned char* lds, const Gemm g, const Sched& S, const Epi& E) {
    int tid_l = threadIdx.x; asm volatile("" : "+v"(tid_l));
    const int tid = tid_l, wid = __builtin_amdgcn_readfirstlane(tid >> 6), lane = tid & 63, wr = wid >> 2, wc = wid & 3, fr = lane & 15, fq = lane >> 4;
    const int K = g.ld;
    unsigned voffA[2], voffB[2];
#pragma unroll
    for (int i = 0; i < 2; ++i) { int R, C; stage_rc(tid * 16 + i * 8192, R, C); const int Rb = Epi::PERM ? ((R & ~31) + perm32(R & 31)) : R;
        voffA[i] = (unsigned)(R * K + C) * 2u; voffB[i] = (unsigned)(Rb * K + C) * 2u; }
    const size_t kstep = (size_t)(BK * 2);
    const size_t hstep = (size_t)HALF * K * 2;
    const size_t tstep = 2 * hstep;
    const unsigned ldsw = (unsigned)wid * 1024u;
    const unsigned ldsbase_w = (unsigned)(size_t)lds + ldsw;
    const int aoff = lds_byte(wr * 64 + fr, fq * 8), boff = lds_byte(wc * 32 + fr, fq * 8);
#define PG8_SA(b, h) (((b) * 2 + (h)) * HTB)
#define PG8_SB(b, h) ((4 + (b) * 2 + (h)) * HTB)
#define PG8_STAGE1(ldsoff, gbase, IMM, voff32) asm volatile("s_mov_b32 m0, %2\n\ts_nop 0\n\tglobal_load_lds_dwordx4 %0, %1 offset:" #IMM :: "v"(voff32), "s"(gbase), "s"(ldsbase_w + (unsigned)(ldsoff)) : "memory", "m0")
#define PG8_STAGEI(bufoff, gbase, IMM, voff) do { PG8_STAGE1((bufoff), gbase, IMM, (voff)[0]); PG8_STAGE1((bufoff) + 8192, gbase, IMM, (voff)[1]); } while (0)
#define PG8_STAGE(bufoff, gbase, voff) PG8_STAGEI(bufoff, gbase, 0, voff)
#define PG8_LDA(dst, b, h) do { _Pragma("unroll") for (int m = 0; m < 4; ++m) _Pragma("unroll") for (int k = 0; k < 2; ++k) dst[m][k] = *(const PG8_LAS bf16x8*)(lds + PG8_SA(b, h) + aoff + m * 2048 + k * 1024); } while (0)
#define PG8_LDB(dst, b, h) do { _Pragma("unroll") for (int n = 0; n < 2; ++n) _Pragma("unroll") for (int k = 0; k < 2; ++k) dst[n][k] = *(const PG8_LAS bf16x8*)(lds + PG8_SB(b, h) + boff + n * 2048 + k * 1024); } while (0)
#define PG8_MMA(ai, bj, At, Bt) do { __builtin_amdgcn_s_setprio(1); _Pragma("unroll") for (int m = 0; m < 4; ++m) _Pragma("unroll") for (int n = 0; n < 2; ++n) _Pragma("unroll") for (int k = 0; k < 2; ++k) \
        acc[ai][bj][m][n] = __builtin_amdgcn_mfma_f32_16x16x32_bf16(Bt[n][k], At[m][k], acc[ai][bj][m][n], 0, 0, 0); __builtin_amdgcn_s_setprio(0); } while (0)
#define PG8_WAIT_V(n) asm volatile("s_waitcnt vmcnt(" #n ")" ::: "memory")
#define PG8_WAIT_L(n) asm volatile("s_waitcnt lgkmcnt(" #n ")" ::: "memory")
#define PG8_BAR __builtin_amdgcn_s_barrier()
#define PG8_SCHED __builtin_amdgcn_sched_barrier(0)
    Unit cur, nxt; int ui = 0;
    if (!S.next(0, cur)) return;
    f32x4 acc[2][2][4][2];
#pragma unroll
    for (int a = 0; a < 2; ++a)
#pragma unroll
        for (int b = 0; b < 2; ++b)
#pragma unroll
            for (int m = 0; m < 4; ++m)
#pragma unroll
                for (int n = 0; n < 2; ++n) acc[a][b][m][n] = (f32x4){0.f, 0.f, 0.f, 0.f};
    bf16x8 At[4][2], B0[2][2], B1[2][2];
    const char* cA = (const char*)g.A + (size_t)cur.pm * tstep + (size_t)cur.ko * 2; const char* cB = (const char*)g.Bt + (size_t)cur.pn * tstep + (size_t)cur.ko * 2;
    S.a_ready(cur);
    float pre[8];
    if constexpr (Epi::PRE) E.prefetch(cur, wr, fr, pre);
    PG8_LAS unsigned char* const tbl = lds + STAGE_BYTES;
    if constexpr (Epi::TBL) E.table_load(cur, tbl, wid);
    if constexpr (SP2) {
        PG8_STAGE(PG8_SB(0, 0), cB, voffB); PG8_STAGE(PG8_SB(0, 1), cB + hstep, voffB); PG8_STAGE(PG8_SA(0, 0), cA, voffA); PG8_STAGE(PG8_SA(0, 1), cA + hstep, voffA);
        if (wr == 1) PG8_BAR;
        PG8_WAIT_V(2); PG8_BAR;
        PG8_STAGE(PG8_SB(1, 0), cB + kstep, voffB); PG8_STAGE(PG8_SA(1, 0), cA + kstep, voffA); PG8_STAGE(PG8_SB(1, 1), cB + hstep + kstep, voffB);
        PG8_WAIT_V(6); PG8_BAR;
    } else {
        PG8_STAGE(PG8_SB(0, 0), cB, voffB); PG8_STAGE(PG8_SA(0, 0), cA, voffA); PG8_STAGE(PG8_SB(0, 1), cB + hstep, voffB); PG8_STAGE(PG8_SA(0, 1), cA + hstep, voffA);
        if (wr == 1) PG8_BAR;
        PG8_WAIT_V(4); PG8_BAR;
        PG8_STAGE(PG8_SB(1, 0), cB + kstep, voffB); PG8_STAGE(PG8_SA(1, 0), cA + kstep, voffA); PG8_STAGE(PG8_SB(1, 1), cB + hstep + kstep, voffB);
        PG8_WAIT_V(6); PG8_BAR;
    }
    for (;;) {
        const bool has_next = S.next(ui + 1, nxt);
        const char* nA = has_next ? (const char*)g.A + (size_t)nxt.pm * tstep + (size_t)nxt.ko * 2 : cA; const char* nB = has_next ? (const char*)g.Bt + (size_t)nxt.pn * tstep + (size_t)nxt.ko * 2 : cB;
        const int nt = cur.kt;
#define PG8_KSETUP() const bool last = (t == nt - 2); const char* a1 = cA + (size_t)(t + 1) * kstep; \
            const char* a2 = last ? nA : cA + (size_t)(t + 2) * kstep; const char* b2 = last ? nB : cB + (size_t)(t + 2) * kstep; const char* a3 = a2 + kstep; const char* b3 = b2 + kstep; \
            if (last && has_next) S.a_ready(nxt)
#define PG8_KITER_SP2(W1, W2) do { \
            PG8_LDB(B0, 0, 0); PG8_LDB(B1, 0, 1); PG8_SCHED; PG8_LDA(At, 0, 0); PG8_STAGE(PG8_SA(1, 1), a1 + hstep, voffA); \
            PG8_WAIT_V(W1); PG8_WAIT_L(0); PG8_BAR; PG8_MMA(0, 0, At, B0); PG8_MMA(0, 1, At, B1); PG8_BAR; PG8_SCHED; \
            PG8_LDA(At, 0, 1); PG8_STAGE(PG8_SB(0, 0), b2, voffB); PG8_STAGE(PG8_SB(0, 1), b2 + hstep, voffB); PG8_STAGE(PG8_SA(0, 0), a2, voffA); \
            PG8_WAIT_V(W2); PG8_WAIT_L(0); PG8_BAR; PG8_MMA(1, 0, At, B0); PG8_MMA(1, 1, At, B1); PG8_BAR; PG8_SCHED; \
            PG8_LDB(B0, 1, 0); PG8_LDB(B1, 1, 1); PG8_SCHED; PG8_LDA(At, 1, 0); PG8_STAGE(PG8_SA(0, 1), a2 + hstep, voffA); \
            PG8_WAIT_V(8); PG8_WAIT_L(0); PG8_BAR; PG8_MMA(0, 0, At, B0); PG8_MMA(0, 1, At, B1); PG8_BAR; PG8_SCHED; \
            PG8_LDA(At, 1, 1); PG8_STAGE(PG8_SB(1, 0), b3, voffB); PG8_STAGE(PG8_SB(1, 1), b3 + hstep, voffB); PG8_STAGE(PG8_SA(1, 0), a3, voffA); \
            PG8_WAIT_V(8); PG8_WAIT_L(0); PG8_BAR; PG8_MMA(1, 0, At, B0); PG8_MMA(1, 1, At, B1); PG8_BAR; PG8_SCHED; } while (0)
        int t0 = 0;
        if constexpr (SP2 && Epi::NVM == 16) { if (ui > 0) { const int t = 0; PG8_KSETUP(); PG8_KITER_SP2(24, 24); t0 = 2; } }
        if constexpr (SP2 && Epi::NVM == 8) { if (ui > 0) { const int t = 0; PG8_KSETUP(); PG8_KITER_SP2(16, 16); t0 = 2; } }
        for (int t = t0; t < nt; t += 2) {
            PG8_KSETUP();
            if constexpr (SP2) {
            PG8_KITER_SP2(8, 8);
            } else {
            PG8_LDB(B0, 0, 0); PG8_SCHED; PG8_LDA(At, 0, 0); PG8_STAGE(PG8_SA(1, 1), a1 + hstep, voffA);
            PG8_WAIT_L(8); PG8_BAR; PG8_WAIT_L(0); PG8_MMA(0, 0, At, B0); PG8_BAR; PG8_SCHED;
            PG8_LDB(B1, 0, 1); PG8_STAGE(PG8_SB(0, 0), b2, voffB);
            PG8_BAR; PG8_WAIT_L(0); PG8_MMA(0, 1, At, B1); PG8_BAR;
            PG8_LDA(At, 0, 1); PG8_STAGE(PG8_SA(0, 0), a2, voffA);
            PG8_BAR; PG8_WAIT_L(0); PG8_MMA(1, 0, At, B0); PG8_BAR; PG8_SCHED;
            PG8_STAGE(PG8_SB(0, 1), b2 + hstep, voffB);
            PG8_WAIT_V(6); PG8_BAR; PG8_MMA(1, 1, At, B1); PG8_BAR;
            PG8_LDB(B0, 1, 0); PG8_SCHED; PG8_LDA(At, 1, 0); PG8_STAGE(PG8_SA(0, 1), a2 + hstep, voffA);
            PG8_WAIT_L(8); PG8_BAR; PG8_WAIT_L(0); PG8_MMA(0, 0, At, B0); PG8_BAR; PG8_SCHED;
            PG8_LDB(B1, 1, 1); PG8_STAGE(PG8_SB(1, 0), b3, voffB);
            PG8_BAR; PG8_WAIT_L(0); PG8_MMA(0, 1, At, B1); PG8_BAR;
            PG8_LDA(At, 1, 1); PG8_STAGE(PG8_SA(1, 0), a3, voffA);
            PG8_BAR; PG8_WAIT_L(0); PG8_MMA(1, 0, At, B0); PG8_BAR; PG8_SCHED;
            PG8_STAGE(PG8_SB(1, 1), b3 + hstep, voffB);
            PG8_WAIT_V(6); PG8_BAR; PG8_MMA(1, 1, At, B1); PG8_BAR;
            }
        }
#undef PG8_KSETUP
#undef PG8_KITER_SP2
        if constexpr (ALIGN_EPI) { if (wr == 0) PG8_BAR; }
        if constexpr (!Epi::AFTER_DRAIN) { if constexpr (Epi::TBL) { E(acc, cur, wr, wc, fr, fq, (const PG8_LAS float*)(tbl + (ui & 1) * 1024)); if (has_next) E.table_load(nxt, tbl + ((ui + 1) & 1) * 1024, wid); } else if constexpr (Epi::PRE) { E(acc, cur, wr, wc, fr, fq, pre); if (has_next) E.prefetch(nxt, wr, fr, pre); } else E(acc, cur, wr, wc, fr, fq); S.done(cur); }
        if (!has_next) break;
#pragma unroll
        for (int a = 0; a < 2; ++a)
#pragma unroll
            for (int b = 0; b < 2; ++b)
#pragma unroll
                for (int m = 0; m < 4; ++m)
#pragma unroll
                    for (int n = 0; n < 2; ++n) acc[a][b][m][n] = (f32x4){0.f, 0.f, 0.f, 0.f};
        cur = nxt; cA = nA; cB = nB; ++ui;
        if constexpr (ALIGN_EPI) { if (wr == 1) PG8_BAR; }
    }
    PG8_WAIT_V(0);
    if constexpr (!ALIGN_EPI) { if (wr == 0) PG8_BAR; }
    PG8_BAR;
    if constexpr (Epi::AFTER_DRAIN) { E.fused(acc, cur, wr, wc, fr, fq, lds, wid, lane); S.done(cur); }
#undef PG8_SA
#undef PG8_SB
#undef PG8_STAGE
#undef PG8_LDA
#undef PG8_LDB
#undef PG8_MMA
#undef PG8_WAIT_V
#undef PG8_WAIT_L
#undef PG8_BAR
#undef PG8_SCHED
}
}
namespace att {
typedef unsigned short u16;
using bf16x8 = __attribute__((ext_vector_type(8))) short;
using s16x4  = __attribute__((ext_vector_type(4))) short;
using f32x16 = __attribute__((ext_vector_type(16))) float;
using u32x4  = __attribute__((ext_vector_type(4))) unsigned;
constexpr int   D = 128, KVBLK = 64, LDK = 128, LDQ = 3072, LDO = 2048;
constexpr float SCALE = 0.088388347648318440f;
constexpr float THR = 8.f;
constexpr float NEGBIG = -1e30f;
constexpr size_t SHM_V = KVBLK * D * 2, SHM_K = KVBLK * D * 2, SHM_ATTN = 2 * SHM_V + 2 * SHM_K + 8 * 64 * 4;
#define KSWZ(row, colB) ((row) * 256 + ((colB) ^ (((row) & 7) << 4)))
#define SBAR() __builtin_amdgcn_sched_barrier(0)
__device__ __forceinline__ int crow(int r, int hi) { return (r & 3) + 8 * (r >> 2) + 4 * hi; }
__device__ __forceinline__ unsigned cvtpk(float lo, float hi) { unsigned r; asm volatile("v_cvt_pk_bf16_f32 %0, %1, %2" : "=v"(r) : "v"(lo), "v"(hi)); return r; }

__device__ __forceinline__ void partialSM(f32x16& p0, f32x16& p1, float& m_reg, float& mn, float& alpha) {
  constexpr float C = SCALE * 1.4426950408889634f;
  float pmax = p0[0]; for (int r = 1; r < 16; ++r) pmax = fmaxf(pmax, p0[r]); for (int r = 0; r < 16; ++r) pmax = fmaxf(pmax, p1[r]);
  { auto rr = __builtin_amdgcn_permlane32_swap(__float_as_uint(pmax), __float_as_uint(pmax), false, false);
    pmax = fmaxf(__uint_as_float(rr[0]), __uint_as_float(rr[1])); }
  if (__builtin_expect(__all(pmax - m_reg <= THR / SCALE), 1)) { mn = m_reg; alpha = 1.f; }
  else { mn = fmaxf(m_reg, pmax); alpha = __builtin_amdgcn_exp2f((m_reg - mn) * C); m_reg = mn; }
  float mnC = -mn * C;
  for (int r = 0; r < 16; ++r) p0[r] = fmaf(p0[r], C, mnC); for (int r = 0; r < 16; ++r) p1[r] = fmaf(p1[r], C, mnC);
  for (int r = 0; r < 16; ++r) p0[r] = __builtin_amdgcn_exp2f(p0[r]);
}
__device__ __forceinline__ void finishSM(f32x16& p0, f32x16& p1, float alpha, float& l_reg, bf16x8& pa0, bf16x8& pa1, bf16x8& pa2, bf16x8& pa3) {
  for (int r = 0; r < 16; ++r) p1[r] = __builtin_amdgcn_exp2f(p1[r]);
  float ps = 0; for (int r = 0; r < 16; ++r) ps += p0[r]; for (int r = 0; r < 16; ++r) ps += p1[r];
  { auto rr = __builtin_amdgcn_permlane32_swap(__float_as_uint(ps), __float_as_uint(ps), false, false);
    ps = __uint_as_float(rr[0]) + __uint_as_float(rr[1]); }
  l_reg = l_reg * alpha + ps;
#define PK4(P, BASE, OUT) do { unsigned a0 = cvtpk(P[BASE + 0], P[BASE + 1]), a1 = cvtpk(P[BASE + 2], P[BASE + 3]);   \
    unsigned b0 = cvtpk(P[BASE + 4], P[BASE + 5]), b1 = cvtpk(P[BASE + 6], P[BASE + 7]);                              \
    auto r0 = __builtin_amdgcn_permlane32_swap(a0, b0, false, false); auto r1 = __builtin_amdgcn_permlane32_swap(a1, b1, false, false); \
    u32x4 w = {r0[0], r1[0], r0[1], r1[1]}; OUT = *reinterpret_cast<bf16x8*>(&w); } while (0)
  PK4(p0, 0, pa0); PK4(p0, 8, pa1); PK4(p1, 0, pa2); PK4(p1, 8, pa3);
#undef PK4
}
__device__ __forceinline__ void qkt(f32x16& p0, f32x16& p1, const u16* Ks, const bf16x8* qr, int r32, int hi) {
  p0 = f32x16{}; p1 = f32x16{};
  for (int d0 = 0; d0 < 8; ++d0) { int cb = (d0 * 16 + hi * 8) * 2;
    bf16x8 b0 = *reinterpret_cast<const bf16x8*>((const char*)Ks + KSWZ(r32, cb));
    bf16x8 b1 = *reinterpret_cast<const bf16x8*>((const char*)Ks + KSWZ(32 + r32, cb));
    p0 = __builtin_amdgcn_mfma_f32_32x32x16_bf16(b0, qr[d0], p0, 0, 0, 0);
    p1 = __builtin_amdgcn_mfma_f32_32x32x16_bf16(b1, qr[d0], p1, 0, 0, 0); }
}
__device__ __forceinline__ void qkt_lds(f32x16& p0, f32x16& p1, const u16* Ks, const char* qs, int r32, int hi) {
  p0 = f32x16{}; p1 = f32x16{};
  for (int d0 = 0; d0 < 8; ++d0) { int cb = (d0 * 16 + hi * 8) * 2;
    bf16x8 q = *reinterpret_cast<const bf16x8*>(qs + d0 * 1024);
    bf16x8 b0 = *reinterpret_cast<const bf16x8*>((const char*)Ks + KSWZ(r32, cb));
    bf16x8 b1 = *reinterpret_cast<const bf16x8*>((const char*)Ks + KSWZ(32 + r32, cb));
    p0 = __builtin_amdgcn_mfma_f32_32x32x16_bf16(b0, q, p0, 0, 0, 0);
    p1 = __builtin_amdgcn_mfma_f32_32x32x16_bf16(b1, q, p1, 0, 0, 0); }
}
__device__ __forceinline__ int v_st(int k, int c) { const int kk = (k & ~0xC) | ((k & 4) << 1) | ((k & 8) >> 1); return ((kk >> 3) * 4 + (c >> 5)) * 512 + ((kk & 7) * 32 + (c & 31)) * 2; }
__device__ __forceinline__ int v_rd_base(int lane) { return ((lane & 3) << 3) | (((lane >> 2) & 3) << 6) | (((lane >> 4) & 1) << 5) | (((lane >> 5) & 1) << 8); }
constexpr int v_rd_off(int d0, int ks, int half) { return d0 * 512 + ks * 4096 + half * 2048; }
template <int OFF> __device__ __forceinline__ s16x4 tr_read(int vb) {
  s16x4 r; asm volatile("ds_read_b64_tr_b16 %0, %1 offset:%2" : "=&v"(r) : "v"(vb), "i"(OFF) : "memory"); return r;
}
template <int D0> __device__ __forceinline__ void pv_one(f32x16& od, int vb, bf16x8 pa0, bf16x8 pa1, bf16x8 pa2, bf16x8 pa3) {
  const s16x4 l0 = tr_read<v_rd_off(D0, 0, 0)>(vb), h0 = tr_read<v_rd_off(D0, 0, 1)>(vb), l1 = tr_read<v_rd_off(D0, 1, 0)>(vb), h1 = tr_read<v_rd_off(D0, 1, 1)>(vb);
  const s16x4 l2 = tr_read<v_rd_off(D0, 2, 0)>(vb), h2 = tr_read<v_rd_off(D0, 2, 1)>(vb), l3 = tr_read<v_rd_off(D0, 3, 0)>(vb), h3 = tr_read<v_rd_off(D0, 3, 1)>(vb);
  asm volatile("s_waitcnt lgkmcnt(0)" ::: "memory"); SBAR();
#define PK(L, H) (bf16x8){L[0], L[1], L[2], L[3], H[0], H[1], H[2], H[3]}
  od = __builtin_amdgcn_mfma_f32_32x32x16_bf16(pa0, PK(l0, h0), od, 0, 0, 0);
  od = __builtin_amdgcn_mfma_f32_32x32x16_bf16(pa1, PK(l1, h1), od, 0, 0, 0);
  od = __builtin_amdgcn_mfma_f32_32x32x16_bf16(pa2, PK(l2, h2), od, 0, 0, 0);
  od = __builtin_amdgcn_mfma_f32_32x32x16_bf16(pa3, PK(l3, h3), od, 0, 0, 0);
#undef PK
}
__device__ __forceinline__ void pv_d0(f32x16* o, int vb, bf16x8 pa0, bf16x8 pa1, bf16x8 pa2, bf16x8 pa3) {
  pv_one<0>(o[0], vb, pa0, pa1, pa2, pa3); pv_one<1>(o[1], vb, pa0, pa1, pa2, pa3); pv_one<2>(o[2], vb, pa0, pa1, pa2, pa3); pv_one<3>(o[3], vb, pa0, pa1, pa2, pa3);
}
__device__ __forceinline__ void mask_meta_tile(f32x16& p0, f32x16& p1) {
#pragma unroll
  for (int r = 8; r < 16; ++r) p0[r] = NEGBIG;
#pragma unroll
  for (int r = 0; r < 16; ++r) p1[r] = NEGBIG;
}
__device__ __forceinline__ void mask_win_tile(f32x16& p0, f32x16& p1, float dlt  , float slopeS, bool ismeta) {
  if (!ismeta) {
#pragma unroll
    for (int r = 0; r < 16; ++r) { const float c = (float)((r & 3) + 8 * (r >> 2)); const float d0 = fabsf(dlt - c), d1 = fabsf(dlt - 32.f - c);
      p0[r] = (d0 <= 128.f) ? fmaf(-slopeS, d0, p0[r]) : NEGBIG; p1[r] = (d1 <= 128.f) ? fmaf(-slopeS, d1, p1[r]) : NEGBIG; }
  } else {
#pragma unroll
    for (int r = 0; r < 16; ++r) { const float c = (float)((r & 3) + 8 * (r >> 2));
      p0[r] = (dlt - c >= 0.f) ? p0[r] : NEGBIG; p1[r] = (dlt - 32.f - c >= 0.f) ? p1[r] : NEGBIG; }
  }
}

template <int MODE>
__device__ __forceinline__ void attn_item(const u16* __restrict__ Qw, const u16* __restrict__ Kh, const u16* __restrict__ Vh, u16* __restrict__ Ow, bool metaq, bool store,
                                          int NT, int ktlo, int tq, float slopeS, float sinkL2, char* lds, bool mask0, float* __restrict__ po, float* __restrict__ pml) {
  int tid_l = threadIdx.x; asm volatile("" : "+v"(tid_l));
  const int tid = tid_l, wid = tid >> 6, lane = tid & 63, r32 = lane & 31, hi = lane >> 5;
  constexpr int NS = (MODE == 0) ? 3 : 2;
  u16* V_lds = (u16*)lds; u16* K_lds = (u16*)(lds + NS * SHM_V);
  float* ws = (float*)(lds + NS * (SHM_V + SHM_K)) + wid * 64; float* li_l = ws; float* al_l = ws + 32;
  float m_reg = -1e30f, l_reg = 0; f32x16 o[4] = {}; bf16x8 qr[8];
  char* qs = lds + SHM_ATTN + wid * 8192 + lane * 16;
#pragma unroll
  for (int d0 = 0; d0 < 8; ++d0) qr[d0] = *reinterpret_cast<const bf16x8*>(Qw + d0 * 16);
#define QKT(P0, P1, KS) do { if (MODE == 1) qkt_lds(P0, P1, KS, qs, r32, hi); else qkt(P0, P1, KS, qr, r32, hi); } while (0)
  const int sr = tid >> 4, sc = (tid & 15) * 8, vst0 = v_st(sr, sc), vst1 = v_st(32 + sr, sc);
  const int vb0 = (int)(uintptr_t)V_lds + v_rd_base(lane);
  constexpr int SD = 2;
  struct { bf16x8 vs0, vs1, ks0, ks1; } sr_[SD];
#define KROW(t) ((MODE == 0 || (t)) ? 64 * (ktlo + (t)) : 0)
#define SLOAD(i, tt) do { const int k0_ = KROW(tt); sr_[i].vs0 = *reinterpret_cast<const bf16x8*>(&Vh[(long)(k0_ + sr) * LDK + sc]); sr_[i].vs1 = *reinterpret_cast<const bf16x8*>(&Vh[(long)(k0_ + 32 + sr) * LDK + sc]); \
    sr_[i].ks0 = *reinterpret_cast<const bf16x8*>(&Kh[(long)(k0_ + sr) * LDK + sc]); sr_[i].ks1 = *reinterpret_cast<const bf16x8*>(&Kh[(long)(k0_ + 32 + sr) * LDK + sc]); } while (0)
#define SWRITE(b, i) do { *(bf16x8*)((char*)V_lds + (b) * SHM_V + vst0) = sr_[i].vs0;          \
    *(bf16x8*)((char*)V_lds + (b) * SHM_V + vst1) = sr_[i].vs1; int kc = sc * 2;               \
    *(bf16x8*)((char*)K_lds + (b) * SHM_K + KSWZ(sr, kc)) = sr_[i].ks0;                       \
    *(bf16x8*)((char*)K_lds + (b) * SHM_K + KSWZ(32 + sr, kc)) = sr_[i].ks1; } while (0)
#define SWAIT() do { if (SD == 2) asm volatile("s_waitcnt vmcnt(4)" ::: "memory"); else asm volatile("s_waitcnt vmcnt(0)" ::: "memory"); } while (0)
#define RESC(a) do { if (__any((a) < 1.f)) { if (hi == 0) al_l[r32] = (a); asm volatile("s_waitcnt lgkmcnt(0)" ::: "memory"); \
    for (int d = 0; d < 4; ++d) for (int r = 0; r < 16; ++r) o[d][r] *= al_l[crow(r, hi)]; } } while (0)
  const float tqf = (float)(tq - 4 * hi);
#define WMASK(P0, P1, tt) do { if (MODE == 1) mask_win_tile(P0, P1, tqf - (float)(64 * (ktlo + (tt) - 1)), slopeS, metaq); } while (0)
  f32x16 pA0, pA1, pB0, pB1; float mnA, mnB, alA, alB; bf16x8 pa0, pa1, pa2, pa3;
  constexpr int SE = 0, SO = SD - 1;
  SLOAD(SE, 0);
  __builtin_amdgcn_sched_barrier(0);
  if (MODE == 1) {
    __builtin_amdgcn_sched_barrier(0);
#pragma unroll
    for (int d0 = 0; d0 < 8; ++d0) *reinterpret_cast<bf16x8*>(qs + d0 * 1024) = qr[d0];
    __builtin_amdgcn_sched_barrier(0); }
  __syncthreads();
  asm volatile("s_waitcnt vmcnt(0)" ::: "memory"); SWRITE(0, SE); __syncthreads();
  QKT(pA0, pA1, K_lds); if (mask0) mask_meta_tile(pA0, pA1); partialSM(pA0, pA1, m_reg, mnA, alA);
  SLOAD(SO, 1); if (SD == 2) SLOAD(SE, 2);
  SWAIT(); SWRITE(1, SO); __syncthreads();
  if (MODE == 0) {
    int sj = 1, slast = 1;
    for (int j = 1; j + 1 < NT; j += 2) {
      const int s0_ = sj, s1_ = sj == 2 ? 0 : sj + 1, s2_ = s1_ == 2 ? 0 : s1_ + 1;
      SBAR(); QKT(pB0, pB1, (u16*)((char*)K_lds + s0_ * SHM_K));
      finishSM(pA0, pA1, alA, l_reg, pa0, pa1, pa2, pa3); SBAR();
      { const int tn = (j + 2 < NT) ? j + 2 : NT - 1; SLOAD(SO, tn); } SBAR();
      pv_d0(o, vb0 + s2_ * (int)SHM_V, pa0, pa1, pa2, pa3); partialSM(pB0, pB1, m_reg, mnB, alB);
      SWAIT(); SWRITE(s1_, SE);
      RESC(alB); __syncthreads();
      SBAR(); QKT(pA0, pA1, (u16*)((char*)K_lds + s1_ * SHM_K));
      finishSM(pB0, pB1, alB, l_reg, pa0, pa1, pa2, pa3); SBAR();
      { const int tn = (j + 3 < NT) ? j + 3 : NT - 1; SLOAD(SE, tn); } SBAR();
      pv_d0(o, vb0 + s0_ * (int)SHM_V, pa0, pa1, pa2, pa3); partialSM(pA0, pA1, m_reg, mnA, alA);
      SWAIT(); SWRITE(s2_, SO);
      RESC(alA); __syncthreads();
      sj = s2_; slast = s1_;
    }
    finishSM(pA0, pA1, alA, l_reg, pa0, pa1, pa2, pa3); SBAR();
    pv_d0(o, vb0 + slast * (int)SHM_V, pa0, pa1, pa2, pa3);
  } else {
  for (int j = 1; j + 1 < NT; j += 2) {
    SBAR(); QKT(pB0, pB1, (u16*)((char*)K_lds + SHM_K)); WMASK(pB0, pB1, j);
    finishSM(pA0, pA1, alA, l_reg, pa0, pa1, pa2, pa3); SBAR();
    { const int tn = (j + SD < NT) ? j + SD : NT - 1; SLOAD(SO, tn); } SBAR();
    pv_d0(o, vb0, pa0, pa1, pa2, pa3); partialSM(pB0, pB1, m_reg, mnB, alB);
    __syncthreads(); SWAIT(); SWRITE(0, SE);
    RESC(alB); __syncthreads();
    SBAR(); QKT(pA0, pA1, K_lds); WMASK(pA0, pA1, j + 1);
    finishSM(pB0, pB1, alB, l_reg, pa0, pa1, pa2, pa3); SBAR();
    { const int tn = (j + 1 + SD < NT) ? j + 1 + SD : NT - 1; SLOAD(SE, tn); } SBAR();
    pv_d0(o, vb0 + (int)SHM_V, pa0, pa1, pa2, pa3); partialSM(pA0, pA1, m_reg, mnA, alA);
    __syncthreads(); SWAIT(); SWRITE(1, SO);
    RESC(alA); __syncthreads();
  }
  finishSM(pA0, pA1, alA, l_reg, pa0, pa1, pa2, pa3); SBAR();
  pv_d0(o, vb0, pa0, pa1, pa2, pa3);
  }
  if (MODE == 1) l_reg += __builtin_amdgcn_exp2f(sinkL2 - m_reg * (SCALE * 1.4426950408889634f));
  if (MODE == 0 && po != nullptr) {
    if (store) {
      if (hi == 0) { pml[2 * r32] = m_reg; pml[2 * r32 + 1] = l_reg; }
#pragma unroll
      for (int r = 0; r < 16; ++r) { const int orow = crow(r, hi);
#pragma unroll
        for (int d0 = 0; d0 < 4; ++d0) po[orow * 128 + d0 * 32 + r32] = o[d0][r]; }
    }
  } else {
  if (hi == 0) li_l[r32] = l_reg; asm volatile("s_waitcnt lgkmcnt(0)" ::: "memory");
  float rli[16];
#pragma unroll
  for (int r = 0; r < 16; ++r) rli[r] = __builtin_amdgcn_rcpf(li_l[crow(r, hi)]);
  if (store) {
#pragma unroll
    for (int r = 0; r < 16; ++r) { const int orow = crow(r, hi); const long ro = metaq ? (long)(orow & 15) * LDO + (orow >> 4) * 128 : (long)orow * LDO;
#pragma unroll
      for (int d0 = 0; d0 < 4; ++d0) { const float v = o[d0][r] * rli[r]; Ow[ro + d0 * 32 + r32] = (u16)(cvtpk(v, v) & 0xffffu); } }
  }
  }
#undef KROW
#undef QKT
#undef SLOAD
#undef SWRITE
#undef SWAIT
#undef RESC
#undef WMASK
}
}
typedef unsigned short u16;
typedef float f32x4 __attribute__((ext_vector_type(4)));
typedef float f32x2 __attribute__((ext_vector_type(2)));
typedef unsigned u32x4 __attribute__((ext_vector_type(4)));
typedef unsigned u32x2 __attribute__((ext_vector_type(2)));
typedef short bf16x8 __attribute__((ext_vector_type(8)));
typedef short s16x4 __attribute__((ext_vector_type(4)));
#define LAS __attribute__((address_space(3)))

constexpr int DM = 2048, NH = 16, NKV = 4, HD = 128, QKVD = 3072, DFF = 5632, NMETA = 16, NSEQ = 4;
constexpr int TREAL = 49152, MROW0 = TREAL, TTOK = TREAL + NSEQ * NMETA  , TPAD = 49408  ;
constexpr float EPS = 1e-6f;
__host__ __device__ constexpr int seq_S(int s) { return s < 2 ? 8192 : 16384; }
__host__ __device__ constexpr int seq_R0(int s) { return s == 0 ? 0 : s == 1 ? 8192 : s == 2 ? 16384 : 32768; }
__host__ __device__ constexpr int seq_K0(int s) { return s == 0 ? 0 : s == 1 ? 8256 : s == 2 ? 16512 : 32960; }
__host__ __device__ constexpr int seq_Y0(int s) { return s == 0 ? 0 : s == 1 ? 8208 : s == 2 ? 16416 : 32816; }
constexpr int P_N1 = 76, P_N2 = 108, S_N1 = 100, S_N2 = 164;
constexpr int FA_P_J = 160, FA_P_KK = 160, FB_P_J = 224, FB_P_KK = 112, FA_S_J = 224, FA_S_KK = 208, FB_S_J = 352, FB_S_KK = 176;

constexpr size_t MiB = 1u << 20;
constexpr size_t WS_CTL = 0, CTL_ZERO_BYTES = 1 * MiB;
constexpr size_t WS_ROPE = 1 * MiB;
constexpr size_t WS_FC = WS_ROPE + 64 * 1024;
constexpr size_t WS_FA_P = WS_FC + 256 * 1024, WS_FB_P = WS_FA_P + 128 * 1024, WS_FA_S = WS_FB_P + 128 * 1024, WS_FB_S = WS_FA_S + 128 * 1024;
constexpr size_t WS_HMETA = 2 * MiB;
constexpr size_t WS_W = 4 * MiB;
constexpr size_t W_AQKV = 0, W_AWO = W_AQKV + (size_t)QKVD * DM, W_BW = W_AWO + (size_t)DM * DM, W_CIN = W_BW + (size_t)DM * DM, W_COUT = W_CIN + (size_t)3 * DM * DM,
                 W_DQKV = W_COUT + (size_t)DM * DM, W_DWO = W_DQKV + (size_t)QKVD * DM, W_FIN = W_DWO + (size_t)DM * DM, W_FOUT = W_FIN + (size_t)4 * 2 * DFF * DM, W_END = W_FOUT + (size_t)4 * DFF * DM;
constexpr size_t WS_HB = WS_W + 352 * MiB;
constexpr size_t WS_BIG = WS_HB + 193 * MiB;
constexpr size_t BIG_QKV = 0, BIG_KC = 290 * MiB, BIG_VC = 339 * MiB;
constexpr size_t BIG_PO = 400 * MiB, BIG_PML = 410 * MiB;
constexpr size_t BIG_SS = 560 * MiB, BIG_RSTD = 570 * MiB;
constexpr size_t BIG_TAILP = 540 * MiB;
constexpr size_t BIG_ACT = 0;
constexpr size_t BIG_BB = 0, BIG_GB = 193 * MiB;
constexpr size_t BIG_Z = 0, BIG_Y = 385 * MiB;
constexpr size_t WS_END = WS_BIG + 770 * MiB;
static_assert(W_END * 2 <= 352 * MiB && (size_t)TPAD * DM * 2 <= 193 * MiB && (size_t)TPAD * QKVD * 2 <= 290 * MiB && (size_t)TPAD * 512 * 2 <= 49 * MiB, "ws map");
static_assert((size_t)TPAD * DFF * 2 <= 770 * MiB && (size_t)TTOK * 4096 * 2 <= 385 * MiB, "ws map");
constexpr int CW_BAR = 4096;

constexpr int LDS_STAGE = 133120;
constexpr int LDS_MISC = LDS_STAGE;
constexpr int LDS_BYTES = LDS_STAGE + 256;

#define XB_TMO      128
#define XB_XCNT(j)  (256  + 64 * (j))
#define XB_XSUB(j)  (1280 + 64 * (j))
#define XB_XGEN(j)  (2304 + 64 * (j))
#define XB_TOP      3328
#define XB_TOPGEN   3392
#define XCD_BAR_WORDS 3456
#define XB_SPIN_CAP (1u << 18)
__device__ __forceinline__ unsigned xb_ld(unsigned* p)              { return __hip_atomic_load(p, __ATOMIC_RELAXED, __HIP_MEMORY_SCOPE_AGENT); }
__device__ __forceinline__ unsigned xb_add(unsigned* p, unsigned v) { return __hip_atomic_fetch_add(p, v, __ATOMIC_RELAXED, __HIP_MEMORY_SCOPE_AGENT); }
__device__ __forceinline__ unsigned xb_xcc_id() { return (unsigned)__builtin_amdgcn_s_getreg((3 << 11) | 20) & 0xFu; }
#define XB_SPIN(cond, bar) do { unsigned _sp = 0; while (cond) { __builtin_amdgcn_s_sleep(1); \
    if ((++_sp & 255u) == 0u) { if (xb_ld(&(bar)[XB_TMO])) break; if (_sp > XB_SPIN_CAP) { atomicAdd(&(bar)[XB_TMO], 1u); break; } } } } while (0)
struct XcdBarrier { unsigned* bar; unsigned x; volatile LAS unsigned* st; };
__device__ __forceinline__ XcdBarrier xcd_barrier_post(unsigned* bar, volatile LAS unsigned* st) {
    XcdBarrier b; b.bar = bar; b.x = xb_xcc_id(); b.st = st;
    if (threadIdx.x == 0) (void)xb_add(&bar[XB_XCNT(b.x)], 1u);
    return b;
}
__device__ __forceinline__ void xcd_barrier_complete(unsigned* bar, unsigned x, unsigned& nloc, unsigned& nx) {
    const unsigned G = gridDim.x * gridDim.y * gridDim.z;
    unsigned sum, cnt, mine, sp = 0u;
    for (;;) {
        sum = 0u; cnt = 0u; mine = 0u;
#pragma unroll
        for (unsigned j = 0; j < 16; ++j) { const unsigned c = xb_ld(&bar[XB_XCNT(j)]); sum += c; cnt += (c > 0u) ? 1u : 0u; mine = (j == x) ? c : mine; }
        if (sum == G) break;
        __builtin_amdgcn_s_sleep(1);
        if ((++sp & 255u) == 0u) { if (xb_ld(&bar[XB_TMO])) break; if (sp > XB_SPIN_CAP) { atomicAdd(&bar[XB_TMO], 1u); break; } }
    }
    nloc = mine > 0u ? mine : 1u; nx = cnt > 0u ? cnt : 1u;
}
__device__ __forceinline__ void xcd_barrier(const XcdBarrier& b) {
    asm volatile("s_waitcnt vmcnt(0)" ::: "memory");
    __syncthreads();
    if (threadIdx.x == 0) {
        unsigned* bar = b.bar;
        __builtin_amdgcn_s_waitcnt(0);
        unsigned nloc = b.st[0], nx = b.st[1];
        if (nloc == 0u) { xcd_barrier_complete(bar, b.x, nloc, nx); b.st[0] = nloc; b.st[1] = nx; }
        const unsigned old = xb_add(&bar[XB_XSUB(b.x)], 1u);
        const unsigned gen = old / nloc;
        if (old + 1u == (gen + 1u) * nloc) {
            __builtin_amdgcn_fence(__ATOMIC_RELEASE, "agent");
            asm volatile("s_waitcnt vmcnt(0)" ::: "memory");
            const unsigned og = xb_add(&bar[XB_TOP], 1u);
            const unsigned tg = og / nx;
            if (og + 1u == (tg + 1u) * nx) xb_add(&bar[XB_TOPGEN], 1u);
            else XB_SPIN(xb_ld(&bar[XB_TOPGEN]) == tg, bar);
            __builtin_amdgcn_fence(__ATOMIC_ACQUIRE, "agent");
            xb_add(&bar[XB_XGEN(b.x)], 1u);
            asm volatile("s_waitcnt vmcnt(0)" ::: "memory");
        } else {
            XB_SPIN(xb_ld(&bar[XB_XGEN(b.x)]) == gen, bar);
            __builtin_amdgcn_fence(__ATOMIC_ACQUIRE, "agent");
            asm volatile("s_waitcnt vmcnt(0)" ::: "memory");
        }
    }
    __syncthreads();
}

struct Job { const float* src; u16* dst; const float* gain; int K, ld, col0, ncols, split, mult, roff, item0; };
struct Params {
    const float* in[20]; float* out; unsigned char* ws;
    int ph_lo, ph_hi;
};
enum { I_XP = 0, I_XS, I_META, I_LNMIX, I_LNFFN, I_AWQKV, I_AQN, I_AKN, I_AWO, I_BW, I_CWIN, I_CCONV, I_CWOUT, I_DWQKV, I_DQN, I_DKN, I_DSINK, I_DWO, I_FIN, I_FOUT };

#define GAS __attribute__((address_space(1)))
#define LAUNDER_PTR(T, name, src) GAS char* name##_g = (GAS char*)(src); asm volatile("" : "+s"(name##_g)); T name = (T)name##_g
template <int M> __device__ __forceinline__ float swz_xor(float v) { return __int_as_float(__builtin_amdgcn_ds_swizzle(__float_as_int(v), 0x1f | (M << 10))); }
__device__ __forceinline__ float wave_sum(float v) {
    v += swz_xor<1>(v); v += swz_xor<2>(v); v += swz_xor<4>(v); v += swz_xor<8>(v); v += swz_xor<16>(v);
    const auto rr = __builtin_amdgcn_permlane32_swap(__float_as_uint(v), __float_as_uint(v), false, false);
    return __uint_as_float(rr[0]) + __uint_as_float(rr[1]);
}
__device__ __forceinline__ unsigned pk2(float lo, float hi) { unsigned r; asm volatile("v_cvt_pk_bf16_f32 %0, %1, %2" : "=v"(r) : "v"(lo), "v"(hi)); return r; }
__device__ __forceinline__ float bflo(unsigned w) { return __uint_as_float(w << 16); }
__device__ __forceinline__ float bfhi(unsigned w) { return __uint_as_float(w & 0xffff0000u); }
__device__ __forceinline__ int rowmap(int s, int l) { return l < NMETA ? MROW0 + NMETA * s + l : seq_R0(s) + l - NMETA; }

__device__ __forceinline__ void transpose_item(const Job& jb, LAS float* scr, int item, int lane) {
    const int nblk = jb.ncols / 64, kb = item / nblk, nb = item % nblk, k0 = 64 * kb, n0 = 64 * nb;
    const float* W = jb.src + jb.col0;
#pragma unroll 8
    for (int kk = 0; kk < 64; ++kk) scr[kk * 65 + lane] = W[(size_t)(k0 + kk) * jb.ld + n0 + lane];
    asm volatile("s_waitcnt lgkmcnt(0)" ::: "memory");
    const int c = lane & 7;
    f32x4 ga = {1.f, 1.f, 1.f, 1.f}, gb = ga;
    if (jb.gain) { ga = *(const f32x4*)(jb.gain + k0 + 8 * c); gb = *(const f32x4*)(jb.gain + k0 + 8 * c + 4); }
#pragma unroll
    for (int j = 0; j < 8; ++j) { const int n = (lane >> 3) + 8 * j; const LAS float* s = scr + (8 * c) * 65 + n;
        u32x4 o; o.x = pk2(s[0 * 65] * ga.x, s[1 * 65] * ga.y); o.y = pk2(s[2 * 65] * ga.z, s[3 * 65] * ga.w); o.z = pk2(s[4 * 65] * gb.x, s[5 * 65] * gb.y); o.w = pk2(s[6 * 65] * gb.z, s[7 * 65] * gb.w);
        const int nn = n0 + n; int drow;
        if (jb.mult == 1) drow = jb.roff + nn;
        else { const int part = nn / jb.split, jj = nn % jb.split, o = jj & 127;
            drow = jb.roff + (jj >> 7) * 256 + ((o >> 2) & 1) * 128 + (o >> 5) * 32 + ((o >> 3) & 3) * 8 + (o & 3) * 2 + part; }
        *(u32x4*)(jb.dst + (size_t)drow * jb.K + k0 + 8 * c) = o; }
    asm volatile("s_waitcnt lgkmcnt(0)" ::: "memory");
}
__device__ __forceinline__ u16 f2bf(float f) { return (u16)(pk2(f, f) & 0xffffu); }
__device__ __forceinline__ void gen_FA(u16* F, int N1, int Jp, int KKp, int gt, int ngt) {
    for (int e = gt; e < KKp * Jp; e += ngt) { const int kk = e / Jp, j = e % Jp; float v = 0.f;
        if (kk < 2 * N1 && j < 2 * N1) { const int po = kk >= N1, pi = j >= N1, k1 = kk - po * N1, l1 = j - pi * N1; float sn, cs; sincospif(2.0f * (float)((k1 * l1) % N1) / (float)N1, &sn, &cs);
            v = (po == pi) ? cs : (po ? -sn : sn); }
        F[e] = f2bf(v); }
}
__device__ __forceinline__ void gen_FB(u16* F, int N2, int Jp, int KKp, float scale, int gt, int ngt) {
    for (int e = gt; e < KKp * Jp; e += ngt) { const int kk = e / Jp, j = e % Jp; float v = 0.f;
        if (kk < N2 && j < 2 * N2) { const int pi = j >= N2, l2 = j - pi * N2; float sn, cs; sincospif(2.0f * (float)((kk * l2) % N2) / (float)N2, &sn, &cs); v = (pi ? sn : cs) * scale; }
        F[e] = f2bf(v); }
}
__device__ __forceinline__ void prologue_phase(const Params& P, LAS unsigned char* lds, int wave_, int lane_) {
    int tid_q = threadIdx.x; asm volatile("" : "+v"(tid_q)); const int lane = tid_q & 63, wave = __builtin_amdgcn_readfirstlane(tid_q >> 6); (void)lane_; (void)wave_;
    LAUNDER_PTR(unsigned char*, ws, P.ws);
    LAS float* scr = (LAS float*)(lds + wave * 16640);
    const int gw = blockIdx.x * 8 + wave, NGW = gridDim.x * 8;
    u16* Wb = (u16*)(ws + WS_W);
    constexpr int IT_S = 32 * 32  , IT_QKV = 32 * 48, IT_CU = 32 * 64, IT_FIN = 32 * 176, IT_FOUT = 88 * 32;
    constexpr int O1 = IT_QKV, O2 = O1 + IT_S, O3 = O2 + IT_S, O4 = O3 + IT_S, O5 = O4 + IT_CU, O6 = O5 + IT_S, O7 = O6 + IT_QKV, O8 = O7 + IT_S, O9 = O8 + 4 * IT_FIN, O10 = O9 + 4 * IT_FOUT;
    for (int it = gw; it < O10; it += NGW) {
        Job jb;
        if (it < O1)      jb = Job{P.in[I_AWQKV], Wb + W_AQKV, P.in[I_LNMIX], DM, QKVD, 0, QKVD, QKVD, 1, 0, 0};
        else if (it < O2) jb = Job{P.in[I_AWO], Wb + W_AWO, nullptr, DM, DM, 0, DM, DM, 1, 0, O1};
        else if (it < O3) jb = Job{P.in[I_BW], Wb + W_BW, nullptr, DM, DM, 0, DM, DM, 1, 0, O2};
        else if (it < O4) jb = Job{P.in[I_CWIN], Wb + W_CIN, P.in[I_LNMIX] + 2 * DM, DM, 3 * DM, 0, DM, DM, 1, 0, O3};
        else if (it < O5) jb = Job{P.in[I_CWIN], Wb + W_CIN, P.in[I_LNMIX] + 2 * DM, DM, 3 * DM, DM, 2 * DM, DM, 2, DM, O4};
        else if (it < O6) jb = Job{P.in[I_CWOUT], Wb + W_COUT, nullptr, DM, DM, 0, DM, DM, 1, 0, O5};
        else if (it < O7) jb = Job{P.in[I_DWQKV], Wb + W_DQKV, P.in[I_LNMIX] + 3 * DM, DM, QKVD, 0, QKVD, QKVD, 1, 0, O6};
        else if (it < O8) jb = Job{P.in[I_DWO], Wb + W_DWO, nullptr, DM, DM, 0, DM, DM, 1, 0, O7};
        else if (it < O9) { const int l = (it - O8) / IT_FIN; jb = Job{P.in[I_FIN] + (size_t)l * DM * 2 * DFF, Wb + W_FIN + (size_t)l * 2 * DFF * DM, P.in[I_LNFFN] + l * DM, DM, 2 * DFF, 0, 2 * DFF, DFF, 2, 0, O8 + l * IT_FIN}; }
        else { const int l = (it - O9) / IT_FOUT; jb = Job{P.in[I_FOUT] + (size_t)l * DFF * DM, Wb + W_FOUT + (size_t)l * DFF * DM, nullptr, DFF, DM, 0, DM, DM, 1, 0, O9 + l * IT_FOUT}; }
        transpose_item(jb, scr, it - jb.item0, lane);
    }
    const int gt = blockIdx.x * 512 + threadIdx.x, ngt = gridDim.x * 512;
    { float2* tab = (float2*)(ws + WS_ROPE);
      for (int e = gt; e < 256 * 32; e += ngt) { const int pos = e >> 5, i = e & 31; const double ang = (double)pos * pow(10000.0, -(double)i / 32.0); tab[e] = make_float2((float)cos(ang), (float)sin(ang)); } }
    { u16* fc = (u16*)(ws + WS_FC);
      for (int e = gt; e < 512 * 256; e += ngt) { const int n = e >> 8, c = e & 255, cp = n & 255; float sn, cs; sincospif(2.0f * (float)((c * cp) & 255) / 256.0f, &sn, &cs); fc[e] = f2bf(n < 256 ? cs : -sn); } }
    gen_FA((u16*)(ws + WS_FA_P), P_N1, FA_P_J, FA_P_KK, gt, ngt);
    gen_FA((u16*)(ws + WS_FA_S), S_N1, FA_S_J, FA_S_KK, gt, ngt);
    gen_FB((u16*)(ws + WS_FB_P), P_N2, FB_P_J, FB_P_KK, 1.0f / sqrtf(256.0f * 8208.0f), gt, ngt);
    gen_FB((u16*)(ws + WS_FB_S), S_N2, FB_S_J, FB_S_KK, 1.0f / sqrtf(256.0f * 16400.0f), gt, ngt);
}

template <bool EMBED>
__device__ __forceinline__ void norm_phase(const Params& P, const float* gain, int nks  , int wave_, int lane_) {
    int tid_q = threadIdx.x; asm volatile("" : "+v"(tid_q)); const int lane = tid_q & 63, wave = __builtin_amdgcn_readfirstlane(tid_q >> 6); (void)lane_; (void)wave_;
    LAUNDER_PTR(unsigned char*, ws, P.ws);
    LAUNDER_PTR(float*, outp, P.out); u16* X = (u16*)outp; u16* HB = (u16*)(ws + WS_HB); float* hmeta = (float*)(ws + WS_HMETA);
    const int gw = blockIdx.x * 8 + wave, NGW = gridDim.x * 8;
    LAUNDER_PTR(const float*, gainp, gain);
    f32x4 g[8];
#pragma unroll
    for (int j = 0; j < 8; ++j) g[j] = ((const f32x4*)gainp)[lane + 64 * j];
    for (int r = gw; r < TTOK; r += NGW) {
        f32x4 v[8];
        if (r < TREAL) {
            if (EMBED) { const float* src = r < 16384 ? P.in[I_XP] + (size_t)r * DM : P.in[I_XS] + (size_t)(r - 16384) * DM;
#pragma unroll
                for (int j = 0; j < 8; ++j) v[j] = ((const f32x4*)src)[lane + 64 * j];
                u32x2* hb = (u32x2*)(HB + (size_t)r * DM);
#pragma unroll
                for (int j = 0; j < 8; ++j) { u32x2 w; w.x = pk2(v[j].x, v[j].y); w.y = pk2(v[j].z, v[j].w); hb[lane + 64 * j] = w;
                    v[j] = (f32x4){bflo(w.x), bfhi(w.x), bflo(w.y), bfhi(w.y)}; }
            } else { const u32x2* hb = (const u32x2*)(HB + (size_t)r * DM);
#pragma unroll
                for (int j = 0; j < 8; ++j) { const u32x2 w = hb[lane + 64 * j]; v[j] = (f32x4){bflo(w.x), bfhi(w.x), bflo(w.y), bfhi(w.y)}; } }
        } else {
            float* hdst = hmeta + (size_t)(r - TREAL) * DM; const float* src = EMBED ? P.in[I_META] + (size_t)((r - TREAL) & 15) * DM : hdst;
#pragma unroll
            for (int j = 0; j < 8; ++j) v[j] = ((const f32x4*)src)[lane + 64 * j];
            if (!EMBED) {
                const float* tp = (const float*)(ws + WS_BIG + BIG_TAILP) + (size_t)(r - TREAL) * DM;
                for (int ks = 0; ks < nks; ++ks) {
#pragma unroll
                    for (int j = 0; j < 8; ++j) v[j] += ((const f32x4*)(tp + (size_t)ks * 64 * DM))[lane + 64 * j]; }
            }
#pragma unroll
            for (int j = 0; j < 8; ++j) ((f32x4*)hdst)[lane + 64 * j] = v[j];
        }
        float ss = 0.f;
#pragma unroll
        for (int j = 0; j < 8; ++j) ss += (v[j].x * v[j].x + v[j].y * v[j].y) + (v[j].z * v[j].z + v[j].w * v[j].w);
        const float rstd = 1.0f / sqrtf(wave_sum(ss) * (1.0f / DM) + EPS);
        u32x2* o = (u32x2*)(X + (size_t)r * DM);
#pragma unroll
        for (int j = 0; j < 8; ++j) { u32x2 w; w.x = pk2(v[j].x * rstd * g[j].x, v[j].y * rstd * g[j].y); w.y = pk2(v[j].z * rstd * g[j].z, v[j].w * rstd * g[j].w); o[lane + 64 * j] = w; }
    }
}

__device__ __forceinline__ void embed_phase(const Params& P) {
    int tid_q = threadIdx.x; asm volatile("" : "+v"(tid_q)); const int lane = tid_q & 63, wave = __builtin_amdgcn_readfirstlane(tid_q >> 6);
    LAUNDER_PTR(unsigned char*, ws, P.ws);
    u16* HB = (u16*)(ws + WS_HB); float* hmeta = (float*)(ws + WS_HMETA); float* rstdp = (float*)(ws + WS_BIG + BIG_RSTD);
    const int gw = blockIdx.x * 8 + wave, NGW = gridDim.x * 8;
    for (int r = gw; r < TTOK; r += NGW) {
        const float* src = r < 16384 ? P.in[I_XP] + (size_t)r * DM : r < TREAL ? P.in[I_XS] + (size_t)(r - 16384) * DM : P.in[I_META] + (size_t)((r - TREAL) & 15) * DM;
        f32x4 v[8]; float ss = 0.f;
#pragma unroll
        for (int j = 0; j < 8; ++j) v[j] = ((const f32x4*)src)[lane + 64 * j];
        if (r >= TREAL) {
#pragma unroll
            for (int j = 0; j < 8; ++j) ((f32x4*)(hmeta + (size_t)(r - TREAL) * DM))[lane + 64 * j] = v[j];
        }
        u32x2* hb = (u32x2*)(HB + (size_t)r * DM);
#pragma unroll
        for (int j = 0; j < 8; ++j) { u32x2 w; w.x = pk2(v[j].x, v[j].y); w.y = pk2(v[j].z, v[j].w); hb[lane + 64 * j] = w;
            ss += (v[j].x * v[j].x + v[j].y * v[j].y) + (v[j].z * v[j].z + v[j].w * v[j].w); }
        const float rstd = 1.0f / sqrtf(wave_sum(ss) * (1.0f / DM) + EPS);
        if (lane == 0) rstdp[r] = rstd;
    }
}
__device__ __forceinline__ void stats_phase(const Params& P, int nks) {
    int tid_q = threadIdx.x; asm volatile("" : "+v"(tid_q)); const int lane = tid_q & 63, wave = __builtin_amdgcn_readfirstlane(tid_q >> 6);
    LAUNDER_PTR(unsigned char*, ws, P.ws);
    u16* HB = (u16*)(ws + WS_HB); float* hmeta = (float*)(ws + WS_HMETA); float* rstdp = (float*)(ws + WS_BIG + BIG_RSTD); const float* SS = (const float*)(ws + WS_BIG + BIG_SS);
    for (int r = blockIdx.x * 512 + tid_q; r < TREAL; r += gridDim.x * 512) {
        float s = 0.f, pv[32];
#pragma unroll
        for (int j = 0; j < 32; ++j) pv[j] = SS[(size_t)j * TREAL + r];
        __builtin_amdgcn_sched_barrier(0);
#pragma unroll
        for (int j = 0; j < 32; j += 4) s += (pv[j] + pv[j + 1]) + (pv[j + 2] + pv[j + 3]);
        rstdp[r] = 1.0f / sqrtf(s * (1.0f / DM) + EPS);
    }
    const int gw = blockIdx.x * 8 + wave;
    const int mrow = (int)(gridDim.x * 8) - 1 - gw;
    if (mrow < NSEQ * NMETA) {
        float* hrow = hmeta + (size_t)mrow * DM; const float* tp = (const float*)(ws + WS_BIG + BIG_TAILP) + (size_t)mrow * DM;
        f32x4 v[8]; float ss = 0.f;
#pragma unroll
        for (int j = 0; j < 8; ++j) v[j] = ((const f32x4*)hrow)[lane + 64 * j];
        for (int ks = 0; ks < nks; ++ks) {
#pragma unroll
            for (int j = 0; j < 8; ++j) v[j] += ((const f32x4*)(tp + (size_t)ks * 64 * DM))[lane + 64 * j]; }
        u32x2* hb = (u32x2*)(HB + (size_t)(TREAL + mrow) * DM);
#pragma unroll
        for (int j = 0; j < 8; ++j) { ((f32x4*)hrow)[lane + 64 * j] = v[j]; u32x2 w; w.x = pk2(v[j].x, v[j].y); w.y = pk2(v[j].z, v[j].w); hb[lane + 64 * j] = w;
            ss += (v[j].x * v[j].x + v[j].y * v[j].y) + (v[j].z * v[j].z + v[j].w * v[j].w); }
        const float rstd = 1.0f / sqrtf(wave_sum(ss) * (1.0f / DM) + EPS);
        if (lane == 0) rstdp[TREAL + mrow] = rstd;
    }
}

__device__ __forceinline__ size_t kc_off(int s, int kvh, int lrow) { return ((size_t)seq_K0(s) * 4 + (size_t)kvh * (64 + seq_S(s)) + lrow) * HD; }
template <bool ROPE>
__device__ __forceinline__ void qkprep_phase(const Params& P, const float* qgain, const float* kgain, int wave_, int lane_) {
    int tid_q = threadIdx.x; asm volatile("" : "+v"(tid_q)); const int lane = tid_q & 63, wave = __builtin_amdgcn_readfirstlane(tid_q >> 6); (void)lane_; (void)wave_;
    LAUNDER_PTR(unsigned char*, ws, P.ws);
    u16* QKV = (u16*)(ws + WS_BIG + BIG_QKV); u16* Kc = (u16*)(ws + WS_BIG + BIG_KC); u16* Vc = (u16*)(ws + WS_BIG + BIG_VC);
    const float2* tab = (const float2*)(ws + WS_ROPE);
    const int gw = blockIdx.x * 8 + wave, NGW = gridDim.x * 8;
    const int li = lane & 15, hg = lane >> 4;
    float qg[8], kg[8];
#pragma unroll
    for (int e = 0; e < 8; ++e) { qg[e] = qgain[8 * li + e]; kg[e] = kgain[8 * li + e]; }
    __syncthreads();
#define QK_GLD(dst_, ptr_) asm volatile("global_load_dwordx4 %0, %1, off" : "=v"(dst_) : "v"(ptr_) : "memory")
#define QK_ROWINFO(r_, krow_, rowpos_, colpos_, s_) do { if ((r_) < TREAL) { s_ = (r_) < 8192 ? 0 : (r_) < 16384 ? 1 : (r_) < 32768 ? 2 : 3; const int p_ = (r_) - seq_R0(s_); krow_ = 64 + p_; rowpos_ = p_ >> 6; colpos_ = p_ & 63; } \
        else { const int m_ = (r_) - TREAL; s_ = m_ >> 4; krow_ = m_ & 15; rowpos_ = 0; colpos_ = 0; } } while (0)
#define QK_LOADROW(buf_, tb_, r_) do { int kr_, rp_, cp_, s2_; QK_ROWINFO(r_, kr_, rp_, cp_, s2_); (void)kr_; (void)s2_; const u16* q_ = QKV + (size_t)(r_) * QKVD; \
        _Pragma("unroll") for (int it = 0; it < 5; ++it) QK_GLD(buf_[it], q_ + (it * 4 + hg) * HD + 8 * li); QK_GLD(buf_[5], q_ + 2560 + 8 * lane); \
        if (ROPE) { const int pos_ = (li & 8) ? cp_ : rp_; const float2* t_ = tab + pos_ * 32 + 8 * (li & 3); _Pragma("unroll") for (int e = 0; e < 4; ++e) QK_GLD(tb_[e], t_ + 2 * e); } } while (0)
    u32x4 cb[6], nb[6], ct[4], nt[4];
#define QK_ROW(CB, CT, NB, NT, WAIT0) do { \
        const int rn = r + NGW; \
        if (WAIT0) asm volatile("s_waitcnt vmcnt(0)" ::: "memory"); else asm volatile("s_waitcnt vmcnt(6)" ::: "memory");     \
        _Pragma("unroll") for (int i = 0; i < 6; ++i) asm volatile("" : "+v"(CB[i])); \
        if (ROPE) { _Pragma("unroll") for (int i = 0; i < 4; ++i) asm volatile("" : "+v"(CT[i])); } \
        if (rn < TTOK) QK_LOADROW(NB, NT, rn); \
        int krow, rowpos, colpos, s; QK_ROWINFO(r, krow, rowpos, colpos, s); (void)rowpos; (void)colpos; \
        u16* qrow = QKV + (size_t)r * QKVD; \
        float cs[8], sn[8]; \
        if (ROPE) { _Pragma("unroll") for (int e = 0; e < 4; ++e) { cs[2 * e] = __uint_as_float(CT[e].x); sn[2 * e] = __uint_as_float(CT[e].y); cs[2 * e + 1] = __uint_as_float(CT[e].z); sn[2 * e + 1] = __uint_as_float(CT[e].w); } } \
        _Pragma("unroll") for (int it = 0; it < 5; ++it) { \
            u16* ptr = qrow + (it * 4 + hg) * HD + 8 * li; \
            const u32x4 w = CB[it]; \
            float x[8] = {bflo(w.x), bfhi(w.x), bflo(w.y), bfhi(w.y), bflo(w.z), bfhi(w.z), bflo(w.w), bfhi(w.w)}; \
            float ss = 0.f; \
            _Pragma("unroll") for (int e = 0; e < 8; ++e) ss += x[e] * x[e]; \
            ss += swz_xor<1>(ss); ss += swz_xor<2>(ss); ss += swz_xor<4>(ss); ss += swz_xor<8>(ss); \
            const float rs = 1.0f / sqrtf(ss * (1.0f / HD) + EPS); \
            float y[8]; \
            _Pragma("unroll") for (int e = 0; e < 8; ++e) y[e] = x[e] * rs * (it < 4 ? qg[e] : kg[e]); \
            if (ROPE) { _Pragma("unroll") for (int e = 0; e < 8; ++e) { const float yp = swz_xor<4>(y[e]); y[e] = (li & 4) ? (yp * sn[e] + y[e] * cs[e]) : (y[e] * cs[e] - yp * sn[e]); } } \
            u32x4 o; o.x = pk2(y[0], y[1]); o.y = pk2(y[2], y[3]); o.z = pk2(y[4], y[5]); o.w = pk2(y[6], y[7]); \
            if (it < 4) *(u32x4*)ptr = o; \
            else *(u32x4*)(Kc + kc_off(s, hg, krow) + 8 * li) = o; \
        } \
        *(u32x4*)(Vc + kc_off(s, lane >> 4, krow) + 8 * (lane & 15)) = CB[5]; \
    } while (0)
    int r = gw;
    if (r < TTOK) { QK_LOADROW(cb, ct, r); QK_ROW(cb, ct, nb, nt, true); r += NGW; }
    for (; r < TTOK; r += 2 * NGW) {
        QK_ROW(nb, nt, cb, ct, false);
        r += NGW; if (r >= TTOK) break;
        QK_ROW(cb, ct, nb, nt, false);
        r -= NGW;
    }
#undef QK_ROW
    for (int mrow = gw; mrow < 4 * NMETA; mrow += NGW) { const int s = mrow >> 4, mi = mrow & 15; const u32x4 z = {0u, 0u, 0u, 0u};
#pragma unroll
        for (int q = 0; q < 3; ++q) { const size_t pr = kc_off(s, lane >> 4, 16 + 3 * mi + q) + 8 * (lane & 15); *(u32x4*)(Kc + pr) = z; *(u32x4*)(Vc + pr) = z; } }
#undef QK_GLD
#undef QK_ROWINFO
#undef QK_LOADROW
}

template <int MODE>
__device__ __forceinline__ void attn_phase(const Params& P, const float* sinks, char* lds, int wave_, int lane_) {
    int tid_q = threadIdx.x; asm volatile("" : "+v"(tid_q)); const int lane = tid_q & 63, wave = __builtin_amdgcn_readfirstlane(tid_q >> 6); (void)lane_; (void)wave_;
    LAUNDER_PTR(unsigned char*, ws, P.ws);
    const u16* QKV = (const u16*)(ws + WS_BIG + BIG_QKV); const u16* Kc = (const u16*)(ws + WS_BIG + BIG_KC); const u16* Vc = (const u16*)(ws + WS_BIG + BIG_VC);
    LAUNDER_PTR(float*, outp, P.out); u16* X = (u16*)outp;
    const int r32 = lane & 31, hi = lane >> 5, G = gridDim.x;
    constexpr int NITEMS = (MODE == 0) ? 3072 + 240 : 3088;
    for (int e = blockIdx.x; e < NITEMS; e += G) {
        int s, kvh, hgp = 0, qb = 0, chunk = 0, y = 0; bool meta = false;
        if (e < 2048) { const int k = e >> 8, bb = e & 255, x = bb & 7, i = bb >> 3, id = i + 32 * k; s = 2 + (x >> 2); kvh = x & 3; hgp = id >> 6; qb = id & 63; }
        else if (e < 3072) { const int e2 = e - 2048, k = e2 >> 8, bb = e2 & 255, x = bb & 7, i = bb >> 3, id = i + 32 * k; s = x >> 2; kvh = x & 3; hgp = id >> 5; qb = id & 31; }
        else { const int e3 = e - 3072; if (MODE == 0) { y = e3 / 15; chunk = e3 - 15 * y; } else y = e3; const int x = y & 7; s = (y < 8 ? 0 : 2) + (x >> 2); kvh = x & 3; meta = true; }
        const int S = seq_S(s);
        const u16* Kh = Kc + kc_off(s, kvh, 0); const u16* Vh = Vc + kc_off(s, kvh, 0);
        const u16* Qw; u16* Ow; int NT, ktlo = 0, tq = 0, head; bool store = true, mask0 = true; float* po = nullptr; float* pml = nullptr;
        if (!meta) {
            head = kvh * 4 + hgp; const int row = seq_R0(s) + 256 * qb + 32 * wave;
            Qw = QKV + (size_t)(row + r32) * QKVD + head * HD + hi * 8; Ow = X + (size_t)row * DM + head * HD;
            if (MODE == 0) NT = 1 + S / 64;
            else { const int t0 = 4 * qb - 2 < 0 ? 0 : 4 * qb - 2, t1 = 4 * qb + 5 > S / 64 - 1 ? S / 64 - 1 : 4 * qb + 5; ktlo = t0; NT = 2 + t1 - t0; tq = 256 * qb + 32 * wave + r32; }
        } else {
            const int w1 = wave & 1, gl = r32 >> 4, mi = r32 & 15; head = kvh * 4 + 2 * w1 + gl; store = wave < 2;
            Qw = QKV + (size_t)(MROW0 + NMETA * s + mi) * QKVD + head * HD + hi * 8; Ow = X + (size_t)(MROW0 + NMETA * s) * DM + (kvh * 4 + 2 * w1) * HD;
            if (MODE == 0) {
                if (s < 2) { ktlo = chunk < 12 ? 9 * chunk : 108 + 7 * (chunk - 12); NT = chunk < 12 ? 9 : 7; } else { ktlo = 17 * chunk; NT = chunk < 14 ? 17 : 19; }
                mask0 = (chunk == 0);
                po = (float*)(ws + WS_BIG + BIG_PO) + ((size_t)(y * 15 + chunk) * 64 + 32 * w1) * 128; pml = (float*)(ws + WS_BIG + BIG_PML) + ((size_t)(y * 15 + chunk) * 64 + 32 * w1) * 2;
            } else { NT = 3; tq = 112 + mi; }
        }
        float slopeS = 0.f, sinkL2 = 0.f;
        if (MODE == 1) { slopeS = exp2f(-0.5f * (float)(head + 1)) * (1.0f / att::SCALE); slopeS = __int_as_float(__builtin_amdgcn_readfirstlane(__float_as_int(slopeS)));
            sinkL2 = sinks[head] * 1.4426950408889634f; }
        att::attn_item<MODE>(Qw, Kh, Vh, Ow, meta, store, NT, ktlo, tq, slopeS, sinkL2, lds, mask0, po, pml);
    }
}
__device__ __forceinline__ void metacombine_phase(const Params& P) {
    int tid_q = threadIdx.x; asm volatile("" : "+v"(tid_q)); const int lane = tid_q & 63, wave = __builtin_amdgcn_readfirstlane(tid_q >> 6);
    LAUNDER_PTR(unsigned char*, ws, P.ws);
    const float* PO = (const float*)(ws + WS_BIG + BIG_PO); const float* PML = (const float*)(ws + WS_BIG + BIG_PML); LAUNDER_PTR(float*, outp, P.out); u16* X = (u16*)outp;
    constexpr float C = att::SCALE * 1.4426950408889634f;
    for (int it = blockIdx.x * 8 + wave; it < 16 * 64; it += gridDim.x * 8) {
        const int y = it >> 6, rr = it & 63, x = y & 7, s = (y < 8 ? 0 : 2) + (x >> 2), kvh = x & 3, head = kvh * 4 + (rr >> 4), mi = rr & 15;
        float mc[15], lc[15], M = -3e38f;
#pragma unroll
        for (int c = 0; c < 15; ++c) { const float2 v = *(const float2*)(PML + ((size_t)(y * 15 + c) * 64 + rr) * 2); mc[c] = v.x; lc[c] = v.y; M = fmaxf(M, v.x); }
        float L = 0.f, o0 = 0.f, o1 = 0.f;
#pragma unroll
        for (int c = 0; c < 15; ++c) { const float w = __builtin_amdgcn_exp2f((mc[c] - M) * C); L += w * lc[c];
            const float2 ov = *(const float2*)(PO + ((size_t)(y * 15 + c) * 64 + rr) * 128 + 2 * lane); o0 += w * ov.x; o1 += w * ov.y; }
        const float rl = 1.0f / L;
        *(unsigned*)(X + (size_t)(MROW0 + NMETA * s + mi) * DM + head * HD + 2 * lane) = pk2(o0 * rl, o1 * rl);
    }
}

constexpr int DFT_RS = 256;
__device__ __forceinline__ int dft_swz(int j) { return (j & 3) | ((j >> 1) & 4); }
template <int STEP, int N1, int N2, int KS  , int NMB  >
__device__ __forceinline__ void dft_run(const Params& P, size_t f_off, int s0, int boff  , LAS unsigned char* lds, int wave_, int lane_) {
    (void)lane_; (void)wave_;
    LAUNDER_PTR(unsigned char*, ws, P.ws); const u16* F = (const u16*)(ws + f_off);
    constexpr int L = N1 * N2, JP = KS * 32, J = STEP == 0 ? 2 * N1 : 2 * N2, KK = STEP == 0 ? 2 * N1 : N2, NB = STEP == 0 ? N2 : N1  ;
    const u16* Z = (const u16*)(ws + WS_BIG + BIG_Z); u16* Y = (u16*)(ws + WS_BIG + BIG_Y); LAUNDER_PTR(float*, outp, P.out); u16* X = (u16*)outp;
    int tid_l = threadIdx.x; asm volatile("" : "+v"(tid_l));
    const int tid = tid_l, lane = tid_l & 63, wave = __builtin_amdgcn_readfirstlane(tid_l >> 6), fi = tid_l & 15, fg = (tid_l & 63) >> 4; (void)lane;
    bf16x8 Ff[2][KS];
#pragma unroll
    for (int q = 0; q < 2; ++q)
#pragma unroll
        for (int ks = 0; ks < KS; ++ks) { const int mb = wave + 8 * q; Ff[q][ks] = (mb < NMB) ? *(const bf16x8*)(F + (size_t)(mb * 16 + fi) * JP + ks * 32 + 8 * fg) : (bf16x8){0, 0, 0, 0, 0, 0, 0, 0}; }
    for (int c = tid; c < (JP - J) * 16; c += 512) *(LAS u32x4*)(lds + (J + c / 16) * DFT_RS + (c % 16) * 16) = (u32x4){0u, 0u, 0u, 0u};
    const int trrow = (fi >> 2) + 8 * fg;
    const int trbase = trrow * DFT_RS + (fi & 3) * 8, sw0 = dft_swz(trrow) << 5;
    constexpr int NCH = STEP == 0 ? (J * 16 + 511) / 512 : (N2 * 16 + 511) / 512;
    u32x4 sa[NCH], sb[STEP == 0 ? 1 : NCH];
    const int NIT = 2 * NB * 16;
#define DFT_GLD(dst_, ptr_) asm volatile("global_load_dwordx4 %0, %1, off" : "=v"(dst_) : "v"(ptr_) : "memory")
#define DFT_BAR() do { asm volatile("s_waitcnt lgkmcnt(0)" ::: "memory"); __builtin_amdgcn_s_barrier(); } while (0)
    const int nst = 8 * (((wave < NMB && wave * 16 < KK) ? 1 : 0) + ((wave + 8 < NMB && (wave + 8) * 16 < KK) ? 1 : 0));
    int pend = 0;
#define DFT_LOAD(e_) do { const int s_ = s0 + (e_) / (NB * 16), rem_ = (e_) % (NB * 16), beta_ = rem_ >> 4, gh_ = rem_ & 15, colb_ = (gh_ >> 1) * 512 + (gh_ & 1) * 128; \
        _Pragma("unroll") for (int i = 0; i < NCH; ++i) { const int c = tid + 512 * i; \
            if (STEP == 0) { if (c < J * 16) { const int j = c >> 4, ch = c & 15, part = j >= N1, l1 = j - part * N1; DFT_GLD(sa[i], Z + (size_t)rowmap(s_, N2 * l1 + beta_) * 4096 + colb_ + part * 256 + ch * 8); } } \
            else { if (c < N2 * 16) { const int l2 = c >> 4, ch = c & 15; const u16* src = Y + (size_t)(seq_Y0(s_) + beta_ * N2 + l2) * 4096 + colb_ + ch * 8; DFT_GLD(sa[i], src); DFT_GLD(sb[i], src + 256); } } } } while (0)
    __syncthreads();
    int e = (int)((blockIdx.x + (unsigned)boff) % gridDim.x);
    if (e < NIT) DFT_LOAD(e);
    for (; e < NIT; e += gridDim.x) {
        const int s = s0 + e / (NB * 16), rem = e % (NB * 16), beta = rem >> 4, gh = rem & 15, colb = (gh >> 1) * 512 + (gh & 1) * 128;
        DFT_BAR();
        if (pend == 16) asm volatile("s_waitcnt vmcnt(16)" ::: "memory"); else if (pend == 8) asm volatile("s_waitcnt vmcnt(8)" ::: "memory"); else asm volatile("s_waitcnt vmcnt(0)" ::: "memory");
#pragma unroll
        for (int i = 0; i < NCH; ++i) { asm volatile("" : "+v"(sa[i])); if (STEP == 1) asm volatile("" : "+v"(sb[i])); }
        pend = nst;
#pragma unroll
        for (int i = 0; i < NCH; ++i) { const int c = tid + 512 * i;
            if (STEP == 0) { if (c < J * 16) { const int j = c >> 4, ch = c & 15; *(LAS u32x4*)(lds + j * DFT_RS + (((ch >> 1) ^ dft_swz(j)) << 5) + (ch & 1) * 16) = sa[i]; } }
            else if (c < N2 * 16) { const int l2 = c >> 4, ch = c & 15; const u32x4 a = sa[i], b = sb[i];
                float sn, cs; sincospif(2.0f * (float)((beta * l2) % L) / (float)L, &sn, &cs);
                u32x4 ore, oim;
#define TW(F_) { const float r0 = bflo(a.F_), r1 = bfhi(a.F_), i0 = bflo(b.F_), i1 = bfhi(b.F_); ore.F_ = pk2(r0 * cs + i0 * sn, r1 * cs + i1 * sn); oim.F_ = pk2(i0 * cs - r0 * sn, i1 * cs - r1 * sn); }
                TW(x) TW(y) TW(z) TW(w)
#undef TW
                *(LAS u32x4*)(lds + l2 * DFT_RS + (((ch >> 1) ^ dft_swz(l2)) << 5) + (ch & 1) * 16) = ore; *(LAS u32x4*)(lds + (N2 + l2) * DFT_RS + (((ch >> 1) ^ dft_swz(N2 + l2)) << 5) + (ch & 1) * 16) = oim; } }
        DFT_BAR();
        if (e + (int)gridDim.x < NIT) DFT_LOAD(e + (int)gridDim.x);
#pragma unroll
        for (int q = 0; q < 2; ++q) {
            const int mb = wave + 8 * q;
            if (mb < NMB) {
                f32x4 acc[8];
#pragma unroll
                for (int nb = 0; nb < 8; ++nb) acc[nb] = (f32x4){0.f, 0.f, 0.f, 0.f};
#pragma unroll
                for (int ks = 0; ks < KS; ++ks) {
                    LAS unsigned char* ap = lds + trbase + ks * 32 * DFT_RS;
#pragma unroll
                    for (int h = 0; h < 2; ++h) {
                        s16x4 a0[4], a1[4];
#pragma unroll
                        for (int n4 = 0; n4 < 4; ++n4) { const int nb = 4 * h + n4; a0[n4] = __builtin_amdgcn_ds_read_tr16_b64_v4i16((LAS s16x4*)(ap + ((nb * 32) ^ sw0))); a1[n4] = __builtin_amdgcn_ds_read_tr16_b64_v4i16((LAS s16x4*)(ap + ((nb * 32) ^ sw0) + 4 * DFT_RS)); }
#pragma unroll
                        for (int n4 = 0; n4 < 4; ++n4) { const int nb = 4 * h + n4; const bf16x8 af = {a0[n4][0], a0[n4][1], a0[n4][2], a0[n4][3], a1[n4][0], a1[n4][1], a1[n4][2], a1[n4][3]};
                            acc[nb] = __builtin_amdgcn_mfma_f32_16x16x32_bf16(af, Ff[q][ks], acc[nb], 0, 0, 0); }
                    }
                }
                const int kk = mb * 16 + fi;
                if (kk < KK) {
                    u16* dst;
                    if (STEP == 0) { const int part = kk >= N1, k1 = kk - part * N1; dst = Y + (size_t)(seq_Y0(s) + k1 * N2 + beta) * 4096 + colb + part * 256 + 4 * fg; }
                    else { dst = X + (size_t)rowmap(s, beta + N1 * kk) * DM + (gh >> 1) * 256 + (gh & 1) * 128 + 4 * fg; }
#pragma unroll
                    for (int nb = 0; nb < 8; ++nb) { u32x2 w; w.x = pk2(acc[nb][0], acc[nb][1]); w.y = pk2(acc[nb][2], acc[nb][3]); *(u32x2*)(dst + nb * 16) = w; }
                }
            }
        }
    }
#undef DFT_LOAD
#undef DFT_GLD
#undef DFT_BAR
    __syncthreads();
}

__device__ __forceinline__ void conv_phase(const Params& P, const float* cw  , int wave_, int lane_) {
    int tid_q = threadIdx.x; asm volatile("" : "+v"(tid_q)); const int lane = tid_q & 63, wave = __builtin_amdgcn_readfirstlane(tid_q >> 6); (void)lane_; (void)wave_;
    LAUNDER_PTR(unsigned char*, ws, P.ws);
    const u16* Bb = (const u16*)(ws + WS_BIG + BIG_BB); const u16* Gb = (const u16*)(ws + WS_BIG + BIG_GB); LAUNDER_PTR(float*, outp, P.out); u16* X = (u16*)outp;
    const int gw = blockIdx.x * 8 + wave, NGW = gridDim.x * 8;
    f32x4 w0[4][2], w1[4][2], w2[4][2];
#pragma unroll
    for (int j = 0; j < 4; ++j)
#pragma unroll
        for (int h = 0; h < 2; ++h) { const int c = 8 * lane + 512 * j + 4 * h; w0[j][h] = *(const f32x4*)(cw + c); w1[j][h] = *(const f32x4*)(cw + DM + c); w2[j][h] = *(const f32x4*)(cw + 2 * DM + c); }
    const int per = (TTOK + NGW - 1) / NGW, rbeg = gw * per, rend = rbeg + per < TTOK ? rbeg + per : TTOK;
    for (int r = rbeg; r < rend; ++r) {
        int prev, next;
        if (r < TREAL) { const int s = r < 8192 ? 0 : r < 16384 ? 1 : r < 32768 ? 2 : 3; const int p = r - seq_R0(s); prev = p > 0 ? r - 1 : MROW0 + NMETA * s + 15; next = p < seq_S(s) - 1 ? r + 1 : -1; }
        else { const int m = r - TREAL, s = m >> 4, i = m & 15; prev = i > 0 ? r - 1 : -1; next = i < 15 ? r + 1 : seq_R0(s); }
        u32x4 bv[4], g0[4], g1[4], g2[4]; const u32x4 zero = {0u, 0u, 0u, 0u};
#pragma unroll
        for (int j = 0; j < 4; ++j) { const int c = 8 * lane + 512 * j;
            bv[j] = *(const u32x4*)(Bb + (size_t)r * DM + c); g1[j] = *(const u32x4*)(Gb + (size_t)r * DM + c);
            g0[j] = prev >= 0 ? *(const u32x4*)(Gb + (size_t)prev * DM + c) : zero; g2[j] = next >= 0 ? *(const u32x4*)(Gb + (size_t)next * DM + c) : zero; }
#pragma unroll
        for (int j = 0; j < 4; ++j) { const int c = 8 * lane + 512 * j; u32x4 o;
#define CV(F_, H, I0, I1) o.F_ = pk2(bflo(bv[j].F_) * (w0[j][H][I0] * bflo(g0[j].F_) + w1[j][H][I0] * bflo(g1[j].F_) + w2[j][H][I0] * bflo(g2[j].F_)), bfhi(bv[j].F_) * (w0[j][H][I1] * bfhi(g0[j].F_) + w1[j][H][I1] * bfhi(g1[j].F_) + w2[j][H][I1] * bfhi(g2[j].F_)));
            CV(x, 0, 0, 1) CV(y, 0, 2, 3) CV(z, 1, 0, 1) CV(w, 1, 2, 3)
#undef CV
            *(u32x4*)(X + (size_t)r * DM + c) = o; }
    }
}

template <int KIND, int KS = 8>
__device__ __forceinline__ void thin_meta_gemm(const Params& P, size_t w_off, int N, LAS unsigned char* lds) {
    int tid_l = threadIdx.x; asm volatile("" : "+v"(tid_l));
    const int tid = tid_l, lane = tid & 63, wave = __builtin_amdgcn_readfirstlane(tid >> 6), fi = lane & 15, fg = lane >> 4, k0 = wave * (KS * 32);
    constexpr int LDK = KS * 256;
    LAUNDER_PTR(unsigned char*, ws, P.ws); LAUNDER_PTR(float*, outp, P.out);
    const u16* A = (KIND != 3) ? (const u16*)(ws + WS_HB) + (size_t)TREAL * DM : (KS == 8) ? (const u16*)outp + (size_t)TREAL * DM : (const u16*)(ws + WS_BIG) + (size_t)TREAL * DFF;
    const u16* Bt = (const u16*)(ws + WS_W) + w_off; const float* rstd = (const float*)(ws + WS_BIG + BIG_RSTD) + TREAL;
    u16* BIG = (u16*)(ws + WS_BIG);
    LAS float* red = (LAS float*)lds;
    for (int blk = blockIdx.x; blk < N / 16; blk += gridDim.x) {
        const int c0 = blk * 16;
        const int frow = tid & 63, fp = tid >> 6; float rs_pre = 1.0f; f32x2 h_pre = {0.f, 0.f};
        if (KIND != 3) rs_pre = rstd[frow]; else h_pre = *(const f32x2*)((const float*)(ws + WS_HMETA) + (size_t)frow * DM + c0 + 2 * fp);
        f32x4 acc[4];
#pragma unroll
        for (int nbk = 0; nbk < 4; ++nbk) acc[nbk] = (f32x4){0.f, 0.f, 0.f, 0.f};
#pragma unroll
        for (int ks = 0; ks < KS; ++ks) {
            const bf16x8 wf = *(const bf16x8*)(Bt + (size_t)(c0 + fi) * LDK + k0 + ks * 32 + 8 * fg);
#pragma unroll
            for (int nbk = 0; nbk < 4; ++nbk) { const bf16x8 af = *(const bf16x8*)(A + (size_t)(nbk * 16 + fi) * LDK + k0 + ks * 32 + 8 * fg);
                acc[nbk] = __builtin_amdgcn_mfma_f32_16x16x32_bf16(wf, af, acc[nbk], 0, 0, 0); }
        }
#pragma unroll
        for (int nbk = 0; nbk < 4; ++nbk)
#pragma unroll
            for (int rg = 0; rg < 4; ++rg) red[((wave * 4 + nbk) * 4 + rg) * 64 + lane] = acc[nbk][rg];
        __syncthreads();
        { const int row = tid & 63, p = tid >> 6, l = (p >> 1) * 16 + (row & 15), nbk = row >> 4, rg = 2 * (p & 1);
          float v0 = 0.f, v1 = 0.f;
#pragma unroll
          for (int w = 0; w < 8; ++w) { v0 += red[((w * 4 + nbk) * 4 + rg) * 64 + l]; v1 += red[((w * 4 + nbk) * 4 + rg + 1) * 64 + l]; }
          const float rs = rs_pre; const int c = c0 + 2 * p; const size_t orow = (size_t)(TREAL + row);
          if (KIND == 0) *(unsigned*)(BIG + orow * QKVD + c) = pk2(v0 * rs, v1 * rs);
          else if (KIND == 3) { float* hm = (float*)(ws + WS_HMETA) + (size_t)row * DM + c; const f32x2 h = h_pre; *(f32x2*)hm = (f32x2){h.x + v0, h.y + v1}; }
          else {
              const bool plain = (KIND == 1) && c < DM; const int cc = (KIND == 1) ? c - DM : c, cl = cc & 255;
              const int o = (cc >> 8) * 128 + ((cl >> 5) & 3) * 32 + ((cl >> 3) & 3) * 8 + (cl >> 7) * 4 + ((cl >> 1) & 3);
              if (plain) *(unsigned*)(BIG + orow * DM + c) = pk2(v0 * rs, v1 * rs);
              else if (KIND == 1) { const float gq = v0 * v1 * rs * rs; ((u16*)(ws + WS_BIG + BIG_GB))[orow * DM + o] = (u16)(pk2(gq, gq) & 0xffffu); }
              else { const float gs = v0 * rs, us = v1 * rs, sv = gs * us * __builtin_amdgcn_rcpf(1.0f + __builtin_amdgcn_exp2f(-1.4426950408889634f * gs)); BIG[orow * DFF + o] = (u16)(pk2(sv, sv) & 0xffffu); }
          } }
        __syncthreads();
    }
}

constexpr int PH_PER_LAYER = 9, N_PHASES = 1 + 4 * PH_PER_LAYER;
#ifndef PH_EN
#define PH_EN 0xffffffffu
#endif
#define EN(k) (((PH_EN) >> (k)) & 1u)
#define RUN(p) (lo <= (p) && (p) < hi)
#ifndef REP_MASK
#define REP_MASK 0u
#endif
#define REP(k) (((REP_MASK) >> (k)) & 1u)
#define SEAM(p) do { if ((p) + 1 < hi) { XcdBarrier b2_ = bar; { GAS unsigned* g_ = (GAS unsigned*)b2_.bar; asm volatile("" : "+s"(g_)); b2_.bar = (unsigned*)g_; } xcd_barrier(b2_); if (REP(15)) xcd_barrier(b2_); } } while (0)
#define SITE_PTRS LAUNDER_PTR(unsigned char*, ws, P.ws); LAUNDER_PTR(float*, outp, P.out); u16* Wb = (u16*)(ws + WS_W); u16* X = (u16*)outp; u16* BIG = (u16*)(ws + WS_BIG); (void)Wb; (void)X; (void)BIG
template <int layer>
__device__ __forceinline__ void run_layer(const Params& P, LAS unsigned char* lds, unsigned char* lds_raw, const XcdBarrier& bar, int lo, int hi, int wave, int lane) {

        const int pb = 1 + layer * PH_PER_LAYER;
        if (EN(1) && RUN(pb + 0)) {
            if (layer == 0) embed_phase(P);
            else if (layer == 1) norm_phase<false>(P, P.in[I_LNMIX] + layer * DM, 0, wave, lane);
            else { stats_phase(P, 0); if (REP(1)) stats_phase(P, 0); }
            SEAM(pb + 0); }
        if (RUN(pb + 1)) {
            if (EN(2) && (layer == 0 || layer == 3)) { thin_meta_gemm<0>(P, layer == 0 ? W_AQKV : W_DQKV, QKVD, lds);
                SITE_PTRS; pg8::Gemm g{(const u16*)(ws + WS_HB), Wb + (layer == 0 ? W_AQKV : W_DQKV), TREAL, QKVD, DM, DM}; pg8::StaticOrder S; S.init(TREAL, QKVD, gridDim.x, blockIdx.x, DM); pg8::EpiPlain E{BIG, QKVD, (const float*)(ws + WS_BIG + BIG_RSTD)};
                pg8::gemm_phase<pg8::EpiPlain, pg8::StaticOrder, true, true>(lds, g, S, E); if (REP(2)) pg8::gemm_phase<pg8::EpiPlain, pg8::StaticOrder, true, true>(lds, g, S, E); }
            else if (EN(2) && layer == 1) { SITE_PTRS; pg8::Gemm g{X, (const u16*)(ws + WS_FC), TTOK * 8, 512, 256, 256}; pg8::StaticOrder S; S.init(TTOK * 8, 512, gridDim.x, blockIdx.x, 256); pg8::EpiPlain E{BIG, 512, nullptr};
                pg8::gemm_phase<pg8::EpiPlain, pg8::StaticOrder, true, true>(lds, g, S, E); if (REP(3)) pg8::gemm_phase<pg8::EpiPlain, pg8::StaticOrder, true, true>(lds, g, S, E); }
            else if (EN(3)) { thin_meta_gemm<1>(P, W_CIN, 3 * DM, lds);
                SITE_PTRS; pg8::Gemm g{(const u16*)(ws + WS_HB), Wb + W_CIN, TREAL, 3 * DM, DM, DM}; pg8::StaticOrder S; S.init(TREAL, 3 * DM, gridDim.x, blockIdx.x, DM); pg8::EpiCin E{BIG, (u16*)(ws + WS_BIG + BIG_GB), (const float*)(ws + WS_BIG + BIG_RSTD)};
                pg8::gemm_phase<pg8::EpiCin, pg8::StaticOrder, true, true>(lds, g, S, E); if (REP(4)) pg8::gemm_phase<pg8::EpiCin, pg8::StaticOrder, true, true>(lds, g, S, E); }
            SEAM(pb + 1);
        }
        if (RUN(pb + 2)) {
            if (EN(4) && layer == 0) qkprep_phase<true>(P, P.in[I_AQN], P.in[I_AKN], wave, lane);
            else if (EN(4) && layer == 3) qkprep_phase<false>(P, P.in[I_DQN], P.in[I_DKN], wave, lane);
            else if (EN(5) && layer == 1) { dft_run<0, P_N1, P_N2, FA_P_J / 32, FA_P_KK / 16>(P, WS_FA_P, 0, 0, lds, wave, lane);
                                   dft_run<0, S_N1, S_N2, FA_S_J / 32, FA_S_KK / 16>(P, WS_FA_S, 2, (int)(gridDim.x - (2 * P_N2 * 16) % gridDim.x), lds, wave, lane);
                if (REP(5)) { dft_run<0, P_N1, P_N2, FA_P_J / 32, FA_P_KK / 16>(P, WS_FA_P, 0, 0, lds, wave, lane); dft_run<0, S_N1, S_N2, FA_S_J / 32, FA_S_KK / 16>(P, WS_FA_S, 2, (int)(gridDim.x - (2 * P_N2 * 16) % gridDim.x), lds, wave, lane); } }
            else if (EN(6)) { conv_phase(P, P.in[I_CCONV], wave, lane); if (REP(6)) conv_phase(P, P.in[I_CCONV], wave, lane); }
            SEAM(pb + 2);
        }
        if (RUN(pb + 3)) {
            if (EN(7) && layer == 0) { attn_phase<0>(P, nullptr, (char*)lds_raw, wave, lane); if (REP(7)) attn_phase<0>(P, nullptr, (char*)lds_raw, wave, lane); }
            else if (EN(8) && layer == 3) { attn_phase<1>(P, P.in[I_DSINK], (char*)lds_raw, wave, lane); if (REP(8)) attn_phase<1>(P, P.in[I_DSINK], (char*)lds_raw, wave, lane); }
            else if (EN(9) && layer == 1) { dft_run<1, P_N1, P_N2, FB_P_J / 32, FB_P_KK / 16>(P, WS_FB_P, 0, 0, lds, wave, lane);
                                   dft_run<1, S_N1, S_N2, FB_S_J / 32, FB_S_KK / 16>(P, WS_FB_S, 2, (int)(gridDim.x - (2 * P_N1 * 16) % gridDim.x), lds, wave, lane);
                if (REP(9)) { dft_run<1, P_N1, P_N2, FB_P_J / 32, FB_P_KK / 16>(P, WS_FB_P, 0, 0, lds, wave, lane); dft_run<1, S_N1, S_N2, FB_S_J / 32, FB_S_KK / 16>(P, WS_FB_S, 2, (int)(gridDim.x - (2 * P_N1 * 16) % gridDim.x), lds, wave, lane); } }
            if (layer != 2) SEAM(pb + 3);
        }
        if (layer == 0 && EN(7) && RUN(pb + 4)) { metacombine_phase(P); SEAM(pb + 4); }
        if (EN(10) && RUN(pb + 5)) {
            SITE_PTRS;
            const size_t wo = layer == 0 ? W_AWO : layer == 1 ? W_BW : layer == 2 ? W_COUT : W_DWO;
            if (layer < 3) thin_meta_gemm<3, 8>(P, wo, DM, lds);
            { pg8::Gemm g{X, Wb + wo, TREAL, DM, DM, DM}; pg8::StaticOrder S; S.init(TREAL, DM, gridDim.x, blockIdx.x, DM); const pg8::EpiResidB E{(u16*)(ws + WS_HB), (float*)(ws + WS_BIG + BIG_SS)};
              pg8::gemm_phase<pg8::EpiResidB, pg8::StaticOrder, true, true>(lds, g, S, E); }
            if (REP(10)) { pg8::Gemm g{X, Wb + wo, TREAL, DM, DM, DM}; pg8::StaticOrder S; S.init(TREAL, DM, gridDim.x, blockIdx.x, DM); pg8::EpiPlain E{(u16*)(ws + WS_BIG + 600 * MiB), DM, nullptr};
              pg8::gemm_phase<pg8::EpiPlain, pg8::StaticOrder, true, true>(lds, g, S, E); }
            SEAM(pb + 5);
        }
        if (EN(1) && RUN(pb + 6)) { stats_phase(P, 0); if (REP(1)) stats_phase(P, 0); SEAM(pb + 6); }
        if (EN(11) && RUN(pb + 7)) {
            SITE_PTRS;
            constexpr int MF = TREAL;
            if (layer < 3) thin_meta_gemm<2>(P, W_FIN + (size_t)layer * 2 * DFF * DM, 2 * DFF, lds);
            pg8::Gemm g{(const u16*)(ws + WS_HB), Wb + W_FIN + (size_t)layer * 2 * DFF * DM, MF, 2 * DFF, DM, DM}; pg8::StaticOrder S; S.init(MF, 2 * DFF, gridDim.x, blockIdx.x, DM); pg8::EpiSwiglu E{BIG, DFF, (const float*)(ws + WS_BIG + BIG_RSTD)};
            pg8::gemm_phase<pg8::EpiSwiglu, pg8::StaticOrder, true, true>(lds, g, S, E); if (REP(11)) pg8::gemm_phase<pg8::EpiSwiglu, pg8::StaticOrder, true, true>(lds, g, S, E); if (REP(16)) { pg8::EpiNone E0; pg8::gemm_phase<pg8::EpiNone, pg8::StaticOrder, true, true>(lds, g, S, E0); }
            SEAM(pb + 7);
        }
        if (EN(12) && RUN(pb + 8)) {
            if (layer < 3) thin_meta_gemm<3, 22>(P, W_FOUT + (size_t)layer * DFF * DM, DM, lds);
            SITE_PTRS;
            { pg8::Gemm g{BIG, Wb + W_FOUT + (size_t)layer * DFF * DM, TREAL, DM, DFF, DFF}; pg8::StaticOrder S; S.init(TREAL, DM, gridDim.x, blockIdx.x, DFF); if (layer < 3) { const pg8::EpiResidB E{(u16*)(ws + WS_HB), layer == 0 ? nullptr : (float*)(ws + WS_BIG + BIG_SS)}; pg8::gemm_phase<pg8::EpiResidB, pg8::StaticOrder, true, true>(lds, g, S, E); }
              else { const pg8::EpiResidFinal E{(const u16*)(ws + WS_HB), outp}; pg8::gemm_phase<pg8::EpiResidFinal, pg8::StaticOrder, true, true>(lds, g, S, E); } }
            if (REP(12)) { pg8::Gemm g{BIG, Wb + W_FOUT + (size_t)layer * DFF * DM, TREAL, DM, DFF, DFF}; pg8::StaticOrder S; S.init(TREAL, DM, gridDim.x, blockIdx.x, DFF); pg8::EpiPlain E{X, DM, nullptr};
              pg8::gemm_phase<pg8::EpiPlain, pg8::StaticOrder, true, true>(lds, g, S, E); }
            SEAM(pb + 8);
        }
    }

__global__ void __launch_bounds__(512, 2) encoder_fwd(Params P) {
    extern __shared__ __attribute__((aligned(16))) unsigned char lds_raw[];
    LAS unsigned char* lds = (LAS unsigned char*)lds_raw;
    const int tid = threadIdx.x; constexpr int lane = 0, wave = 0;
    if (tid < 4) ((LAS unsigned*)(lds + LDS_MISC))[tid] = 0u;
    __syncthreads();
    unsigned* barw = (unsigned*)(P.ws + WS_CTL) + CW_BAR;
    XcdBarrier bar = xcd_barrier_post(barw, (volatile LAS unsigned*)(lds + LDS_MISC));
    const int lo = P.ph_lo, hi = P.ph_hi;

    if (EN(0) && RUN(0)) { prologue_phase(P, lds, wave, lane); if (REP(0)) prologue_phase(P, lds, wave, lane); asm volatile("s_waitcnt vmcnt(0) lgkmcnt(0)" ::: "memory"); __syncthreads(); }

    run_layer<0>(P, lds, lds_raw, bar, lo, hi, wave, lane);
    run_layer<1>(P, lds, lds_raw, bar, lo, hi, wave, lane);
    run_layer<2>(P, lds, lds_raw, bar, lo, hi, wave, lane);
    run_layer<3>(P, lds, lds_raw, bar, lo, hi, wave, lane);
#undef SITE_PTRS
#undef RUN
#undef SEAM
}

#ifndef MK_PER_PHASE
#define MK_PER_PHASE 0
#endif
extern "C" void kernel_launch(void* const* d_in, const int* in_sizes, int n_in, void* d_out, int out_size, void* d_ws, size_t ws_size, hipStream_t stream) {
    static int grid = 0;
    if (grid == 0) {
        if (n_in != 20 || out_size != TREAL * DM || ws_size < WS_END) { fprintf(stderr, "kernel_launch: unexpected shapes: n_in %d out %d ws %zu (need %zu)\n", n_in, out_size, ws_size, (size_t)WS_END); grid = -1; return; }
        int dev = 0, cus = 0, per_cu = 0;
        if (hipGetDevice(&dev) != hipSuccess || hipDeviceGetAttribute(&cus, hipDeviceAttributeMultiprocessorCount, dev) != hipSuccess) { grid = -1; return; }
        if (hipFuncSetAttribute((const void*)encoder_fwd, hipFuncAttributeMaxDynamicSharedMemorySize, LDS_BYTES) != hipSuccess) { fprintf(stderr, "kernel_launch: hipFuncSetAttribute failed\n"); grid = -1; return; }
        if (hipOccupancyMaxActiveBlocksPerMultiprocessor(&per_cu, (const void*)encoder_fwd, 512, LDS_BYTES) != hipSuccess || per_cu < 1) { fprintf(stderr, "kernel_launch: occupancy query says %d blocks per CU\n", per_cu); (void)hipGetLastError(); grid = -1; return; }
        grid = cus;
    }
    if (grid < 0) return;
    (void)in_sizes;
    if (hipMemsetAsync((char*)d_ws + WS_CTL, 0, CTL_ZERO_BYTES, stream) != hipSuccess) { fprintf(stderr, "kernel_launch: memset failed\n"); return; }
    Params p; memset(&p, 0, sizeof(p));
    for (int i = 0; i < 20; ++i) p.in[i] = (const float*)d_in[i];
    p.out = (float*)d_out; p.ws = (unsigned char*)d_ws;
#if MK_PER_PHASE
    for (int ph = 0; ph < N_PHASES; ++ph) { p.ph_lo = ph; p.ph_hi = ph + 1; hipLaunchKernelGGL(encoder_fwd, dim3(grid), dim3(512), LDS_BYTES, stream, p); }
#else
    p.ph_lo = 0; p.ph_hi = N_PHASES;
    hipLaunchKernelGGL(encoder_fwd, dim3(grid), dim3(512), LDS_BYTES, stream, p);
#endif
    const hipError_t le = hipPeekAtLastError();
    if (le != hipSuccess) fprintf(stderr, "kernel_launch: launch failed: %s\n", hipGetErrorName(le));
}
```

```cpp
#include <hip/hip_runtime.h>
#include <cstdio>
#include <cstdint>
#include <cstring>
namespace pg8 {
#define PG8_LAS __attribute__((address_space(3)))
typedef unsigned short bf16_t;
typedef short bf16x8 __attribute__((ext_vector_type(8)));
typedef float f32x4 __attribute__((ext_vector_type(4)));
typedef unsigned u32x4 __attribute__((ext_vector_type(4)));
constexpr int BM = 256, BK = 64, HALF = 128, HTB = HALF * BK * 2  , STAGE_BYTES = 8 * HTB, NXCD = 8, WGM = 4;

__host__ __device__ __forceinline__ int lds_byte(int r, int c) { const int st = (r >> 4) * 2 + (c >> 5), rr = r & 15, cc = c & 31, ob = rr * 64 + cc * 2; return st * 1024 + (ob ^ (((ob >> 9) & 1) << 5)); }
__host__ __device__ __forceinline__ void stage_rc(int b, int& R, int& C) { const int st = b / 1024, sb = b % 1024, swz = sb ^ (((sb >> 9) & 1) << 5); R = (st >> 1) * 16 + swz / 64; C = (st & 1) * 32 + (swz % 64) / 2; }
__host__ __device__ __forceinline__ int perm32(int rho) { const int n = rho >> 4, i = rho & 15; return 8 * (i >> 2) + 4 * n + (i & 3); }

struct Unit { int pm, pn, ko, kt; };
struct Gemm { const bf16_t* A; const bf16_t* Bt; int M, N, K, ld; };

struct StaticOrder {
    int nM, nN, nwg, G, c, kt;
    __host__ __device__ void init(int M, int N, int G_, int c_, int K_) { nM = M / BM; nN = N / BM; nwg = nM * nN; G = G_; c = c_; kt = K_ / BK; }
    __host__ __device__ bool next(int i, Unit& u) const {
        const long L = (long)i * G + c; if (L >= nwg) return false;
        int wgid = (int)L; { const int q = nwg / NXCD, r = nwg % NXCD, xcd = wgid % NXCD, off = wgid / NXCD; wgid = (xcd < r ? xcd * (q + 1) : r * (q + 1) + (xcd - r) * q) + off; }
        const int nig = WGM * nN, gid = wgid / nig, fm = gid * WGM, gsz = (nM - fm) < WGM ? (nM - fm) : WGM;
        u.pm = fm + ((wgid % nig) % gsz); u.pn = (wgid % nig) / gsz; u.ko = 0; u.kt = kt; return true;
    }
    __device__ __forceinline__ void a_ready(const Unit&) const {}
    __device__ __forceinline__ void done(const Unit&) const {}
};
__device__ __forceinline__ unsigned cvt_pk_bf16(float lo, float hi) { unsigned r; asm volatile("v_cvt_pk_bf16_f32 %0, %1, %2" : "=v"(r) : "v"(lo), "v"(hi)); return r; }
typedef unsigned u32x2 __attribute__((ext_vector_type(2)));
struct EpiPlain {
    static constexpr bool PERM = true, AFTER_DRAIN = false, PRE = false, TBL = false; static constexpr int NVM = 0;
    bf16_t* O; int ldc; const float* rstd;
    __device__ __forceinline__ void prefetch(const Unit& u, int wr, int fr, float (&pre)[8]) const {
#pragma unroll
        for (int i = 0; i < 8; ++i) pre[i] = rstd ? rstd[u.pm * BM + wr * 64 + fr + (i >> 2) * HALF + (i & 3) * 16] : 1.0f; }
    __device__ __forceinline__ void operator()(const f32x4 (&acc)[2][2][4][2], const Unit& u, int wr, int wc, int fr, int fq) const {
        const int row0 = u.pm * BM + wr * 64 + fr, col0 = u.pn * BM + wc * 32 + 8 * fq;
        float rsv[8];
#pragma unroll
        for (int i = 0; i < 8; ++i) rsv[i] = rstd ? rstd[row0 + (i >> 2) * HALF + (i & 3) * 16] : 1.0f;
        __builtin_amdgcn_sched_barrier(0);
#pragma unroll
        for (int ai = 0; ai < 2; ++ai)
#pragma unroll
            for (int m = 0; m < 4; ++m) { bf16_t* rowp = O + (size_t)(row0 + ai * HALF + m * 16) * ldc + col0; const float rs = rsv[ai * 4 + m];
#pragma unroll
                for (int bj = 0; bj < 2; ++bj) { const f32x4 v0 = acc[ai][bj][m][0] * rs, v1 = acc[ai][bj][m][1] * rs;
                    u32x4 w; w.x = cvt_pk_bf16(v0[0], v0[1]); w.y = cvt_pk_bf16(v0[2], v0[3]); w.z = cvt_pk_bf16(v1[0], v1[1]); w.w = cvt_pk_bf16(v1[2], v1[3]);
                    *(u32x4*)(rowp + bj * HALF) = w; } }
    }
};
struct EpiResid {
    static constexpr bool PERM = false, AFTER_DRAIN = false, PRE = false, TBL = false; static constexpr int NVM = 0;
    float* hreal; float* hmeta; int nreal; float scale;
    __device__ __forceinline__ void operator()(const f32x4 (&acc)[2][2][4][2], const Unit& u, int wr, int wc, int fr, int fq) const {
        float* base = (u.pm < nreal) ? hreal + (size_t)u.pm * BM * 2048 : hmeta;
        const int row0 = wr * 64 + fr, col0 = u.pn * BM + wc * 32 + 4 * fq;
#pragma unroll
        for (int ai = 0; ai < 2; ++ai) {
            f32x4 t[4][2][2];
#pragma unroll
            for (int m = 0; m < 4; ++m) { const float* rowp = base + (size_t)(row0 + ai * HALF + m * 16) * 2048 + col0;
#pragma unroll
                for (int bj = 0; bj < 2; ++bj)
#pragma unroll
                    for (int n = 0; n < 2; ++n) t[m][bj][n] = *(const f32x4*)(rowp + bj * HALF + n * 16); }
            __builtin_amdgcn_sched_barrier(0);
#pragma unroll
            for (int m = 0; m < 4; ++m) { float* rowp = base + (size_t)(row0 + ai * HALF + m * 16) * 2048 + col0;
#pragma unroll
                for (int bj = 0; bj < 2; ++bj)
#pragma unroll
                    for (int n = 0; n < 2; ++n) *(f32x4*)(rowp + bj * HALF + n * 16) = t[m][bj][n] + acc[ai][bj][m][n] * scale; }
            __builtin_amdgcn_sched_barrier(0);
        }
    }
};
constexpr int SS_PLANE = 49152;
struct EpiResidB {
    static constexpr bool PERM = true, AFTER_DRAIN = false, PRE = false, TBL = false; static constexpr int NVM = 16;
    bf16_t* hb; float* ss;
    __device__ __forceinline__ void operator()(const f32x4 (&acc)[2][2][4][2], const Unit& u, int wr, int wc, int fr, int fq) const {
        const int row0 = u.pm * BM + wr * 64 + fr, col0 = u.pn * BM + wc * 32 + 8 * fq;
        u32x4 t[2][4][2];
#pragma unroll
        for (int ai = 0; ai < 2; ++ai)
#pragma unroll
            for (int m = 0; m < 4; ++m)
#pragma unroll
                for (int bj = 0; bj < 2; ++bj) t[ai][m][bj] = *(const u32x4*)(hb + (size_t)(row0 + ai * HALF + m * 16) * 2048 + col0 + bj * HALF);
        __builtin_amdgcn_sched_barrier(0);
#pragma unroll
        for (int ai = 0; ai < 2; ++ai) {
            float q[4] = {0.f, 0.f, 0.f, 0.f};
#pragma unroll
            for (int m = 0; m < 4; ++m)
#pragma unroll
                for (int bj = 0; bj < 2; ++bj) { const u32x4 h = t[ai][m][bj]; const f32x4 a0 = acc[ai][bj][m][0], a1 = acc[ai][bj][m][1];
                    const f32x4 v0 = {__uint_as_float(h.x << 16) + a0[0], __uint_as_float(h.x & 0xffff0000u) + a0[1], __uint_as_float(h.y << 16) + a0[2], __uint_as_float(h.y & 0xffff0000u) + a0[3]};
                    const f32x4 v1 = {__uint_as_float(h.z << 16) + a1[0], __uint_as_float(h.z & 0xffff0000u) + a1[1], __uint_as_float(h.w << 16) + a1[2], __uint_as_float(h.w & 0xffff0000u) + a1[3]};
                    q[m] += (v0[0] * v0[0] + v0[1] * v0[1]) + (v0[2] * v0[2] + v0[3] * v0[3]) + (v1[0] * v1[0] + v1[1] * v1[1]) + (v1[2] * v1[2] + v1[3] * v1[3]);
                    u32x4 w; w.x = cvt_pk_bf16(v0[0], v0[1]); w.y = cvt_pk_bf16(v0[2], v0[3]); w.z = cvt_pk_bf16(v1[0], v1[1]); w.w = cvt_pk_bf16(v1[2], v1[3]);
                    *(u32x4*)(hb + (size_t)(row0 + ai * HALF + m * 16) * 2048 + col0 + bj * HALF) = w; }
            if (ss) {
#pragma unroll
                for (int m = 0; m < 4; ++m) { float s = q[m];
                    s += __int_as_float(__builtin_amdgcn_ds_swizzle(__float_as_int(s), 0x1f | (16 << 10)));
                    const auto rr = __builtin_amdgcn_permlane32_swap(__float_as_uint(s), __float_as_uint(s), false, false); s = __uint_as_float(rr[0]) + __uint_as_float(rr[1]);
                    if (fq == 0) ss[(size_t)(4 * u.pn + wc) * SS_PLANE + row0 + ai * HALF + m * 16] = s; }
            }
            __builtin_amdgcn_sched_barrier(0);
        }
    }
};
struct EpiResidFinal {
    static constexpr bool PERM = true, AFTER_DRAIN = false, PRE = false, TBL = false; static constexpr int NVM = 16;
    const bf16_t* hb; float* out;
    __device__ __forceinline__ void operator()(const f32x4 (&acc)[2][2][4][2], const Unit& u, int wr, int wc, int fr, int fq) const {
        const int row0 = u.pm * BM + wr * 64 + fr, col0 = u.pn * BM + wc * 32 + 8 * fq;
#pragma unroll
        for (int ai = 0; ai < 2; ++ai) {
            u32x4 t[4][2];
#pragma unroll
            for (int m = 0; m < 4; ++m)
#pragma unroll
                for (int bj = 0; bj < 2; ++bj) t[m][bj] = *(const u32x4*)(hb + (size_t)(row0 + ai * HALF + m * 16) * 2048 + col0 + bj * HALF);
            __builtin_amdgcn_sched_barrier(0);
#pragma unroll
            for (int m = 0; m < 4; ++m)
#pragma unroll
                for (int bj = 0; bj < 2; ++bj) { const u32x4 h = t[m][bj]; const f32x4 v0 = acc[ai][bj][m][0], v1 = acc[ai][bj][m][1]; float* op = out + (size_t)(row0 + ai * HALF + m * 16) * 2048 + col0 + bj * HALF;
                    *(f32x4*)op = (f32x4){__uint_as_float(h.x << 16) + v0[0], __uint_as_float(h.x & 0xffff0000u) + v0[1], __uint_as_float(h.y << 16) + v0[2], __uint_as_float(h.y & 0xffff0000u) + v0[3]};
                    *(f32x4*)(op + 4) = (f32x4){__uint_as_float(h.z << 16) + v1[0], __uint_as_float(h.z & 0xffff0000u) + v1[1], __uint_as_float(h.w << 16) + v1[2], __uint_as_float(h.w & 0xffff0000u) + v1[3]}; }
            __builtin_amdgcn_sched_barrier(0);
        }
    }
};
__device__ __forceinline__ float silu_mul(float g, float u) { return g * u * __builtin_amdgcn_rcpf(1.0f + __builtin_amdgcn_exp2f(-1.4426950408889634f * g)); }
struct EpiSwiglu {
    static constexpr bool PERM = true, AFTER_DRAIN = false, PRE = false, TBL = true; static constexpr int NVM = 8;
    bf16_t* O; int ldc; const float* rstd;
    __device__ __forceinline__ void table_load(const Unit& u, PG8_LAS unsigned char* t, int wid) const {
        int l2; asm volatile("v_mbcnt_lo_u32_b32 %0, -1, 0\n\tv_mbcnt_hi_u32_b32 %0, -1, %0" : "=v"(l2));
        if (wid < 4) __builtin_amdgcn_global_load_lds((const unsigned*)(rstd + u.pm * BM + wid * 64 + l2), (PG8_LAS unsigned*)(t + wid * 256), 4, 0, 0); }
    __device__ __forceinline__ void operator()(const f32x4 (&acc)[2][2][4][2], const Unit& u, int wr, int wc, int fr, int fq, const PG8_LAS float* tb) const {
        const int row0 = u.pm * BM + wr * 64 + fr, col0 = u.pn * (BM / 2) + wc * 32 + 8 * fq;
        float rsv[8];
#pragma unroll
        for (int i = 0; i < 8; ++i) rsv[i] = tb[wr * 64 + fr + (i >> 2) * HALF + (i & 3) * 16];
        __builtin_amdgcn_sched_barrier(0);
#pragma unroll
        for (int ai = 0; ai < 2; ++ai)
#pragma unroll
            for (int m = 0; m < 4; ++m) { bf16_t* rowp = O + (size_t)(row0 + ai * HALF + m * 16) * ldc + col0; const float rs = rsv[ai * 4 + m];
                const float c1 = -1.4426950408889634f * rs, irs2 = __builtin_amdgcn_rcpf(rs * rs);
                const f32x4 a0 = acc[ai][0][m][0], a1 = acc[ai][0][m][1], b0 = acc[ai][1][m][0], b1 = acc[ai][1][m][1];
#define SWG(G_, U_) ((G_) * (U_) * __builtin_amdgcn_rcpf(__builtin_fmaf(__builtin_amdgcn_exp2f((G_) * c1), irs2, irs2)))
                u32x4 w; w.x = cvt_pk_bf16(SWG(a0[0], a0[1]), SWG(a0[2], a0[3])); w.y = cvt_pk_bf16(SWG(a1[0], a1[1]), SWG(a1[2], a1[3]));
                w.z = cvt_pk_bf16(SWG(b0[0], b0[1]), SWG(b0[2], b0[3])); w.w = cvt_pk_bf16(SWG(b1[0], b1[1]), SWG(b1[2], b1[3]));
#undef SWG
                *(u32x4*)rowp = w; }
    }
};
struct EpiCin {
    static constexpr bool PERM = true, AFTER_DRAIN = false, PRE = false, TBL = false; static constexpr int NVM = 0;
    bf16_t* Bb; bf16_t* Gb; const float* rstd;
    __device__ __forceinline__ void prefetch(const Unit& u, int wr, int fr, float (&pre)[8]) const {
#pragma unroll
        for (int i = 0; i < 8; ++i) pre[i] = rstd ? rstd[u.pm * BM + wr * 64 + fr + (i >> 2) * HALF + (i & 3) * 16] : 1.0f; }
    __device__ __forceinline__ void operator()(const f32x4 (&acc)[2][2][4][2], const Unit& u, int wr, int wc, int fr, int fq) const {
        const int row0 = u.pm * BM + wr * 64 + fr;
        float rsv[8];
#pragma unroll
        for (int i = 0; i < 8; ++i) rsv[i] = rstd ? rstd[row0 + (i >> 2) * HALF + (i & 3) * 16] : 1.0f;
        __builtin_amdgcn_sched_barrier(0);
        if (u.pn < 8) {
            const int col0 = u.pn * BM + wc * 32 + 8 * fq;
#pragma unroll
            for (int ai = 0; ai < 2; ++ai)
#pragma unroll
                for (int m = 0; m < 4; ++m) { bf16_t* rowp = Bb + (size_t)(row0 + ai * HALF + m * 16) * 2048 + col0; const float rs = rsv[ai * 4 + m];
#pragma unroll
                    for (int bj = 0; bj < 2; ++bj) { const f32x4 v0 = acc[ai][bj][m][0] * rs, v1 = acc[ai][bj][m][1] * rs;
                        u32x4 w; w.x = cvt_pk_bf16(v0[0], v0[1]); w.y = cvt_pk_bf16(v0[2], v0[3]); w.z = cvt_pk_bf16(v1[0], v1[1]); w.w = cvt_pk_bf16(v1[2], v1[3]);
                        *(u32x4*)(rowp + bj * HALF) = w; } }
        } else {
            const int col0 = (u.pn - 8) * (BM / 2) + wc * 32 + 8 * fq;
#pragma unroll
            for (int ai = 0; ai < 2; ++ai)
#pragma unroll
                for (int m = 0; m < 4; ++m) { bf16_t* rowp = Gb + (size_t)(row0 + ai * HALF + m * 16) * 2048 + col0; const float rs = rsv[ai * 4 + m]; const float rs2 = rs * rs;
                    const f32x4 a0 = acc[ai][0][m][0], a1 = acc[ai][0][m][1], b0 = acc[ai][1][m][0], b1 = acc[ai][1][m][1];
                    u32x4 w; w.x = cvt_pk_bf16(a0[0] * a0[1] * rs2, a0[2] * a0[3] * rs2); w.y = cvt_pk_bf16(a1[0] * a1[1] * rs2, a1[2] * a1[3] * rs2);
                    w.z = cvt_pk_bf16(b0[0] * b0[1] * rs2, b0[2] * b0[3] * rs2); w.w = cvt_pk_bf16(b1[0] * b1[1] * rs2, b1[2] * b1[3] * rs2);
                    *(u32x4*)rowp = w; }
        }
    }
};
struct TailOrder {
    int nunits, c, pm, kchunk;
    __device__ __forceinline__ bool next(int i, Unit& u) const { if (i > 0 || c >= nunits) return false; u.pm = pm; u.pn = c & 7; u.ko = (c >> 3) * kchunk; u.kt = kchunk / BK; return true; }
    __device__ __forceinline__ void a_ready(const Unit&) const {}
    __device__ __forceinline__ void done(const Unit&) const {}
};
struct EpiTailStore {
    static constexpr bool PERM = false, AFTER_DRAIN = false, PRE = false, TBL = false; static constexpr int NVM = 0;
    float* tailp; int kchunk;
    __device__ __forceinline__ void operator()(const f32x4 (&acc)[2][2][4][2], const Unit& u, int wr, int wc, int fr, int fq) const {
        if (wr != 0) return;
        const int col0 = u.pn * BM + wc * 32 + 4 * fq; float* base = tailp + (size_t)(u.ko / kchunk) * 64 * 2048;
#pragma unroll
        for (int m = 0; m < 4; ++m) { float* rowp = base + (size_t)(m * 16 + fr) * 2048 + col0;
#pragma unroll
            for (int bj = 0; bj < 2; ++bj)
#pragma unroll
                for (int n = 0; n < 2; ++n) *(f32x4*)(rowp + bj * HALF + n * 16) = acc[0][bj][m][n]; }
    }
};
struct StaggerOrder : StaticOrder {
    int rounds, kcut;
    __device__ __forceinline__ void init2(int M, int N, int G_, int c_, int K_) {
        init(M, N, G_, c_, K_); rounds = nwg / G; const int sg = (c_ >> 3) & 7; int kc = ((kt * sg / 8) + 1) & ~1; if (kc < 4 || kt - kc < 4 || nwg % G != 0) kc = 0; kcut = kc; }
    __device__ __forceinline__ bool next(int i, Unit& u) const {
        if (kcut == 0) return StaticOrder::next(i, u);
        if (i > rounds) return false;
        if (i == rounds) { StaticOrder::next(0, u); u.ko = kcut * BK; u.kt = kt - kcut; return true; }
        StaticOrder::next(i, u); if (i == 0) u.kt = kcut; return true;
    }
};
struct EpiNone {
    static constexpr bool PERM = true, AFTER_DRAIN = false, PRE = false, TBL = false; static constexpr int NVM = 0;
    __device__ __forceinline__ void operator()(const f32x4 (&acc)[2][2][4][2], const Unit&, int, int, int, int) const {
#pragma unroll
        for (int a = 0; a < 2; ++a)
#pragma unroll
            for (int b = 0; b < 2; ++b)
#pragma unroll
                for (int m = 0; m < 4; ++m) asm volatile("" :: "v"(acc[a][b][m][0]), "v"(acc[a][b][m][1]));
    }
};
template <class Epi, class Sched, bool ALIGN_EPI = false, bool SP2 = false>
__device__ __forceinline__ void gemm_phase(PG8_LAS unsigned char* lds, const Gemm g, const Sched& S, const Epi& E) {
    int tid_l = threadIdx.x; asm volatile("" : "+v"(tid_l));
    const int tid = tid_l, wid = __builtin_amdgcn_readfirstlane(tid >> 6), lane = tid & 63, wr = wid >> 2, wc = wid & 3, fr = lane & 15, fq = lane >> 4;
    const int K = g.ld;
    unsigned voffA[2], voffB[2];
#pragma unroll
    for (int i = 0; i < 2; ++i) { int R, C; stage_rc(tid * 16 + i * 8192, R, C); const int Rb = Epi::PERM ? ((R & ~31) + perm32(R & 31)) : R;
        voffA[i] = (unsigned)(R * K + C) * 2u; voffB[i] = (unsigned)(Rb * K + C) * 2u; }
    const size_t kstep = (size_t)(BK * 2);
    const size_t hstep = (size_t)HALF * K * 2;
    const size_t tstep = 2 * hstep;
    const unsigned ldsw = (unsigned)wid * 1024u;
    const unsigned ldsbase_w = (unsigned)(size_t)lds + ldsw;
    const int aoff = lds_byte(wr * 64 + fr, fq * 8), boff = lds_byte(wc * 32 + fr, fq * 8);
#define PG8_SA(b, h) (((b) * 2 + (h)) * HTB)
#define PG8_SB(b, h) ((4 + (b) * 2 + (h)) * HTB)
#define PG8_STAGE1(ldsoff, gbase, IMM, voff32) asm volatile("s_mov_b32 m0, %2\n\ts_nop 0\n\tglobal_load_lds_dwordx4 %0, %1 offset:" #IMM :: "v"(voff32), "s"(gbase), "s"(ldsbase_w + (unsigned)(ldsoff)) : "memory", "m0")
#define PG8_STAGEI(bufoff, gbase, IMM, voff) do { PG8_STAGE1((bufoff), gbase, IMM, (voff)[0]); PG8_STAGE1((bufoff) + 8192, gbase, IMM, (voff)[1]); } while (0)
#define PG8_STAGE(bufoff, gbase, voff) PG8_STAGEI(bufoff, gbase, 0, voff)
#define PG8_LDA(dst, b, h) do { _Pragma("unroll") for (int m = 0; m < 4; ++m) _Pragma("unroll") for (int k = 0; k < 2; ++k) dst[m][k] = *(const PG8_LAS bf16x8*)(lds + PG8_SA(b, h) + aoff + m * 2048 + k * 1024); } while (0)
#define PG8_LDB(dst, b, h) do { _Pragma("unroll") for (int n = 0; n < 2; ++n) _Pragma("unroll") for (int k = 0; k < 2; ++k) dst[n][k] = *(const PG8_LAS bf16x8*)(lds + PG8_SB(b, h) + boff + n * 2048 + k * 1024); } while (0)
#define PG8_MMA(ai, bj, At, Bt) do { __builtin_amdgcn_s_setprio(1); _Pragma("unroll") for (int m = 0; m < 4; ++m) _Pragma("unroll") for (int n = 0; n < 2; ++n) _Pragma("unroll") for (int k = 0; k < 2; ++k) \
        acc[ai][bj][m][n] = __builtin_amdgcn_mfma_f32_16x16x32_bf16(Bt[n][k], At[m][k], acc[ai][bj][m][n], 0, 0, 0); __builtin_amdgcn_s_setprio(0); } while (0)
#define PG8_WAIT_V(n) asm volatile("s_waitcnt vmcnt(" #n ")" ::: "memory")
#define PG8_WAIT_L(n) asm volatile("s_waitcnt lgkmcnt(" #n ")" ::: "memory")
#define PG8_BAR __builtin_amdgcn_s_barrier()
#define PG8_SCHED __builtin_amdgcn_sched_barrier(0)
    Unit cur, nxt; int ui = 0;
    if (!S.next(0, cur)) return;
    f32x4 acc[2][2][4][2];
#pragma unroll
    for (int a = 0; a < 2; ++a)
#pragma unroll
        for (int b = 0; b < 2; ++b)
#pragma unroll
            for (int m = 0; m < 4; ++m)
#pragma unroll
                for (int n = 0; n < 2; ++n) acc[a][b][m][n] = (f32x4){0.f, 0.f, 0.f, 0.f};
    bf16x8 At[4][2], B0[2][2], B1[2][2];
    const char* cA = (const char*)g.A + (size_t)cur.pm * tstep + (size_t)cur.ko * 2; const char* cB = (const char*)g.Bt + (size_t)cur.pn * tstep + (size_t)cur.ko * 2;
    S.a_ready(cur);
    float pre[8];
    if constexpr (Epi::PRE) E.prefetch(cur, wr, fr, pre);
    PG8_LAS unsigned char* const tbl = lds + STAGE_BYTES;
    if constexpr (Epi::TBL) E.table_load(cur, tbl, wid);
    if constexpr (SP2) {
        PG8_STAGE(PG8_SB(0, 0), cB, voffB); PG8_STAGE(PG8_SB(0, 1), cB + hstep, voffB); PG8_STAGE(PG8_SA(0, 0), cA, voffA); PG8_STAGE(PG8_SA(0, 1), cA + hstep, voffA);
        if (wr == 1) PG8_BAR;
        PG8_WAIT_V(2); PG8_BAR;
        PG8_STAGE(PG8_SB(1, 0), cB + kstep, voffB); PG8_STAGE(PG8_SA(1, 0), cA + kstep, voffA); PG8_STAGE(PG8_SB(1, 1), cB + hstep + kstep, voffB);
        PG8_WAIT_V(6); PG8_BAR;
    } else {
        PG8_STAGE(PG8_SB(0, 0), cB, voffB); PG8_STAGE(PG8_SA(0, 0), cA, voffA); PG8_STAGE(PG8_SB(0, 1), cB + hstep, voffB); PG8_STAGE(PG8_SA(0, 1), cA + hstep, voffA);
        if (wr == 1) PG8_BAR;
        PG8_WAIT_V(4); PG8_BAR;
        PG8_STAGE(PG8_SB(1, 0), cB + kstep, voffB); PG8_STAGE(PG8_SA(1, 0), cA + kstep, voffA); PG8_STAGE(PG8_SB(1, 1), cB + hstep + kstep, voffB);
        PG8_WAIT_V(6); PG8_BAR;
    }
    for (;;) {
        const bool has_next = S.next(ui + 1, nxt);
        const char* nA = has_next ? (const char*)g.A + (size_t)nxt.pm * tstep + (size_t)nxt.ko * 2 : cA; const char* nB = has_next ? (const char*)g.Bt + (size_t)nxt.pn * tstep + (size_t)nxt.ko * 2 : cB;
        const int nt = cur.kt;
#define PG8_KSETUP() const bool last = (t == nt - 2); const char* a1 = cA + (size_t)(t + 1) * kstep; \
            const char* a2 = last ? nA : cA + (size_t)(t + 2) * kstep; const char* b2 = last ? nB : cB + (size_t)(t + 2) * kstep; const char* a3 = a2 + kstep; const char* b3 = b2 + kstep; \
            if (last && has_next) S.a_ready(nxt)
#define PG8_KITER_SP2(W1, W2) do { \
            PG8_LDB(B0, 0, 0); PG8_LDB(B1, 0, 1); PG8_SCHED; PG8_LDA(At, 0, 0); PG8_STAGE(PG8_SA(1, 1), a1 + hstep, voffA); \
            PG8_WAIT_V(W1); PG8_WAIT_L(0); PG8_BAR; PG8_MMA(0, 0, At, B0); PG8_MMA(0, 1, At, B1); PG8_BAR; PG8_SCHED; \
            PG8_LDA(At, 0, 1); PG8_STAGE(PG8_SB(0, 0), b2, voffB); PG8_STAGE(PG8_SB(0, 1), b2 + hstep, voffB); PG8_STAGE(PG8_SA(0, 0), a2, voffA); \
            PG8_WAIT_V(W2); PG8_WAIT_L(0); PG8_BAR; PG8_MMA(1, 0, At, B0); PG8_MMA(1, 1, At, B1); PG8_BAR; PG8_SCHED; \
            PG8_LDB(B0, 1, 0); PG8_LDB(B1, 1, 1); PG8_SCHED; PG8_LDA(At, 1, 0); PG8_STAGE(PG8_SA(0, 1), a2 + hstep, voffA); \
            PG8_WAIT_V(8); PG8_WAIT_L(0); PG8_BAR; PG8_MMA(0, 0, At, B0); PG8_MMA(0, 1, At, B1); PG8_BAR; PG8_SCHED; \
            PG8_LDA(At, 1, 1); PG8_STAGE(PG8_SB(1, 0), b3, voffB); PG8_STAGE(PG8_SB(1, 1), b3 + hstep, voffB); PG8_STAGE(PG8_SA(1, 0), a3, voffA); \
            PG8_WAIT_V(8); PG8_WAIT_L(0); PG8_BAR; PG8_MMA(1, 0, At, B0); PG8_MMA(1, 1, At, B1); PG8_BAR; PG8_SCHED; } while (0)
        int t0 = 0;
        if constexpr (SP2 && Epi::NVM == 16) { if (ui > 0) { const int t = 0; PG8_KSETUP(); PG8_KITER_SP2(24, 24); t0 = 2; } }
        if constexpr (SP2 && Epi::NVM == 8) { if (ui > 0) { const int t = 0; PG8_KSETUP(); PG8_KITER_SP2(16, 16); t0 = 2; } }
        for (int t = t0; t < nt; t += 2) {
            PG8_KSETUP();
            if constexpr (SP2) {
            PG8_KITER_SP2(8, 8);
            } else {
            PG8_LDB(B0, 0, 0); PG8_SCHED; PG8_LDA(At, 0, 0); PG8_STAGE(PG8_SA(1, 1), a1 + hstep, voffA);
            PG8_WAIT_L(8); PG8_BAR; PG8_WAIT_L(0); PG8_MMA(0, 0, At, B0); PG8_BAR; PG8_SCHED;
            PG8_LDB(B1, 0, 1); PG8_STAGE(PG8_SB(0, 0), b2, voffB);
            PG8_BAR; PG8_WAIT_L(0); PG8_MMA(0, 1, At, B1); PG8_BAR;
            PG8_LDA(At, 0, 1); PG8_STAGE(PG8_SA(0, 0), a2, voffA);
            PG8_BAR; PG8_WAIT_L(0); PG8_MMA(1, 0, At, B0); PG8_BAR; PG8_SCHED;
            PG8_STAGE(PG8_SB(0, 1), b2 + hstep, voffB);
            PG8_WAIT_V(6); PG8_BAR; PG8_MMA(1, 1, At, B1); PG8_BAR;
            PG8_LDB(B0, 1, 0); PG8_SCHED; PG8_LDA(At, 1, 0); PG8_STAGE(PG8_SA(0, 1), a2 + hstep, voffA);
            PG8_WAIT_L(8); PG8_BAR; PG8_WAIT_L(0); PG8_MMA(0, 0, At, B0); PG8_BAR; PG8_SCHED;
            PG8_LDB(B1, 1, 1); PG8_STAGE(PG8_SB(1, 0), b3, voffB);
            PG8_BAR; PG8_WAIT_L(0); PG8_MMA(0, 1, At, B1); PG8_BAR;
            PG8_LDA(At, 1, 1); PG8_STAGE(PG8_SA(1, 0), a3, voffA);
            PG8_BAR; PG8_WAIT_L(0); PG8_MMA(1, 0, At, B0); PG8_BAR; PG8_SCHED;
            PG8_STAGE(PG8_SB(1, 1), b3 + hstep, voffB);
            PG8_WAIT_V(6); PG8_BAR; PG8_MMA(1, 1, At, B1); PG8_BAR;
            }
        }
#undef PG8_KSETUP
#undef PG8_KITER_SP2
        if constexpr (ALIGN_EPI) { if (wr == 0) PG8_BAR; }
        if constexpr (!Epi::AFTER_DRAIN) { if constexpr (Epi::TBL) { E(acc, cur, wr, wc, fr, fq, (const PG8_LAS float*)(tbl + (ui & 1) * 1024)); if (has_next) E.table_load(nxt, tbl + ((ui + 1) & 1) * 1024, wid); } else if constexpr (Epi::PRE) { E(acc, cur, wr, wc, fr, fq, pre); if (has_next) E.prefetch(nxt, wr, fr, pre); } else E(acc, cur, wr, wc, fr, fq); S.done(cur); }
        if (!has_next) break;
#pragma unroll
        for (int a = 0; a < 2; ++a)
#pragma unroll
            for (int b = 0; b < 2; ++b)
#pragma unroll
                for (int m = 0; m < 4; ++m)
#pragma unroll
                    for (int n = 0; n < 2; ++n) acc[a][b][m][n] = (f32x4){0.f, 0.f, 0.f, 0.f};
        cur = nxt; cA = nA; cB = nB; ++ui;
        if constexpr (ALIGN_EPI) { if (wr == 1) PG8_BAR; }
    }
    PG8_WAIT_V(0);
    if constexpr (!ALIGN_EPI) { if (wr == 0) PG8_BAR; }
    PG8_BAR;
    if constexpr (Epi::AFTER_DRAIN) { E.fused(acc, cur, wr, wc, fr, fq, lds, wid, lane); S.done(cur); }
#undef PG8_SA
#undef PG8_SB
#undef PG8_STAGE
#undef PG8_LDA
#undef PG8_LDB
#undef PG8_MMA
#undef PG8_WAIT_V
#undef PG8_WAIT_L
#undef PG8_BAR
#undef PG8_SCHED
}
}
namespace att {
typedef unsigned short u16;
using bf16x8 = __attribute__((ext_vector_type(8))) short;
using s16x4  = __attribute__((ext_vector_type(4))) short;
using f32x16 = __attribute__((ext_vector_type(16))) float;
using u32x4  = __attribute__((ext_vector_type(4))) unsigned;
constexpr int   D = 128, KVBLK = 64, LDK = 128, LDQ = 3072, LDO = 2048;
constexpr float SCALE = 0.088388347648318440f;
constexpr float THR = 8.f;
constexpr float NEGBIG = -1e30f;
constexpr size_t SHM_V = KVBLK * D * 2, SHM_K = KVBLK * D * 2, SHM_ATTN = 2 * SHM_V + 2 * SHM_K + 8 * 64 * 4;
#define KSWZ(row, colB) ((row) * 256 + ((colB) ^ (((row) & 7) << 4)))
#define SBAR() __builtin_amdgcn_sched_barrier(0)
__device__ __forceinline__ int crow(int r, int hi) { return (r & 3) + 8 * (r >> 2) + 4 * hi; }
__device__ __forceinline__ unsigned cvtpk(float lo, float hi) { unsigned r; asm volatile("v_cvt_pk_bf16_f32 %0, %1, %2" : "=v"(r) : "v"(lo), "v"(hi)); return r; }

__device__ __forceinline__ void partialSM(f32x16& p0, f32x16& p1, float& m_reg, float& mn, float& alpha) {
  constexpr float C = SCALE * 1.4426950408889634f;
  float pmax = p0[0]; for (int r = 1; r < 16; ++r) pmax = fmaxf(pmax, p0[r]); for (int r = 0; r < 16; ++r) pmax = fmaxf(pmax, p1[r]);
  { auto rr = __builtin_amdgcn_permlane32_swap(__float_as_uint(pmax), __float_as_uint(pmax), false, false);
    pmax = fmaxf(__uint_as_float(rr[0]), __uint_as_float(rr[1])); }
  if (__builtin_expect(__all(pmax - m_reg <= THR / SCALE), 1)) { mn = m_reg; alpha = 1.f; }
  else { mn = fmaxf(m_reg, pmax); alpha = __builtin_amdgcn_exp2f((m_reg - mn) * C); m_reg = mn; }
  float mnC = -mn * C;
  for (int r = 0; r < 16; ++r) p0[r] = fmaf(p0[r], C, mnC); for (int r = 0; r < 16; ++r) p1[r] = fmaf(p1[r], C, mnC);
  for (int r = 0; r < 16; ++r) p0[r] = __builtin_amdgcn_exp2f(p0[r]);
}
__device__ __forceinline__ void finishSM(f32x16& p0, f32x16& p1, float alpha, float& l_reg, bf16x8& pa0, bf16x8& pa1, bf16x8& pa2, bf16x8& pa3) {
  for (int r = 0; r < 16; ++r) p1[r] = __builtin_amdgcn_exp2f(p1[r]);
  float ps = 0; for (int r = 0; r < 16; ++r) ps += p0[r]; for (int r = 0; r < 16; ++r) ps += p1[r];
  { auto rr = __builtin_amdgcn_permlane32_swap(__float_as_uint(ps), __float_as_uint(ps), false, false);
    ps = __uint_as_float(rr[0]) + __uint_as_float(rr[1]); }
  l_reg = l_reg * alpha + ps;
#define PK4(P, BASE, OUT) do { unsigned a0 = cvtpk(P[BASE + 0], P[BASE + 1]), a1 = cvtpk(P[BASE + 2], P[BASE + 3]);   \
    unsigned b0 = cvtpk(P[BASE + 4], P[BASE + 5]), b1 = cvtpk(P[BASE + 6], P[BASE + 7]);                              \
    auto r0 = __builtin_amdgcn_permlane32_swap(a0, b0, false, false); auto r1 = __builtin_amdgcn_permlane32_swap(a1, b1, false, false); \
    u32x4 w = {r0[0], r1[0], r0[1], r1[1]}; OUT = *reinterpret_cast<bf16x8*>(&w); } while (0)
  PK4(p0, 0, pa0); PK4(p0, 8, pa1); PK4(p1, 0, pa2); PK4(p1, 8, pa3);
#undef PK4
}
__device__ __forceinline__ void qkt(f32x16& p0, f32x16& p1, const u16* Ks, const bf16x8* qr, int r32, int hi) {
  p0 = f32x16{}; p1 = f32x16{};
  for (int d0 = 0; d0 < 8; ++d0) { int cb = (d0 * 16 + hi * 8) * 2;
    bf16x8 b0 = *reinterpret_cast<const bf16x8*>((const char*)Ks + KSWZ(r32, cb));
    bf16x8 b1 = *reinterpret_cast<const bf16x8*>((const char*)Ks + KSWZ(32 + r32, cb));
    p0 = __builtin_amdgcn_mfma_f32_32x32x16_bf16(b0, qr[d0], p0, 0, 0, 0);
    p1 = __builtin_amdgcn_mfma_f32_32x32x16_bf16(b1, qr[d0], p1, 0, 0, 0); }
}
__device__ __forceinline__ void qkt_lds(f32x16& p0, f32x16& p1, const u16* Ks, const char* qs, int r32, int hi) {
  p0 = f32x16{}; p1 = f32x16{};
  for (int d0 = 0; d0 < 8; ++d0) { int cb = (d0 * 16 + hi * 8) * 2;
    bf16x8 q = *reinterpret_cast<const bf16x8*>(qs + d0 * 1024);
    bf16x8 b0 = *reinterpret_cast<const bf16x8*>((const char*)Ks + KSWZ(r32, cb));
    bf16x8 b1 = *reinterpret_cast<const bf16x8*>((const char*)Ks + KSWZ(32 + r32, cb));
    p0 = __builtin_amdgcn_mfma_f32_32x32x16_bf16(b0, q, p0, 0, 0, 0);
    p1 = __builtin_amdgcn_mfma_f32_32x32x16_bf16(b1, q, p1, 0, 0, 0); }
}
__device__ __forceinline__ int v_st(int k, int c) { const int kk = (k & ~0xC) | ((k & 4) << 1) | ((k & 8) >> 1); return ((kk >> 3) * 4 + (c >> 5)) * 512 + ((kk & 7) * 32 + (c & 31)) * 2; }
__device__ __forceinline__ int v_rd_base(int lane) { return ((lane & 3) << 3) | (((lane >> 2) & 3) << 6) | (((lane >> 4) & 1) << 5) | (((lane >> 5) & 1) << 8); }
constexpr int v_rd_off(int d0, int ks, int half) { return d0 * 512 + ks * 4096 + half * 2048; }
template <int OFF> __device__ __forceinline__ s16x4 tr_read(int vb) {
  s16x4 r; asm volatile("ds_read_b64_tr_b16 %0, %1 offset:%2" : "=&v"(r) : "v"(vb), "i"(OFF) : "memory"); return r;
}
template <int D0> __device__ __forceinline__ void pv_one(f32x16& od, int vb, bf16x8 pa0, bf16x8 pa1, bf16x8 pa2, bf16x8 pa3) {
  const s16x4 l0 = tr_read<v_rd_off(D0, 0, 0)>(vb), h0 = tr_read<v_rd_off(D0, 0, 1)>(vb), l1 = tr_read<v_rd_off(D0, 1, 0)>(vb), h1 = tr_read<v_rd_off(D0, 1, 1)>(vb);
  const s16x4 l2 = tr_read<v_rd_off(D0, 2, 0)>(vb), h2 = tr_read<v_rd_off(D0, 2, 1)>(vb), l3 = tr_read<v_rd_off(D0, 3, 0)>(vb), h3 = tr_read<v_rd_off(D0, 3, 1)>(vb);
  asm volatile("s_waitcnt lgkmcnt(0)" ::: "memory"); SBAR();
#define PK(L, H) (bf16x8){L[0], L[1], L[2], L[3], H[0], H[1], H[2], H[3]}
  od = __builtin_amdgcn_mfma_f32_32x32x16_bf16(pa0, PK(l0, h0), od, 0, 0, 0);
  od = __builtin_amdgcn_mfma_f32_32x32x16_bf16(pa1, PK(l1, h1), od, 0, 0, 0);
  od = __builtin_amdgcn_mfma_f32_32x32x16_bf16(pa2, PK(l2, h2), od, 0, 0, 0);
  od = __builtin_amdgcn_mfma_f32_32x32x16_bf16(pa3, PK(l3, h3), od, 0, 0, 0);
#undef PK
}
__device__ __forceinline__ void pv_d0(f32x16* o, int vb, bf16x8 pa0, bf16x8 pa1, bf16x8 pa2, bf16x8 pa3) {
  pv_one<0>(o[0], vb, pa0, pa1, pa2, pa3); pv_one<1>(o[1], vb, pa0, pa1, pa2, pa3); pv_one<2>(o[2], vb, pa0, pa1, pa2, pa3); pv_one<3>(o[3], vb, pa0, pa1, pa2, pa3);
}
__device__ __forceinline__ void mask_meta_tile(f32x16& p0, f32x16& p1) {
#pragma unroll
  for (int r = 8; r < 16; ++r) p0[r] = NEGBIG;
#pragma unroll
  for (int r = 0; r < 16; ++r) p1[r] = NEGBIG;
}
__device__ __forceinline__ void mask_win_tile(f32x16& p0, f32x16& p1, float dlt  , float slopeS, bool ismeta) {
  if (!ismeta) {
#pragma unroll
    for (int r = 0; r < 16; ++r) { const float c = (float)((r & 3) + 8 * (r >> 2)); const float d0 = fabsf(dlt - c), d1 = fabsf(dlt - 32.f - c);
      p0[r] = (d0 <= 128.f) ? fmaf(-slopeS, d0, p0[r]) : NEGBIG; p1[r] = (d1 <= 128.f) ? fmaf(-slopeS, d1, p1[r]) : NEGBIG; }
  } else {
#pragma unroll
    for (int r = 0; r < 16; ++r) { const float c = (float)((r & 3) + 8 * (r >> 2));
      p0[r] = (dlt - c >= 0.f) ? p0[r] : NEGBIG; p1[r] = (dlt - 32.f - c >= 0.f) ? p1[r] : NEGBIG; }
  }
}

template <int MODE>
__device__ __forceinline__ void attn_item(const u16* __restrict__ Qw, const u16* __restrict__ Kh, const u16* __restrict__ Vh, u16* __restrict__ Ow, bool metaq, bool store,
                                          int NT, int ktlo, int tq, float slopeS, float sinkL2, char* lds, bool mask0, float* __restrict__ po, float* __restrict__ pml) {
  int tid_l = threadIdx.x; asm volatile("" : "+v"(tid_l));
  const int tid = tid_l, wid = tid >> 6, lane = tid & 63, r32 = lane & 31, hi = lane >> 5;
  constexpr int NS = (MODE == 0) ? 3 : 2;
  u16* V_lds = (u16*)lds; u16* K_lds = (u16*)(lds + NS * SHM_V);
  float* ws = (float*)(lds + NS * (SHM_V + SHM_K)) + wid * 64; float* li_l = ws; float* al_l = ws + 32;
  float m_reg = -1e30f, l_reg = 0; f32x16 o[4] = {}; bf16x8 qr[8];
  char* qs = lds + SHM_ATTN + wid * 8192 + lane * 16;
#pragma unroll
  for (int d0 = 0; d0 < 8; ++d0) qr[d0] = *reinterpret_cast<const bf16x8*>(Qw + d0 * 16);
#define QKT(P0, P1, KS) do { if (MODE == 1) qkt_lds(P0, P1, KS, qs, r32, hi); else qkt(P0, P1, KS, qr, r32, hi); } while (0)
  const int sr = tid >> 4, sc = (tid & 15) * 8, vst0 = v_st(sr, sc), vst1 = v_st(32 + sr, sc);
  const int vb0 = (int)(uintptr_t)V_lds + v_rd_base(lane);
  constexpr int SD = 2;
  struct { bf16x8 vs0, vs1, ks0, ks1; } sr_[SD];
#define KROW(t) ((MODE == 0 || (t)) ? 64 * (ktlo + (t)) : 0)
#define SLOAD(i, tt) do { const int k0_ = KROW(tt); sr_[i].vs0 = *reinterpret_cast<const bf16x8*>(&Vh[(long)(k0_ + sr) * LDK + sc]); sr_[i].vs1 = *reinterpret_cast<const bf16x8*>(&Vh[(long)(k0_ + 32 + sr) * LDK + sc]); \
    sr_[i].ks0 = *reinterpret_cast<const bf16x8*>(&Kh[(long)(k0_ + sr) * LDK + sc]); sr_[i].ks1 = *reinterpret_cast<const bf16x8*>(&Kh[(long)(k0_ + 32 + sr) * LDK + sc]); } while (0)
#define SWRITE(b, i) do { *(bf16x8*)((char*)V_lds + (b) * SHM_V + vst0) = sr_[i].vs0;          \
    *(bf16x8*)((char*)V_lds + (b) * SHM_V + vst1) = sr_[i].vs1; int kc = sc * 2;               \
    *(bf16x8*)((char*)K_lds + (b) * SHM_K + KSWZ(sr, kc)) = sr_[i].ks0;                       \
    *(bf16x8*)((char*)K_lds + (b) * SHM_K + KSWZ(32 + sr, kc)) = sr_[i].ks1; } while (0)
#define SWAIT() do { if (SD == 2) asm volatile("s_waitcnt vmcnt(4)" ::: "memory"); else asm volatile("s_waitcnt vmcnt(0)" ::: "memory"); } while (0)
#define RESC(a) do { if (__any((a) < 1.f)) { if (hi == 0) al_l[r32] = (a); asm volatile("s_waitcnt lgkmcnt(0)" ::: "memory"); \
    for (int d = 0; d < 4; ++d) for (int r = 0; r < 16; ++r) o[d][r] *= al_l[crow(r, hi)]; } } while (0)
  const float tqf = (float)(tq - 4 * hi);
#define WMASK(P0, P1, tt) do { if (MODE == 1) mask_win_tile(P0, P1, tqf - (float)(64 * (ktlo + (tt) - 1)), slopeS, metaq); } while (0)
  f32x16 pA0, pA1, pB0, pB1; float mnA, mnB, alA, alB; bf16x8 pa0, pa1, pa2, pa3;
  constexpr int SE = 0, SO = SD - 1;
  SLOAD(SE, 0);
  __builtin_amdgcn_sched_barrier(0);
  if (MODE == 1) {
    __builtin_amdgcn_sched_barrier(0);
#pragma unroll
    for (int d0 = 0; d0 < 8; ++d0) *reinterpret_cast<bf16x8*>(qs + d0 * 1024) = qr[d0];
    __builtin_amdgcn_sched_barrier(0); }
  __syncthreads();
  asm volatile("s_waitcnt vmcnt(0)" ::: "memory"); SWRITE(0, SE); __syncthreads();
  QKT(pA0, pA1, K_lds); if (mask0) mask_meta_tile(pA0, pA1); partialSM(pA0, pA1, m_reg, mnA, alA);
  SLOAD(SO, 1); if (SD == 2) SLOAD(SE, 2);
  SWAIT(); SWRITE(1, SO); __syncthreads();
  if (MODE == 0) {
    int sj = 1, slast = 1;
    for (int j = 1; j + 1 < NT; j += 2) {
      const int s0_ = sj, s1_ = sj == 2 ? 0 : sj + 1, s2_ = s1_ == 2 ? 0 : s1_ + 1;
      SBAR(); QKT(pB0, pB1, (u16*)((char*)K_lds + s0_ * SHM_K));
      finishSM(pA0, pA1, alA, l_reg, pa0, pa1, pa2, pa3); SBAR();
      { const int tn = (j + 2 < NT) ? j + 2 : NT - 1; SLOAD(SO, tn); } SBAR();
      pv_d0(o, vb0 + s2_ * (int)SHM_V, pa0, pa1, pa2, pa3); partialSM(pB0, pB1, m_reg, mnB, alB);
      SWAIT(); SWRITE(s1_, SE);
      RESC(alB); __syncthreads();
      SBAR(); QKT(pA0, pA1, (u16*)((char*)K_lds + s1_ * SHM_K));
      finishSM(pB0, pB1, alB, l_reg, pa0, pa1, pa2, pa3); SBAR();
      { const int tn = (j + 3 < NT) ? j + 3 : NT - 1; SLOAD(SE, tn); } SBAR();
      pv_d0(o, vb0 + s0_ * (int)SHM_V, pa0, pa1, pa2, pa3); partialSM(pA0, pA1, m_reg, mnA, alA);
      SWAIT(); SWRITE(s2_, SO);
      RESC(alA); __syncthreads();
      sj = s2_; slast = s1_;
    }
    finishSM(pA0, pA1, alA, l_reg, pa0, pa1, pa2, pa3); SBAR();
    pv_d0(o, vb0 + slast * (int)SHM_V, pa0, pa1, pa2, pa3);
  } else {
  for (int j = 1; j + 1 < NT; j += 2) {
    SBAR(); QKT(pB0, pB1, (u16*)((char*)K_lds + SHM_K)); WMASK(pB0, pB1, j);
    finishSM(pA0, pA1, alA, l_reg, pa0, pa1, pa2, pa3); SBAR();
    { const int tn = (j + SD < NT) ? j + SD : NT - 1; SLOAD(SO, tn); } SBAR();
    pv_d0(o, vb0, pa0, pa1, pa2, pa3); partialSM(pB0, pB1, m_reg, mnB, alB);
    __syncthreads(); SWAIT(); SWRITE(0, SE);
    RESC(alB); __syncthreads();
    SBAR(); QKT(pA0, pA1, K_lds); WMASK(pA0, pA1, j + 1);
    finishSM(pB0, pB1, alB, l_reg, pa0, pa1, pa2, pa3); SBAR();
    { const int tn = (j + 1 + SD < NT) ? j + 1 + SD : NT - 1; SLOAD(SE, tn); } SBAR();
    pv_d0(o, vb0 + (int)SHM_V, pa0, pa1, pa2, pa3); partialSM(pA0, pA1, m_reg, mnA, alA);
    __syncthreads(); SWAIT(); SWRITE(1, SO);
    RESC(alA); __syncthreads();
  }
  finishSM(pA0, pA1, alA, l_reg, pa0, pa1, pa2, pa3); SBAR();
  pv_d0(o, vb0, pa0, pa1, pa2, pa3);
  }
  if (MODE == 1) l_reg += __builtin_amdgcn_exp2f(sinkL2 - m_reg * (SCALE * 1.4426950408889634f));
  if (MODE == 0 && po != nullptr) {
    if (store) {
      if (hi == 0) { pml[2 * r32] = m_reg; pml[2 * r32 + 1] = l_reg; }
#pragma unroll
      for (int r = 0; r < 16; ++r) { const int orow = crow(r, hi);
#pragma unroll
        for (int d0 = 0; d0 < 4; ++d0) po[orow * 128 + d0 * 32 + r32] = o[d0][r]; }
    }
  } else {
  if (hi == 0) li_l[r32] = l_reg; asm volatile("s_waitcnt lgkmcnt(0)" ::: "memory");
  float rli[16];
#pragma unroll
  for (int r = 0; r < 16; ++r) rli[r] = __builtin_amdgcn_rcpf(li_l[crow(r, hi)]);
  if (store) {
#pragma unroll
    for (int r = 0; r < 16; ++r) { const int orow = crow(r, hi); const long ro = metaq ? (long)(orow & 15) * LDO + (orow >> 4) * 128 : (long)orow * LDO;
#pragma unroll
      for (int d0 = 0; d0 < 4; ++d0) { const float v = o[d0][r] * rli[r]; Ow[ro + d0 * 32 + r32] = (u16)(cvtpk(v, v) & 0xffffu); } }
  }
  }
#undef KROW
#undef QKT
#undef SLOAD
#undef SWRITE
#undef SWAIT
#undef RESC
#undef WMASK
}
}
typedef unsigned short u16;
typedef float f32x4 __attribute__((ext_vector_type(4)));
typedef float f32x2 __attribute__((ext_vector_type(2)));
typedef unsigned u32x4 __attribute__((ext_vector_type(4)));
typedef unsigned u32x2 __attribute__((ext_vector_type(2)));
typedef short bf16x8 __attribute__((ext_vector_type(8)));
typedef short s16x4 __attribute__((ext_vector_type(4)));
#define LAS __attribute__((address_space(3)))

constexpr int DM = 2048, NH = 16, NKV = 4, HD = 128, QKVD = 3072, DFF = 5632, NMETA = 16, NSEQ = 4;
constexpr int TREAL = 49152, MROW0 = TREAL, TTOK = TREAL + NSEQ * NMETA  , TPAD = 49408  ;
constexpr float EPS = 1e-6f;
__host__ __device__ constexpr int seq_S(int s) { return s < 2 ? 8192 : 16384; }
__host__ __device__ constexpr int seq_R0(int s) { return s == 0 ? 0 : s == 1 ? 8192 : s == 2 ? 16384 : 32768; }
__host__ __device__ constexpr int seq_K0(int s) { return s == 0 ? 0 : s == 1 ? 8256 : s == 2 ? 16512 : 32960; }
__host__ __device__ constexpr int seq_Y0(int s) { return s == 0 ? 0 : s == 1 ? 8208 : s == 2 ? 16416 : 32816; }
constexpr int P_N1 = 76, P_N2 = 108, S_N1 = 100, S_N2 = 164;
constexpr int FA_P_J = 160, FA_P_KK = 160, FB_P_J = 224, FB_P_KK = 112, FA_S_J = 224, FA_S_KK = 208, FB_S_J = 352, FB_S_KK = 176;

constexpr size_t MiB = 1u << 20;
constexpr size_t WS_CTL = 0, CTL_ZERO_BYTES = 1 * MiB;
constexpr size_t WS_ROPE = 1 * MiB;
constexpr size_t WS_FC = WS_ROPE + 64 * 1024;
constexpr size_t WS_FA_P = WS_FC + 256 * 1024, WS_FB_P = WS_FA_P + 128 * 1024, WS_FA_S = WS_FB_P + 128 * 1024, WS_FB_S = WS_FA_S + 128 * 1024;
constexpr size_t WS_HMETA = 2 * MiB;
constexpr size_t WS_W = 4 * MiB;
constexpr size_t W_AQKV = 0, W_AWO = W_AQKV + (size_t)QKVD * DM, W_BW = W_AWO + (size_t)DM * DM, W_CIN = W_BW + (size_t)DM * DM, W_COUT = W_CIN + (size_t)3 * DM * DM,
                 W_DQKV = W_COUT + (size_t)DM * DM, W_DWO = W_DQKV + (size_t)QKVD * DM, W_FIN = W_DWO + (size_t)DM * DM, W_FOUT = W_FIN + (size_t)4 * 2 * DFF * DM, W_END = W_FOUT + (size_t)4 * DFF * DM;
constexpr size_t WS_HB = WS_W + 352 * MiB;
constexpr size_t WS_BIG = WS_HB + 193 * MiB;
constexpr size_t BIG_QKV = 0, BIG_KC = 290 * MiB, BIG_VC = 339 * MiB;
constexpr size_t BIG_PO = 400 * MiB, BIG_PML = 410 * MiB;
constexpr size_t BIG_SS = 560 * MiB, BIG_RSTD = 570 * MiB;
constexpr size_t BIG_TAILP = 540 * MiB;
constexpr size_t BIG_ACT = 0;
constexpr size_t BIG_BB = 0, BIG_GB = 193 * MiB;
constexpr size_t BIG_Z = 0, BIG_Y = 385 * MiB;
constexpr size_t WS_END = WS_BIG + 770 * MiB;
static_assert(W_END * 2 <= 352 * MiB && (size_t)TPAD * DM * 2 <= 193 * MiB && (size_t)TPAD * QKVD * 2 <= 290 * MiB && (size_t)TPAD * 512 * 2 <= 49 * MiB, "ws map");
static_assert((size_t)TPAD * DFF * 2 <= 770 * MiB && (size_t)TTOK * 4096 * 2 <= 385 * MiB, "ws map");
constexpr int CW_BAR = 4096;

constexpr int LDS_STAGE = 133120;
constexpr int LDS_MISC = LDS_STAGE;
constexpr int LDS_BYTES = LDS_STAGE + 256;

#define XB_TMO      128
#define XB_XCNT(j)  (256  + 64 * (j))
#define XB_XSUB(j)  (1280 + 64 * (j))
#define XB_XGEN(j)  (2304 + 64 * (j))
#define XB_TOP      3328
#define XB_TOPGEN   3392
#define XCD_BAR_WORDS 3456
#define XB_SPIN_CAP (1u << 18)
__device__ __forceinline__ unsigned xb_ld(unsigned* p)              { return __hip_atomic_load(p, __ATOMIC_RELAXED, __HIP_MEMORY_SCOPE_AGENT); }
__device__ __forceinline__ unsigned xb_add(unsigned* p, unsigned v) { return __hip_atomic_fetch_add(p, v, __ATOMIC_RELAXED, __HIP_MEMORY_SCOPE_AGENT); }
__device__ __forceinline__ unsigned xb_xcc_id() { return (unsigned)__builtin_amdgcn_s_getreg((3 << 11) | 20) & 0xFu; }
#define XB_SPIN(cond, bar) do { unsigned _sp = 0; while (cond) { __builtin_amdgcn_s_sleep(1); \
    if ((++_sp & 255u) == 0u) { if (xb_ld(&(bar)[XB_TMO])) break; if (_sp > XB_SPIN_CAP) { atomicAdd(&(bar)[XB_TMO], 1u); break; } } } } while (0)
struct XcdBarrier { unsigned* bar; unsigned x; volatile LAS unsigned* st; };
__device__ __forceinline__ XcdBarrier xcd_barrier_post(unsigned* bar, volatile LAS unsigned* st) {
    XcdBarrier b; b.bar = bar; b.x = xb_xcc_id(); b.st = st;
    if (threadIdx.x == 0) (void)xb_add(&bar[XB_XCNT(b.x)], 1u);
    return b;
}
__device__ __forceinline__ void xcd_barrier_complete(unsigned* bar, unsigned x, unsigned& nloc, unsigned& nx) {
    const unsigned G = gridDim.x * gridDim.y * gridDim.z;
    unsigned sum, cnt, mine, sp = 0u;
    for (;;) {
        sum = 0u; cnt = 0u; mine = 0u;
#pragma unroll
        for (unsigned j = 0; j < 16; ++j) { const unsigned c = xb_ld(&bar[XB_XCNT(j)]); sum += c; cnt += (c > 0u) ? 1u : 0u; mine = (j == x) ? c : mine; }
        if (sum == G) break;
        __builtin_amdgcn_s_sleep(1);
        if ((++sp & 255u) == 0u) { if (xb_ld(&bar[XB_TMO])) break; if (sp > XB_SPIN_CAP) { atomicAdd(&bar[XB_TMO], 1u); break; } }
    }
    nloc = mine > 0u ? mine : 1u; nx = cnt > 0u ? cnt : 1u;
}
__device__ __forceinline__ void xcd_barrier(const XcdBarrier& b) {
    asm volatile("s_waitcnt vmcnt(0)" ::: "memory");
    __syncthreads();
    if (threadIdx.x == 0) {
        unsigned* bar = b.bar;
        __builtin_amdgcn_s_waitcnt(0);
        unsigned nloc = b.st[0], nx = b.st[1];
        if (nloc == 0u) { xcd_barrier_complete(bar, b.x, nloc, nx); b.st[0] = nloc; b.st[1] = nx; }
        const unsigned old = xb_add(&bar[XB_XSUB(b.x)], 1u);
        const unsigned gen = old / nloc;
        if (old + 1u == (gen + 1u) * nloc) {
            __builtin_amdgcn_fence(__ATOMIC_RELEASE, "agent");
            asm volatile("s_waitcnt vmcnt(0)" ::: "memory");
            const unsigned og = xb_add(&bar[XB_TOP], 1u);
            const unsigned tg = og / nx;
            if (og + 1u == (tg + 1u) * nx) xb_add(&bar[XB_TOPGEN], 1u);
            else XB_SPIN(xb_ld(&bar[XB_TOPGEN]) == tg, bar);
            __builtin_amdgcn_fence(__ATOMIC_ACQUIRE, "agent");
            xb_add(&bar[XB_XGEN(b.x)], 1u);
            asm volatile("s_waitcnt vmcnt(0)" ::: "memory");
        } else {
            XB_SPIN(xb_ld(&bar[XB_XGEN(b.x)]) == gen, bar);
            __builtin_amdgcn_fence(__ATOMIC_ACQUIRE, "agent");
            asm volatile("s_waitcnt vmcnt(0)" ::: "memory");
        }
    }
    __syncthreads();
}

struct Job { const float* src; u16* dst; const float* gain; int K, ld, col0, ncols, split, mult, roff, item0; };
struct Params {
    const float* in[20]; float* out; unsigned char* ws;
    int ph_lo, ph_hi;
};
enum { I_XP = 0, I_XS, I_META, I_LNMIX, I_LNFFN, I_AWQKV, I_AQN, I_AKN, I_AWO, I_BW, I_CWIN, I_CCONV, I_CWOUT, I_DWQKV, I_DQN, I_DKN, I_DSINK, I_DWO, I_FIN, I_FOUT };

#define GAS __attribute__((address_space(1)))
#define LAUNDER_PTR(T, name, src) GAS char* name##_g = (GAS char*)(src); asm volatile("" : "+s"(name##_g)); T name = (T)name##_g
template <int M> __device__ __forceinline__ float swz_xor(float v) { return __int_as_float(__builtin_amdgcn_ds_swizzle(__float_as_int(v), 0x1f | (M << 10))); }
__device__ __forceinline__ float wave_sum(float v) {
    v += swz_xor<1>(v); v += swz_xor<2>(v); v += swz_xor<4>(v); v += swz_xor<8>(v); v += swz_xor<16>(v);
    const auto rr = __builtin_amdgcn_permlane32_swap(__float_as_uint(v), __float_as_uint(v), false, false);
    return __uint_as_float(rr[0]) + __uint_as_float(rr[1]);
}
__device__ __forceinline__ unsigned pk2(float lo, float hi) { unsigned r; asm volatile("v_cvt_pk_bf16_f32 %0, %1, %2" : "=v"(r) : "v"(lo), "v"(hi)); return r; }
__device__ __forceinline__ float bflo(unsigned w) { return __uint_as_float(w << 16); }
__device__ __forceinline__ float bfhi(unsigned w) { return __uint_as_float(w & 0xffff0000u); }
__device__ __forceinline__ int rowmap(int s, int l) { return l < NMETA ? MROW0 + NMETA * s + l : seq_R0(s) + l - NMETA; }

__device__ __forceinline__ void transpose_item(const Job& jb, LAS float* scr, int item, int lane) {
    const int nblk = jb.ncols / 64, kb = item / nblk, nb = item % nblk, k0 = 64 * kb, n0 = 64 * nb;
    const float* W = jb.src + jb.col0;
#pragma unroll 8
    for (int kk = 0; kk < 64; ++kk) scr[kk * 65 + lane] = W[(size_t)(k0 + kk) * jb.ld + n0 + lane];
    asm volatile("s_waitcnt lgkmcnt(0)" ::: "memory");
    const int c = lane & 7;
    f32x4 ga = {1.f, 1.f, 1.f, 1.f}, gb = ga;
    if (jb.gain) { ga = *(const f32x4*)(jb.gain + k0 + 8 * c); gb = *(const f32x4*)(jb.gain + k0 + 8 * c + 4); }
#pragma unroll
    for (int j = 0; j < 8; ++j) { const int n = (lane >> 3) + 8 * j; const LAS float* s = scr + (8 * c) * 65 + n;
        u32x4 o; o.x = pk2(s[0 * 65] * ga.x, s[1 * 65] * ga.y); o.y = pk2(s[2 * 65] * ga.z, s[3 * 65] * ga.w); o.z = pk2(s[4 * 65] * gb.x, s[5 * 65] * gb.y); o.w = pk2(s[6 * 65] * gb.z, s[7 * 65] * gb.w);
        const int nn = n0 + n; int drow;
        if (jb.mult == 1) drow = jb.roff + nn;
        else { const int part = nn / jb.split, jj = nn % jb.split, o = jj & 127;
            drow = jb.roff + (jj >> 7) * 256 + ((o >> 2) & 1) * 128 + (o >> 5) * 32 + ((o >> 3) & 3) * 8 + (o & 3) * 2 + part; }
        *(u32x4*)(jb.dst + (size_t)drow * jb.K + k0 + 8 * c) = o; }
    asm volatile("s_waitcnt lgkmcnt(0)" ::: "memory");
}
__device__ __forceinline__ u16 f2bf(float f) { return (u16)(pk2(f, f) & 0xffffu); }
__device__ __forceinline__ void gen_FA(u16* F, int N1, int Jp, int KKp, int gt, int ngt) {
    for (int e = gt; e < KKp * Jp; e += ngt) { const int kk = e / Jp, j = e % Jp; float v = 0.f;
        if (kk < 2 * N1 && j < 2 * N1) { const int po = kk >= N1, pi = j >= N1, k1 = kk - po * N1, l1 = j - pi * N1; float sn, cs; sincospif(2.0f * (float)((k1 * l1) % N1) / (float)N1, &sn, &cs);
            v = (po == pi) ? cs : (po ? -sn : sn); }
        F[e] = f2bf(v); }
}
__device__ __forceinline__ void gen_FB(u16* F, int N2, int Jp, int KKp, float scale, int gt, int ngt) {
    for (int e = gt; e < KKp * Jp; e += ngt) { const int kk = e / Jp, j = e % Jp; float v = 0.f;
        if (kk < N2 && j < 2 * N2) { const int pi = j >= N2, l2 = j - pi * N2; float sn, cs; sincospif(2.0f * (float)((kk * l2) % N2) / (float)N2, &sn, &cs); v = (pi ? sn : cs) * scale; }
        F[e] = f2bf(v); }
}
__device__ __forceinline__ void prologue_phase(const Params& P, LAS unsigned char* lds, int wave_, int lane_) {
    int tid_q = threadIdx.x; asm volatile("" : "+v"(tid_q)); const int lane = tid_q & 63, wave = __builtin_amdgcn_readfirstlane(tid_q >> 6); (void)lane_; (void)wave_;
    LAUNDER_PTR(unsigned char*, ws, P.ws);
    LAS float* scr = (LAS float*)(lds + wave * 16640);
    const int gw = blockIdx.x * 8 + wave, NGW = gridDim.x * 8;
    u16* Wb = (u16*)(ws + WS_W);
    constexpr int IT_S = 32 * 32  , IT_QKV = 32 * 48, IT_CU = 32 * 64, IT_FIN = 32 * 176, IT_FOUT = 88 * 32;
    constexpr int O1 = IT_QKV, O2 = O1 + IT_S, O3 = O2 + IT_S, O4 = O3 + IT_S, O5 = O4 + IT_CU, O6 = O5 + IT_S, O7 = O6 + IT_QKV, O8 = O7 + IT_S, O9 = O8 + 4 * IT_FIN, O10 = O9 + 4 * IT_FOUT;
    for (int it = gw; it < O10; it += NGW) {
        Job jb;
        if (it < O1)      jb = Job{P.in[I_AWQKV], Wb + W_AQKV, P.in[I_LNMIX], DM, QKVD, 0, QKVD, QKVD, 1, 0, 0};
        else if (it < O2) jb = Job{P.in[I_AWO], Wb + W_AWO, nullptr, DM, DM, 0, DM, DM, 1, 0, O1};
        else if (it < O3) jb = Job{P.in[I_BW], Wb + W_BW, nullptr, DM, DM, 0, DM, DM, 1, 0, O2};
        else if (it < O4) jb = Job{P.in[I_CWIN], Wb + W_CIN, P.in[I_LNMIX] + 2 * DM, DM, 3 * DM, 0, DM, DM, 1, 0, O3};
        else if (it < O5) jb = Job{P.in[I_CWIN], Wb + W_CIN, P.in[I_LNMIX] + 2 * DM, DM, 3 * DM, DM, 2 * DM, DM, 2, DM, O4};
        else if (it < O6) jb = Job{P.in[I_CWOUT], Wb + W_COUT, nullptr, DM, DM, 0, DM, DM, 1, 0, O5};
        else if (it < O7) jb = Job{P.in[I_DWQKV], Wb + W_DQKV, P.in[I_LNMIX] + 3 * DM, DM, QKVD, 0, QKVD, QKVD, 1, 0, O6};
        else if (it < O8) jb = Job{P.in[I_DWO], Wb + W_DWO, nullptr, DM, DM, 0, DM, DM, 1, 0, O7};
        else if (it < O9) { const int l = (it - O8) / IT_FIN; jb = Job{P.in[I_FIN] + (size_t)l * DM * 2 * DFF, Wb + W_FIN + (size_t)l * 2 * DFF * DM, P.in[I_LNFFN] + l * DM, DM, 2 * DFF, 0, 2 * DFF, DFF, 2, 0, O8 + l * IT_FIN}; }
        else { const int l = (it - O9) / IT_FOUT; jb = Job{P.in[I_FOUT] + (size_t)l * DFF * DM, Wb + W_FOUT + (size_t)l * DFF * DM, nullptr, DFF, DM, 0, DM, DM, 1, 0, O9 + l * IT_FOUT}; }
        transpose_item(jb, scr, it - jb.item0, lane);
    }
    const int gt = blockIdx.x * 512 + threadIdx.x, ngt = gridDim.x * 512;
    { float2* tab = (float2*)(ws + WS_ROPE);
      for (int e = gt; e < 256 * 32; e += ngt) { const int pos = e >> 5, i = e & 31; const double ang = (double)pos * pow(10000.0, -(double)i / 32.0); tab[e] = make_float2((float)cos(ang), (float)sin(ang)); } }
    { u16* fc = (u16*)(ws + WS_FC);
      for (int e = gt; e < 512 * 256; e += ngt) { const int n = e >> 8, c = e & 255, cp = n & 255; float sn, cs; sincospif(2.0f * (float)((c * cp) & 255) / 256.0f, &sn, &cs); fc[e] = f2bf(n < 256 ? cs : -sn); } }
    gen_FA((u16*)(ws + WS_FA_P), P_N1, FA_P_J, FA_P_KK, gt, ngt);
    gen_FA((u16*)(ws + WS_FA_S), S_N1, FA_S_J, FA_S_KK, gt, ngt);
    gen_FB((u16*)(ws + WS_FB_P), P_N2, FB_P_J, FB_P_KK, 1.0f / sqrtf(256.0f * 8208.0f), gt, ngt);
    gen_FB((u16*)(ws + WS_FB_S), S_N2, FB_S_J, FB_S_KK, 1.0f / sqrtf(256.0f * 16400.0f), gt, ngt);
}

template <bool EMBED>
__device__ __forceinline__ void norm_phase(const Params& P, const float* gain, int nks  , int wave_, int lane_) {
    int tid_q = threadIdx.x; asm volatile("" : "+v"(tid_q)); const int lane = tid_q & 63, wave = __builtin_amdgcn_readfirstlane(tid_q >> 6); (void)lane_; (void)wave_;
    LAUNDER_PTR(unsigned char*, ws, P.ws);
    LAUNDER_PTR(float*, outp, P.out); u16* X = (u16*)outp; u16* HB = (u16*)(ws + WS_HB); float* hmeta = (float*)(ws + WS_HMETA);
    const int gw = blockIdx.x * 8 + wave, NGW = gridDim.x * 8;
    LAUNDER_PTR(const float*, gainp, gain);
    f32x4 g[8];
#pragma unroll
    for (int j = 0; j < 8; ++j) g[j] = ((const f32x4*)gainp)[lane + 64 * j];
    for (int r = gw; r < TTOK; r += NGW) {
        f32x4 v[8];
        if (r < TREAL) {
            if (EMBED) { const float* src = r < 16384 ? P.in[I_XP] + (size_t)r * DM : P.in[I_XS] + (size_t)(r - 16384) * DM;
#pragma unroll
                for (int j = 0; j < 8; ++j) v[j] = ((const f32x4*)src)[lane + 64 * j];
                u32x2* hb = (u32x2*)(HB + (size_t)r * DM);
#pragma unroll
                for (int j = 0; j < 8; ++j) { u32x2 w; w.x = pk2(v[j].x, v[j].y); w.y = pk2(v[j].z, v[j].w); hb[lane + 64 * j] = w;
                    v[j] = (f32x4){bflo(w.x), bfhi(w.x), bflo(w.y), bfhi(w.y)}; }
            } else { const u32x2* hb = (const u32x2*)(HB + (size_t)r * DM);
#pragma unroll
                for (int j = 0; j < 8; ++j) { const u32x2 w = hb[lane + 64 * j]; v[j] = (f32x4){bflo(w.x), bfhi(w.x), bflo(w.y), bfhi(w.y)}; } }
        } else {
            float* hdst = hmeta + (size_t)(r - TREAL) * DM; const float* src = EMBED ? P.in[I_META] + (size_t)((r - TREAL) & 15) * DM : hdst;
#pragma unroll
            for (int j = 0; j < 8; ++j) v[j] = ((const f32x4*)src)[lane + 64 * j];
            if (!EMBED) {
                const float* tp = (const float*)(ws + WS_BIG + BIG_TAILP) + (size_t)(r - TREAL) * DM;
                for (int ks = 0; ks < nks; ++ks) {
#pragma unroll
                    for (int j = 0; j < 8; ++j) v[j] += ((const f32x4*)(tp + (size_t)ks * 64 * DM))[lane + 64 * j]; }
            }
#pragma unroll
            for (int j = 0; j < 8; ++j) ((f32x4*)hdst)[lane + 64 * j] = v[j];
        }
        float ss = 0.f;
#pragma unroll
        for (int j = 0; j < 8; ++j) ss += (v[j].x * v[j].x + v[j].y * v[j].y) + (v[j].z * v[j].z + v[j].w * v[j].w);
        const float rstd = 1.0f / sqrtf(wave_sum(ss) * (1.0f / DM) + EPS);
        u32x2* o = (u32x2*)(X + (size_t)r * DM);
#pragma unroll
        for (int j = 0; j < 8; ++j) { u32x2 w; w.x = pk2(v[j].x * rstd * g[j].x, v[j].y * rstd * g[j].y); w.y = pk2(v[j].z * rstd * g[j].z, v[j].w * rstd * g[j].w); o[lane + 64 * j] = w; }
    }
}

__device__ __forceinline__ void embed_phase(const Params& P) {
    int tid_q = threadIdx.x; asm volatile("" : "+v"(tid_q)); const int lane = tid_q & 63, wave = __builtin_amdgcn_readfirstlane(tid_q >> 6);
    LAUNDER_PTR(unsigned char*, ws, P.ws);
    u16* HB = (u16*)(ws + WS_HB); float* hmeta = (float*)(ws + WS_HMETA); float* rstdp = (float*)(ws + WS_BIG + BIG_RSTD);
    const int gw = blockIdx.x * 8 + wave, NGW = gridDim.x * 8;
    for (int r = gw; r < TTOK; r += NGW) {
        const float* src = r < 16384 ? P.in[I_XP] + (size_t)r * DM : r < TREAL ? P.in[I_XS] + (size_t)(r - 16384) * DM : P.in[I_META] + (size_t)((r - TREAL) & 15) * DM;
        f32x4 v[8]; float ss = 0.f;
#pragma unroll
        for (int j = 0; j < 8; ++j) v[j] = ((const f32x4*)src)[lane + 64 * j];
        if (r >= TREAL) {
#pragma unroll
            for (int j = 0; j < 8; ++j) ((f32x4*)(hmeta + (size_t)(r - TREAL) * DM))[lane + 64 * j] = v[j];
        }
        u32x2* hb = (u32x2*)(HB + (size_t)r * DM);
#pragma unroll
        for (int j = 0; j < 8; ++j) { u32x2 w; w.x = pk2(v[j].x, v[j].y); w.y = pk2(v[j].z, v[j].w); hb[lane + 64 * j] = w;
            ss += (v[j].x * v[j].x + v[j].y * v[j].y) + (v[j].z * v[j].z + v[j].w * v[j].w); }
        const float rstd = 1.0f / sqrtf(wave_sum(ss) * (1.0f / DM) + EPS);
        if (lane == 0) rstdp[r] = rstd;
    }
}
__device__ __forceinline__ void stats_phase(const Params& P, int nks) {
    int tid_q = threadIdx.x; asm volatile("" : "+v"(tid_q)); const int lane = tid_q & 63, wave = __builtin_amdgcn_readfirstlane(tid_q >> 6);
    LAUNDER_PTR(unsigned char*, ws, P.ws);
    u16* HB = (u16*)(ws + WS_HB); float* hmeta = (float*)(ws + WS_HMETA); float* rstdp = (float*)(ws + WS_BIG + BIG_RSTD); const float* SS = (const float*)(ws + WS_BIG + BIG_SS);
    for (int r = blockIdx.x * 512 + tid_q; r < TREAL; r += gridDim.x * 512) {
        float s = 0.f, pv[32];
#pragma unroll
        for (int j = 0; j < 32; ++j) pv[j] = SS[(size_t)j * TREAL + r];
        __builtin_amdgcn_sched_barrier(0);
#pragma unroll
        for (int j = 0; j < 32; j += 4) s += (pv[j] + pv[j + 1]) + (pv[j + 2] + pv[j + 3]);
        rstdp[r] = 1.0f / sqrtf(s * (1.0f / DM) + EPS);
    }
    const int gw = blockIdx.x * 8 + wave;
    const int mrow = (int)(gridDim.x * 8) - 1 - gw;
    if (mrow < NSEQ * NMETA) {
        float* hrow = hmeta + (size_t)mrow * DM; const float* tp = (const float*)(ws + WS_BIG + BIG_TAILP) + (size_t)mrow * DM;
        f32x4 v[8]; float ss = 0.f;
#pragma unroll
        for (int j = 0; j < 8; ++j) v[j] = ((const f32x4*)hrow)[lane + 64 * j];
        for (int ks = 0; ks < nks; ++ks) {
#pragma unroll
            for (int j = 0; j < 8; ++j) v[j] += ((const f32x4*)(tp + (size_t)ks * 64 * DM))[lane + 64 * j]; }
        u32x2* hb = (u32x2*)(HB + (size_t)(TREAL + mrow) * DM);
#pragma unroll
        for (int j = 0; j < 8; ++j) { ((f32x4*)hrow)[lane + 64 * j] = v[j]; u32x2 w; w.x = pk2(v[j].x, v[j].y); w.y = pk2(v[j].z, v[j].w); hb[lane + 64 * j] = w;
            ss += (v[j].x * v[j].x + v[j].y * v[j].y) + (v[j].z * v[j].z + v[j].w * v[j].w); }
        const float rstd = 1.0f / sqrtf(wave_sum(ss) * (1.0f / DM) + EPS);
        if (lane == 0) rstdp[TREAL + mrow] = rstd;
    }
}

__device__ __forceinline__ size_t kc_off(int s, int kvh, int lrow) { return ((size_t)seq_K0(s) * 4 + (size_t)kvh * (64 + seq_S(s)) + lrow) * HD; }
template <bool ROPE>
__device__ __forceinline__ void qkprep_phase(const Params& P, const float* qgain, const float* kgain, int wave_, int lane_) {
    int tid_q = threadIdx.x; asm volatile("" : "+v"(tid_q)); const int lane = tid_q & 63, wave = __builtin_amdgcn_readfirstlane(tid_q >> 6); (void)lane_; (void)wave_;
    LAUNDER_PTR(unsigned char*, ws, P.ws);
    u16* QKV = (u16*)(ws + WS_BIG + BIG_QKV); u16* Kc = (u16*)(ws + WS_BIG + BIG_KC); u16* Vc = (u16*)(ws + WS_BIG + BIG_VC);
    const float2* tab = (const float2*)(ws + WS_ROPE);
    const int gw = blockIdx.x * 8 + wave, NGW = gridDim.x * 8;
    const int li = lane & 15, hg = lane >> 4;
    float qg[8], kg[8];
#pragma unroll
    for (int e = 0; e < 8; ++e) { qg[e] = qgain[8 * li + e]; kg[e] = kgain[8 * li + e]; }
    __syncthreads();
#define QK_GLD(dst_, ptr_) asm volatile("global_load_dwordx4 %0, %1, off" : "=v"(dst_) : "v"(ptr_) : "memory")
#define QK_ROWINFO(r_, krow_, rowpos_, colpos_, s_) do { if ((r_) < TREAL) { s_ = (r_) < 8192 ? 0 : (r_) < 16384 ? 1 : (r_) < 32768 ? 2 : 3; const int p_ = (r_) - seq_R0(s_); krow_ = 64 + p_; rowpos_ = p_ >> 6; colpos_ = p_ & 63; } \
        else { const int m_ = (r_) - TREAL; s_ = m_ >> 4; krow_ = m_ & 15; rowpos_ = 0; colpos_ = 0; } } while (0)
#define QK_LOADROW(buf_, tb_, r_) do { int kr_, rp_, cp_, s2_; QK_ROWINFO(r_, kr_, rp_, cp_, s2_); (void)kr_; (void)s2_; const u16* q_ = QKV + (size_t)(r_) * QKVD; \
        _Pragma("unroll") for (int it = 0; it < 5; ++it) QK_GLD(buf_[it], q_ + (it * 4 + hg) * HD + 8 * li); QK_GLD(buf_[5], q_ + 2560 + 8 * lane); \
        if (ROPE) { const int pos_ = (li & 8) ? cp_ : rp_; const float2* t_ = tab + pos_ * 32 + 8 * (li & 3); _Pragma("unroll") for (int e = 0; e < 4; ++e) QK_GLD(tb_[e], t_ + 2 * e); } } while (0)
    u32x4 cb[6], nb[6], ct[4], nt[4];
#define QK_ROW(CB, CT, NB, NT, WAIT0) do { \
        const int rn = r + NGW; \
        if (WAIT0) asm volatile("s_waitcnt vmcnt(0)" ::: "memory"); else asm volatile("s_waitcnt vmcnt(6)" ::: "memory");     \
        _Pragma("unroll") for (int i = 0; i < 6; ++i) asm volatile("" : "+v"(CB[i])); \
        if (ROPE) { _Pragma("unroll") for (int i = 0; i < 4; ++i) asm volatile("" : "+v"(CT[i])); } \
        if (rn < TTOK) QK_LOADROW(NB, NT, rn); \
        int krow, rowpos, colpos, s; QK_ROWINFO(r, krow, rowpos, colpos, s); (void)rowpos; (void)colpos; \
        u16* qrow = QKV + (size_t)r * QKVD; \
        float cs[8], sn[8]; \
        if (ROPE) { _Pragma("unroll") for (int e = 0; e < 4; ++e) { cs[2 * e] = __uint_as_float(CT[e].x); sn[2 * e] = __uint_as_float(CT[e].y); cs[2 * e + 1] = __uint_as_float(CT[e].z); sn[2 * e + 1] = __uint_as_float(CT[e].w); } } \
        _Pragma("unroll") for (int it = 0; it < 5; ++it) { \
            u16* ptr = qrow + (it * 4 + hg) * HD + 8 * li; \
            const u32x4 w = CB[it]; \
            float x[8] = {bflo(w.x), bfhi(w.x), bflo(w.y), bfhi(w.y), bflo(w.z), bfhi(w.z), bflo(w.w), bfhi(w.w)}; \
            float ss = 0.f; \
            _Pragma("unroll") for (int e = 0; e < 8; ++e) ss += x[e] * x[e]; \
            ss += swz_xor<1>(ss); ss += swz_xor<2>(ss); ss += swz_xor<4>(ss); ss += swz_xor<8>(ss); \
            const float rs = 1.0f / sqrtf(ss * (1.0f / HD) + EPS); \
            float y[8]; \
            _Pragma("unroll") for (int e = 0; e < 8; ++e) y[e] = x[e] * rs * (it < 4 ? qg[e] : kg[e]); \
            if (ROPE) { _Pragma("unroll") for (int e = 0; e < 8; ++e) { const float yp = swz_xor<4>(y[e]); y[e] = (li & 4) ? (yp * sn[e] + y[e] * cs[e]) : (y[e] * cs[e] - yp * sn[e]); } } \
            u32x4 o; o.x = pk2(y[0], y[1]); o.y = pk2(y[2], y[3]); o.z = pk2(y[4], y[5]); o.w = pk2(y[6], y[7]); \
            if (it < 4) *(u32x4*)ptr = o; \
            else *(u32x4*)(Kc + kc_off(s, hg, krow) + 8 * li) = o; \
        } \
        *(u32x4*)(Vc + kc_off(s, lane >> 4, krow) + 8 * (lane & 15)) = CB[5]; \
    } while (0)
    int r = gw;
    if (r < TTOK) { QK_LOADROW(cb, ct, r); QK_ROW(cb, ct, nb, nt, true); r += NGW; }
    for (; r < TTOK; r += 2 * NGW) {
        QK_ROW(nb, nt, cb, ct, false);
        r += NGW; if (r >= TTOK) break;
        QK_ROW(cb, ct, nb, nt, false);
        r -= NGW;
    }
#undef QK_ROW
    for (int mrow = gw; mrow < 4 * NMETA; mrow += NGW) { const int s = mrow >> 4, mi = mrow & 15; const u32x4 z = {0u, 0u, 0u, 0u};
#pragma unroll
        for (int q = 0; q < 3; ++q) { const size_t pr = kc_off(s, lane >> 4, 16 + 3 * mi + q) + 8 * (lane & 15); *(u32x4*)(Kc + pr) = z; *(u32x4*)(Vc + pr) = z; } }
#undef QK_GLD
#undef QK_ROWINFO
#undef QK_LOADROW
}

template <int MODE>
__device__ __forceinline__ void attn_phase(const Params& P, const float* sinks, char* lds, int wave_, int lane_) {
    int tid_q = threadIdx.x; asm volatile("" : "+v"(tid_q)); const int lane = tid_q & 63, wave = __builtin_amdgcn_readfirstlane(tid_q >> 6); (void)lane_; (void)wave_;
    LAUNDER_PTR(unsigned char*, ws, P.ws);
    const u16* QKV = (const u16*)(ws + WS_BIG + BIG_QKV); const u16* Kc = (const u16*)(ws + WS_BIG + BIG_KC); const u16* Vc = (const u16*)(ws + WS_BIG + BIG_VC);
    LAUNDER_PTR(float*, outp, P.out); u16* X = (u16*)outp;
    const int r32 = lane & 31, hi = lane >> 5, G = gridDim.x;
    constexpr int NITEMS = (MODE == 0) ? 3072 + 240 : 3088;
    for (int e = blockIdx.x; e < NITEMS; e += G) {
        int s, kvh, hgp = 0, qb = 0, chunk = 0, y = 0; bool meta = false;
        if (e < 2048) { const int k = e >> 8, bb = e & 255, x = bb & 7, i = bb >> 3, id = i + 32 * k; s = 2 + (x >> 2); kvh = x & 3; hgp = id >> 6; qb = id & 63; }
        else if (e < 3072) { const int e2 = e - 2048, k = e2 >> 8, bb = e2 & 255, x = bb & 7, i = bb >> 3, id = i + 32 * k; s = x >> 2; kvh = x & 3; hgp = id >> 5; qb = id & 31; }
        else { const int e3 = e - 3072; if (MODE == 0) { y = e3 / 15; chunk = e3 - 15 * y; } else y = e3; const int x = y & 7; s = (y < 8 ? 0 : 2) + (x >> 2); kvh = x & 3; meta = true; }
        const int S = seq_S(s);
        const u16* Kh = Kc + kc_off(s, kvh, 0); const u16* Vh = Vc + kc_off(s, kvh, 0);
        const u16* Qw; u16* Ow; int NT, ktlo = 0, tq = 0, head; bool store = true, mask0 = true; float* po = nullptr; float* pml = nullptr;
        if (!meta) {
            head = kvh * 4 + hgp; const int row = seq_R0(s) + 256 * qb + 32 * wave;
            Qw = QKV + (size_t)(row + r32) * QKVD + head * HD + hi * 8; Ow = X + (size_t)row * DM + head * HD;
            if (MODE == 0) NT = 1 + S / 64;
            else { const int t0 = 4 * qb - 2 < 0 ? 0 : 4 * qb - 2, t1 = 4 * qb + 5 > S / 64 - 1 ? S / 64 - 1 : 4 * qb + 5; ktlo = t0; NT = 2 + t1 - t0; tq = 256 * qb + 32 * wave + r32; }
        } else {
            const int w1 = wave & 1, gl = r32 >> 4, mi = r32 & 15; head = kvh * 4 + 2 * w1 + gl; store = wave < 2;
            Qw = QKV + (size_t)(MROW0 + NMETA * s + mi) * QKVD + head * HD + hi * 8; Ow = X + (size_t)(MROW0 + NMETA * s) * DM + (kvh * 4 + 2 * w1) * HD;
            if (MODE == 0) {
                if (s < 2) { ktlo = chunk < 12 ? 9 * chunk : 108 + 7 * (chunk - 12); NT = chunk < 12 ? 9 : 7; } else { ktlo = 17 * chunk; NT = chunk < 14 ? 17 : 19; }
                mask0 = (chunk == 0);
                po = (float*)(ws + WS_BIG + BIG_PO) + ((size_t)(y * 15 + chunk) * 64 + 32 * w1) * 128; pml = (float*)(ws + WS_BIG + BIG_PML) + ((size_t)(y * 15 + chunk) * 64 + 32 * w1) * 2;
            } else { NT = 3; tq = 112 + mi; }
        }
        float slopeS = 0.f, sinkL2 = 0.f;
        if (MODE == 1) { slopeS = exp2f(-0.5f * (float)(head + 1)) * (1.0f / att::SCALE); slopeS = __int_as_float(__builtin_amdgcn_readfirstlane(__float_as_int(slopeS)));
            sinkL2 = sinks[head] * 1.4426950408889634f; }
        att::attn_item<MODE>(Qw, Kh, Vh, Ow, meta, store, NT, ktlo, tq, slopeS, sinkL2, lds, mask0, po, pml);
    }
}
__device__ __forceinline__ void metacombine_phase(const Params& P) {
    int tid_q = threadIdx.x; asm volatile("" : "+v"(tid_q)); const int lane = tid_q & 63, wave = __builtin_amdgcn_readfirstlane(tid_q >> 6);
    LAUNDER_PTR(unsigned char*, ws, P.ws);
    const float* PO = (const float*)(ws + WS_BIG + BIG_PO); const float* PML = (const float*)(ws + WS_BIG + BIG_PML); LAUNDER_PTR(float*, outp, P.out); u16* X = (u16*)outp;
    constexpr float C = att::SCALE * 1.4426950408889634f;
    for (int it = blockIdx.x * 8 + wave; it < 16 * 64; it += gridDim.x * 8) {
        const int y = it >> 6, rr = it & 63, x = y & 7, s = (y < 8 ? 0 : 2) + (x >> 2), kvh = x & 3, head = kvh * 4 + (rr >> 4), mi = rr & 15;
        float mc[15], lc[15], M = -3e38f;
#pragma unroll
        for (int c = 0; c < 15; ++c) { const float2 v = *(const float2*)(PML + ((size_t)(y * 15 + c) * 64 + rr) * 2); mc[c] = v.x; lc[c] = v.y; M = fmaxf(M, v.x); }
        float L = 0.f, o0 = 0.f, o1 = 0.f;
#pragma unroll
        for (int c = 0; c < 15; ++c) { const float w = __builtin_amdgcn_exp2f((mc[c] - M) * C); L += w * lc[c];
            const float2 ov = *(const float2*)(PO + ((size_t)(y * 15 + c) * 64 + rr) * 128 + 2 * lane); o0 += w * ov.x; o1 += w * ov.y; }
        const float rl = 1.0f / L;
        *(unsigned*)(X + (size_t)(MROW0 + NMETA * s + mi) * DM + head * HD + 2 * lane) = pk2(o0 * rl, o1 * rl);
    }
}

constexpr int DFT_RS = 256;
__device__ __forceinline__ int dft_swz(int j) { return (j & 3) | ((j >> 1) & 4); }
template <int STEP, int N1, int N2, int KS  , int NMB  >
__device__ __forceinline__ void dft_run(const Params& P, size_t f_off, int s0, int boff  , LAS unsigned char* lds, int wave_, int lane_) {
    (void)lane_; (void)wave_;
    LAUNDER_PTR(unsigned char*, ws, P.ws); const u16* F = (const u16*)(ws + f_off);
    constexpr int L = N1 * N2, JP = KS * 32, J = STEP == 0 ? 2 * N1 : 2 * N2, KK = STEP == 0 ? 2 * N1 : N2, NB = STEP == 0 ? N2 : N1  ;
    const u16* Z = (const u16*)(ws + WS_BIG + BIG_Z); u16* Y = (u16*)(ws + WS_BIG + BIG_Y); LAUNDER_PTR(float*, outp, P.out); u16* X = (u16*)outp;
    int tid_l = threadIdx.x; asm volatile("" : "+v"(tid_l));
    const int tid = tid_l, lane = tid_l & 63, wave = __builtin_amdgcn_readfirstlane(tid_l >> 6), fi = tid_l & 15, fg = (tid_l & 63) >> 4; (void)lane;
    bf16x8 Ff[2][KS];
#pragma unroll
    for (int q = 0; q < 2; ++q)
#pragma unroll
        for (int ks = 0; ks < KS; ++ks) { const int mb = wave + 8 * q; Ff[q][ks] = (mb < NMB) ? *(const bf16x8*)(F + (size_t)(mb * 16 + fi) * JP + ks * 32 + 8 * fg) : (bf16x8){0, 0, 0, 0, 0, 0, 0, 0}; }
    for (int c = tid; c < (JP - J) * 16; c += 512) *(LAS u32x4*)(lds + (J + c / 16) * DFT_RS + (c % 16) * 16) = (u32x4){0u, 0u, 0u, 0u};
    const int trrow = (fi >> 2) + 8 * fg;
    const int trbase = trrow * DFT_RS + (fi & 3) * 8, sw0 = dft_swz(trrow) << 5;
    constexpr int NCH = STEP == 0 ? (J * 16 + 511) / 512 : (N2 * 16 + 511) / 512;
    u32x4 sa[NCH], sb[STEP == 0 ? 1 : NCH];
    const int NIT = 2 * NB * 16;
#define DFT_GLD(dst_, ptr_) asm volatile("global_load_dwordx4 %0, %1, off" : "=v"(dst_) : "v"(ptr_) : "memory")
#define DFT_BAR() do { asm volatile("s_waitcnt lgkmcnt(0)" ::: "memory"); __builtin_amdgcn_s_barrier(); } while (0)
    const int nst = 8 * (((wave < NMB && wave * 16 < KK) ? 1 : 0) + ((wave + 8 < NMB && (wave + 8) * 16 < KK) ? 1 : 0));
    int pend = 0;
#define DFT_LOAD(e_) do { const int s_ = s0 + (e_) / (NB * 16), rem_ = (e_) % (NB * 16), beta_ = rem_ >> 4, gh_ = rem_ & 15, colb_ = (gh_ >> 1) * 512 + (gh_ & 1) * 128; \
        _Pragma("unroll") for (int i = 0; i < NCH; ++i) { const int c = tid + 512 * i; \
            if (STEP == 0) { if (c < J * 16) { const int j = c >> 4, ch = c & 15, part = j >= N1, l1 = j - part * N1; DFT_GLD(sa[i], Z + (size_t)rowmap(s_, N2 * l1 + beta_) * 4096 + colb_ + part * 256 + ch * 8); } } \
            else { if (c < N2 * 16) { const int l2 = c >> 4, ch = c & 15; const u16* src = Y + (size_t)(seq_Y0(s_) + beta_ * N2 + l2) * 4096 + colb_ + ch * 8; DFT_GLD(sa[i], src); DFT_GLD(sb[i], src + 256); } } } } while (0)
    __syncthreads();
    int e = (int)((blockIdx.x + (unsigned)boff) % gridDim.x);
    if (e < NIT) DFT_LOAD(e);
    for (; e < NIT; e += gridDim.x) {
        const int s = s0 + e / (NB * 16), rem = e % (NB * 16), beta = rem >> 4, gh = rem & 15, colb = (gh >> 1) * 512 + (gh & 1) * 128;
        DFT_BAR();
        if (pend == 16) asm volatile("s_waitcnt vmcnt(16)" ::: "memory"); else if (pend == 8) asm volatile("s_waitcnt vmcnt(8)" ::: "memory"); else asm volatile("s_waitcnt vmcnt(0)" ::: "memory");
#pragma unroll
        for (int i = 0; i < NCH; ++i) { asm volatile("" : "+v"(sa[i])); if (STEP == 1) asm volatile("" : "+v"(sb[i])); }
        pend = nst;
#pragma unroll
        for (int i = 0; i < NCH; ++i) { const int c = tid + 512 * i;
            if (STEP == 0) { if (c < J * 16) { const int j = c >> 4, ch = c & 15; *(LAS u32x4*)(lds + j * DFT_RS + (((ch >> 1) ^ dft_swz(j)) << 5) + (ch & 1) * 16) = sa[i]; } }
            else if (c < N2 * 16) { const int l2 = c >> 4, ch = c & 15; const u32x4 a = sa[i], b = sb[i];
                float sn, cs; sincospif(2.0f * (float)((beta * l2) % L) / (float)L, &sn, &cs);
                u32x4 ore, oim;
#define TW(F_) { const float r0 = bflo(a.F_), r1 = bfhi(a.F_), i0 = bflo(b.F_), i1 = bfhi(b.F_); ore.F_ = pk2(r0 * cs + i0 * sn, r1 * cs + i1 * sn); oim.F_ = pk2(i0 * cs - r0 * sn, i1 * cs - r1 * sn); }
                TW(x) TW(y) TW(z) TW(w)
#undef TW
                *(LAS u32x4*)(lds + l2 * DFT_RS + (((ch >> 1) ^ dft_swz(l2)) << 5) + (ch & 1) * 16) = ore; *(LAS u32x4*)(lds + (N2 + l2) * DFT_RS + (((ch >> 1) ^ dft_swz(N2 + l2)) << 5) + (ch & 1) * 16) = oim; } }
        DFT_BAR();
        if (e + (int)gridDim.x < NIT) DFT_LOAD(e + (int)gridDim.x);
#pragma unroll
        for (int q = 0; q < 2; ++q) {
            const int mb = wave + 8 * q;
            if (mb < NMB) {
                f32x4 acc[8];
#pragma unroll
                for (int nb = 0; nb < 8; ++nb) acc[nb] = (f32x4){0.f, 0.f, 0.f, 0.f};
#pragma unroll
                for (int ks = 0; ks < KS; ++ks) {
                    LAS unsigned char* ap = lds + trbase + ks * 32 * DFT_RS;
#pragma unroll
                    for (int h = 0; h < 2; ++h) {
                        s16x4 a0[4], a1[4];
#pragma unroll
                        for (int n4 = 0; n4 < 4; ++n4) { const int nb = 4 * h + n4; a0[n4] = __builtin_amdgcn_ds_read_tr16_b64_v4i16((LAS s16x4*)(ap + ((nb * 32) ^ sw0))); a1[n4] = __builtin_amdgcn_ds_read_tr16_b64_v4i16((LAS s16x4*)(ap + ((nb * 32) ^ sw0) + 4 * DFT_RS)); }
#pragma unroll
                        for (int n4 = 0; n4 < 4; ++n4) { const int nb = 4 * h + n4; const bf16x8 af = {a0[n4][0], a0[n4][1], a0[n4][2], a0[n4][3], a1[n4][0], a1[n4][1], a1[n4][2], a1[n4][3]};
                            acc[nb] = __builtin_amdgcn_mfma_f32_16x16x32_bf16(af, Ff[q][ks], acc[nb], 0, 0, 0); }
                    }
                }
                const int kk = mb * 16 + fi;
                if (kk < KK) {
                    u16* dst;
                    if (STEP == 0) { const int part = kk >= N1, k1 = kk - part * N1; dst = Y + (size_t)(seq_Y0(s) + k1 * N2 + beta) * 4096 + colb + part * 256 + 4 * fg; }
                    else { dst = X + (size_t)rowmap(s, beta + N1 * kk) * DM + (gh >> 1) * 256 + (gh & 1) * 128 + 4 * fg; }
#pragma unroll
                    for (int nb = 0; nb < 8; ++nb) { u32x2 w; w.x = pk2(acc[nb][0], acc[nb][1]); w.y = pk2(acc[nb][2], acc[nb][3]); *(u32x2*)(dst + nb * 16) = w; }
                }
            }
        }
    }
#undef DFT_LOAD
#undef DFT_GLD
#undef DFT_BAR
    __syncthreads();
}

__device__ __forceinline__ void conv_phase(const Params& P, const float* cw  , int wave_, int lane_) {
    int tid_q = threadIdx.x; asm volatile("" : "+v"(tid_q)); const int lane = tid_q & 63, wave = __builtin_amdgcn_readfirstlane(tid_q >> 6); (void)lane_; (void)wave_;
    LAUNDER_PTR(unsigned char*, ws, P.ws);
    const u16* Bb = (const u16*)(ws + WS_BIG + BIG_BB); const u16* Gb = (const u16*)(ws + WS_BIG + BIG_GB); LAUNDER_PTR(float*, outp, P.out); u16* X = (u16*)outp;
    const int gw = blockIdx.x * 8 + wave, NGW = gridDim.x * 8;
    f32x4 w0[4][2], w1[4][2], w2[4][2];
#pragma unroll
    for (int j = 0; j < 4; ++j)
#pragma unroll
        for (int h = 0; h < 2; ++h) { const int c = 8 * lane + 512 * j + 4 * h; w0[j][h] = *(const f32x4*)(cw + c); w1[j][h] = *(const f32x4*)(cw + DM + c); w2[j][h] = *(const f32x4*)(cw + 2 * DM + c); }
    const int per = (TTOK + NGW - 1) / NGW, rbeg = gw * per, rend = rbeg + per < TTOK ? rbeg + per : TTOK;
    for (int r = rbeg; r < rend; ++r) {
        int prev, next;
        if (r < TREAL) { const int s = r < 8192 ? 0 : r < 16384 ? 1 : r < 32768 ? 2 : 3; const int p = r - seq_R0(s); prev = p > 0 ? r - 1 : MROW0 + NMETA * s + 15; next = p < seq_S(s) - 1 ? r + 1 : -1; }
        else { const int m = r - TREAL, s = m >> 4, i = m & 15; prev = i > 0 ? r - 1 : -1; next = i < 15 ? r + 1 : seq_R0(s); }
        u32x4 bv[4], g0[4], g1[4], g2[4]; const u32x4 zero = {0u, 0u, 0u, 0u};
#pragma unroll
        for (int j = 0; j < 4; ++j) { const int c = 8 * lane + 512 * j;
            bv[j] = *(const u32x4*)(Bb + (size_t)r * DM + c); g1[j] = *(const u32x4*)(Gb + (size_t)r * DM + c);
            g0[j] = prev >= 0 ? *(const u32x4*)(Gb + (size_t)prev * DM + c) : zero; g2[j] = next >= 0 ? *(const u32x4*)(Gb + (size_t)next * DM + c) : zero; }
#pragma unroll
        for (int j = 0; j < 4; ++j) { const int c = 8 * lane + 512 * j; u32x4 o;
#define CV(F_, H, I0, I1) o.F_ = pk2(bflo(bv[j].F_) * (w0[j][H][I0] * bflo(g0[j].F_) + w1[j][H][I0] * bflo(g1[j].F_) + w2[j][H][I0] * bflo(g2[j].F_)), bfhi(bv[j].F_) * (w0[j][H][I1] * bfhi(g0[j].F_) + w1[j][H][I1] * bfhi(g1[j].F_) + w2[j][H][I1] * bfhi(g2[j].F_)));
            CV(x, 0, 0, 1) CV(y, 0, 2, 3) CV(z, 1, 0, 1) CV(w, 1, 2, 3)
#undef CV
            *(u32x4*)(X + (size_t)r * DM + c) = o; }
    }
}

template <int KIND, int KS = 8>
__device__ __forceinline__ void thin_meta_gemm(const Params& P, size_t w_off, int N, LAS unsigned char* lds) {
    int tid_l = threadIdx.x; asm volatile("" : "+v"(tid_l));
    const int tid = tid_l, lane = tid & 63, wave = __builtin_amdgcn_readfirstlane(tid >> 6), fi = lane & 15, fg = lane >> 4, k0 = wave * (KS * 32);
    constexpr int LDK = KS * 256;
    LAUNDER_PTR(unsigned char*, ws, P.ws); LAUNDER_PTR(float*, outp, P.out);
    const u16* A = (KIND != 3) ? (const u16*)(ws + WS_HB) + (size_t)TREAL * DM : (KS == 8) ? (const u16*)outp + (size_t)TREAL * DM : (const u16*)(ws + WS_BIG) + (size_t)TREAL * DFF;
    const u16* Bt = (const u16*)(ws + WS_W) + w_off; const float* rstd = (const float*)(ws + WS_BIG + BIG_RSTD) + TREAL;
    u16* BIG = (u16*)(ws + WS_BIG);
    LAS float* red = (LAS float*)lds;
    for (int blk = blockIdx.x; blk < N / 16; blk += gridDim.x) {
        const int c0 = blk * 16;
        f32x4 acc[4];
#pragma unroll
        for (int nbk = 0; nbk < 4; ++nbk) acc[nbk] = (f32x4){0.f, 0.f, 0.f, 0.f};
#pragma unroll
        for (int ks = 0; ks < KS; ++ks) {
            const bf16x8 wf = *(const bf16x8*)(Bt + (size_t)(c0 + fi) * LDK + k0 + ks * 32 + 8 * fg);
#pragma unroll
            for (int nbk = 0; nbk < 4; ++nbk) { const bf16x8 af = *(const bf16x8*)(A + (size_t)(nbk * 16 + fi) * LDK + k0 + ks * 32 + 8 * fg);
                acc[nbk] = __builtin_amdgcn_mfma_f32_16x16x32_bf16(wf, af, acc[nbk], 0, 0, 0); }
        }
#pragma unroll
        for (int nbk = 0; nbk < 4; ++nbk)
#pragma unroll
            for (int rg = 0; rg < 4; ++rg) red[((wave * 4 + nbk) * 4 + rg) * 64 + lane] = acc[nbk][rg];
        __syncthreads();
        { const int row = tid & 63, p = tid >> 6, l = (p >> 1) * 16 + (row & 15), nbk = row >> 4, rg = 2 * (p & 1);
          float v0 = 0.f, v1 = 0.f;
#pragma unroll
          for (int w = 0; w < 8; ++w) { v0 += red[((w * 4 + nbk) * 4 + rg) * 64 + l]; v1 += red[((w * 4 + nbk) * 4 + rg + 1) * 64 + l]; }
          const float rs = (KIND == 3) ? 1.0f : rstd[row]; const int c = c0 + 2 * p; const size_t orow = (size_t)(TREAL + row);
          if (KIND == 0) *(unsigned*)(BIG + orow * QKVD + c) = pk2(v0 * rs, v1 * rs);
          else if (KIND == 3) { float* hm = (float*)(ws + WS_HMETA) + (size_t)row * DM + c; const f32x2 h = *(const f32x2*)hm; *(f32x2*)hm = (f32x2){h.x + v0, h.y + v1}; }
          else {
              const bool plain = (KIND == 1) && c < DM; const int cc = (KIND == 1) ? c - DM : c, cl = cc & 255;
              const int o = (cc >> 8) * 128 + ((cl >> 5) & 3) * 32 + ((cl >> 3) & 3) * 8 + (cl >> 7) * 4 + ((cl >> 1) & 3);
              if (plain) *(unsigned*)(BIG + orow * DM + c) = pk2(v0 * rs, v1 * rs);
              else if (KIND == 1) { const float gq = v0 * v1 * rs * rs; ((u16*)(ws + WS_BIG + BIG_GB))[orow * DM + o] = (u16)(pk2(gq, gq) & 0xffffu); }
              else { const float gs = v0 * rs, us = v1 * rs, sv = gs * us * __builtin_amdgcn_rcpf(1.0f + __builtin_amdgcn_exp2f(-1.4426950408889634f * gs)); BIG[orow * DFF + o] = (u16)(pk2(sv, sv) & 0xffffu); }
          } }
        __syncthreads();
    }
}

constexpr int PH_PER_LAYER = 9, N_PHASES = 1 + 4 * PH_PER_LAYER;
#ifndef PH_EN
#define PH_EN 0xffffffffu
#endif
#define EN(k) (((PH_EN) >> (k)) & 1u)
#define RUN(p) (lo <= (p) && (p) < hi)
#ifndef REP_MASK
#define REP_MASK 0u
#endif
#define REP(k) (((REP_MASK) >> (k)) & 1u)
#define SEAM(p) do { if ((p) + 1 < hi) { XcdBarrier b2_ = bar; { GAS unsigned* g_ = (GAS unsigned*)b2_.bar; asm volatile("" : "+s"(g_)); b2_.bar = (unsigned*)g_; } xcd_barrier(b2_); if (REP(15)) xcd_barrier(b2_); } } while (0)
#define SITE_PTRS LAUNDER_PTR(unsigned char*, ws, P.ws); LAUNDER_PTR(float*, outp, P.out); u16* Wb = (u16*)(ws + WS_W); u16* X = (u16*)outp; u16* BIG = (u16*)(ws + WS_BIG); (void)Wb; (void)X; (void)BIG
template <int layer>
__device__ __forceinline__ void run_layer(const Params& P, LAS unsigned char* lds, unsigned char* lds_raw, const XcdBarrier& bar, int lo, int hi, int wave, int lane) {

        const int pb = 1 + layer * PH_PER_LAYER;
        if (EN(1) && RUN(pb + 0)) {
            if (layer == 0) embed_phase(P);
            else if (layer == 1) norm_phase<false>(P, P.in[I_LNMIX] + layer * DM, 0, wave, lane);
            else { stats_phase(P, 0); if (REP(1)) stats_phase(P, 0); }
            SEAM(pb + 0); }
        if (RUN(pb + 1)) {
            if (EN(2) && (layer == 0 || layer == 3)) { thin_meta_gemm<0>(P, layer == 0 ? W_AQKV : W_DQKV, QKVD, lds);
                SITE_PTRS; pg8::Gemm g{(const u16*)(ws + WS_HB), Wb + (layer == 0 ? W_AQKV : W_DQKV), TREAL, QKVD, DM, DM}; pg8::StaticOrder S; S.init(TREAL, QKVD, gridDim.x, blockIdx.x, DM); pg8::EpiPlain E{BIG, QKVD, (const float*)(ws + WS_BIG + BIG_RSTD)};
                pg8::gemm_phase<pg8::EpiPlain, pg8::StaticOrder, true, true>(lds, g, S, E); if (REP(2)) pg8::gemm_phase<pg8::EpiPlain, pg8::StaticOrder, true, true>(lds, g, S, E); }
            else if (EN(2) && layer == 1) { SITE_PTRS; pg8::Gemm g{X, (const u16*)(ws + WS_FC), TTOK * 8, 512, 256, 256}; pg8::StaticOrder S; S.init(TTOK * 8, 512, gridDim.x, blockIdx.x, 256); pg8::EpiPlain E{BIG, 512, nullptr};
                pg8::gemm_phase<pg8::EpiPlain, pg8::StaticOrder, true, true>(lds, g, S, E); if (REP(3)) pg8::gemm_phase<pg8::EpiPlain, pg8::StaticOrder, true, true>(lds, g, S, E); }
            else if (EN(3)) { thin_meta_gemm<1>(P, W_CIN, 3 * DM, lds);
                SITE_PTRS; pg8::Gemm g{(const u16*)(ws + WS_HB), Wb + W_CIN, TREAL, 3 * DM, DM, DM}; pg8::StaticOrder S; S.init(TREAL, 3 * DM, gridDim.x, blockIdx.x, DM); pg8::EpiCin E{BIG, (u16*)(ws + WS_BIG + BIG_GB), (const float*)(ws + WS_BIG + BIG_RSTD)};
                pg8::gemm_phase<pg8::EpiCin, pg8::StaticOrder, true, true>(lds, g, S, E); if (REP(4)) pg8::gemm_phase<pg8::EpiCin, pg8::StaticOrder, true, true>(lds, g, S, E); }
            SEAM(pb + 1);
        }
        if (RUN(pb + 2)) {
            if (EN(4) && layer == 0) qkprep_phase<true>(P, P.in[I_AQN], P.in[I_AKN], wave, lane);
            else if (EN(4) && layer == 3) qkprep_phase<false>(P, P.in[I_DQN], P.in[I_DKN], wave, lane);
            else if (EN(5) && layer == 1) { dft_run<0, P_N1, P_N2, FA_P_J / 32, FA_P_KK / 16>(P, WS_FA_P, 0, 0, lds, wave, lane);
                                   dft_run<0, S_N1, S_N2, FA_S_J / 32, FA_S_KK / 16>(P, WS_FA_S, 2, (int)(gridDim.x - (2 * P_N2 * 16) % gridDim.x), lds, wave, lane);
                if (REP(5)) { dft_run<0, P_N1, P_N2, FA_P_J / 32, FA_P_KK / 16>(P, WS_FA_P, 0, 0, lds, wave, lane); dft_run<0, S_N1, S_N2, FA_S_J / 32, FA_S_KK / 16>(P, WS_FA_S, 2, (int)(gridDim.x - (2 * P_N2 * 16) % gridDim.x), lds, wave, lane); } }
            else if (EN(6)) { conv_phase(P, P.in[I_CCONV], wave, lane); if (REP(6)) conv_phase(P, P.in[I_CCONV], wave, lane); }
            SEAM(pb + 2);
        }
        if (RUN(pb + 3)) {
            if (EN(7) && layer == 0) { attn_phase<0>(P, nullptr, (char*)lds_raw, wave, lane); if (REP(7)) attn_phase<0>(P, nullptr, (char*)lds_raw, wave, lane); }
            else if (EN(8) && layer == 3) { attn_phase<1>(P, P.in[I_DSINK], (char*)lds_raw, wave, lane); if (REP(8)) attn_phase<1>(P, P.in[I_DSINK], (char*)lds_raw, wave, lane); }
            else if (EN(9) && layer == 1) { dft_run<1, P_N1, P_N2, FB_P_J / 32, FB_P_KK / 16>(P, WS_FB_P, 0, 0, lds, wave, lane);
                                   dft_run<1, S_N1, S_N2, FB_S_J / 32, FB_S_KK / 16>(P, WS_FB_S, 2, (int)(gridDim.x - (2 * P_N1 * 16) % gridDim.x), lds, wave, lane);
                if (REP(9)) { dft_run<1, P_N1, P_N2, FB_P_J / 32, FB_P_KK / 16>(P, WS_FB_P, 0, 0, lds, wave, lane); dft_run<1, S_N1, S_N2, FB_S_J / 32, FB_S_KK / 16>(P, WS_FB_S, 2, (int)(gridDim.x - (2 * P_N1 * 16) % gridDim.x), lds, wave, lane); } }
            if (layer != 2) SEAM(pb + 3);
        }
        if (layer == 0 && EN(7) && RUN(pb + 4)) { metacombine_phase(P); SEAM(pb + 4); }
        if (EN(10) && RUN(pb + 5)) {
            SITE_PTRS;
            const size_t wo = layer == 0 ? W_AWO : layer == 1 ? W_BW : layer == 2 ? W_COUT : W_DWO;
            if (layer < 3) thin_meta_gemm<3, 8>(P, wo, DM, lds);
            { pg8::Gemm g{X, Wb + wo, TREAL, DM, DM, DM}; pg8::StaticOrder S; S.init(TREAL, DM, gridDim.x, blockIdx.x, DM); const pg8::EpiResidB E{(u16*)(ws + WS_HB), (float*)(ws + WS_BIG + BIG_SS)};
              pg8::gemm_phase<pg8::EpiResidB, pg8::StaticOrder, true, true>(lds, g, S, E); }
            if (REP(10)) { pg8::Gemm g{X, Wb + wo, TREAL, DM, DM, DM}; pg8::StaticOrder S; S.init(TREAL, DM, gridDim.x, blockIdx.x, DM); pg8::EpiPlain E{(u16*)(ws + WS_BIG + 600 * MiB), DM, nullptr};
              pg8::gemm_phase<pg8::EpiPlain, pg8::StaticOrder, true, true>(lds, g, S, E); }
            SEAM(pb + 5);
        }
        if (EN(1) && RUN(pb + 6)) { stats_phase(P, 0); if (REP(1)) stats_phase(P, 0); SEAM(pb + 6); }
        if (EN(11) && RUN(pb + 7)) {
            SITE_PTRS;
            constexpr int MF = TREAL;
            if (layer < 3) thin_meta_gemm<2>(P, W_FIN + (size_t)layer * 2 * DFF * DM, 2 * DFF, lds);
            pg8::Gemm g{(const u16*)(ws + WS_HB), Wb + W_FIN + (size_t)layer * 2 * DFF * DM, MF, 2 * DFF, DM, DM}; pg8::StaticOrder S; S.init(MF, 2 * DFF, gridDim.x, blockIdx.x, DM); pg8::EpiSwiglu E{BIG, DFF, (const float*)(ws + WS_BIG + BIG_RSTD)};
            pg8::gemm_phase<pg8::EpiSwiglu, pg8::StaticOrder, true, true>(lds, g, S, E); if (REP(11)) pg8::gemm_phase<pg8::EpiSwiglu, pg8::StaticOrder, true, true>(lds, g, S, E); if (REP(16)) { pg8::EpiNone E0; pg8::gemm_phase<pg8::EpiNone, pg8::StaticOrder, true, true>(lds, g, S, E0); }
            SEAM(pb + 7);
        }
        if (EN(12) && RUN(pb + 8)) {
            if (layer < 3) thin_meta_gemm<3, 22>(P, W_FOUT + (size_t)layer * DFF * DM, DM, lds);
            SITE_PTRS;
            { pg8::Gemm g{BIG, Wb + W_FOUT + (size_t)layer * DFF * DM, TREAL, DM, DFF, DFF}; pg8::StaticOrder S; S.init(TREAL, DM, gridDim.x, blockIdx.x, DFF); if (layer < 3) { const pg8::EpiResidB E{(u16*)(ws + WS_HB), layer == 0 ? nullptr : (float*)(ws + WS_BIG + BIG_SS)}; pg8::gemm_phase<pg8::EpiResidB, pg8::StaticOrder, true, true>(lds, g, S, E); }
              else { const pg8::EpiResidFinal E{(const u16*)(ws + WS_HB), outp}; pg8::gemm_phase<pg8::EpiResidFinal, pg8::StaticOrder, true, true>(lds, g, S, E); } }
            if (REP(12)) { pg8::Gemm g{BIG, Wb + W_FOUT + (size_t)layer * DFF * DM, TREAL, DM, DFF, DFF}; pg8::StaticOrder S; S.init(TREAL, DM, gridDim.x, blockIdx.x, DFF); pg8::EpiPlain E{X, DM, nullptr};
              pg8::gemm_phase<pg8::EpiPlain, pg8::StaticOrder, true, true>(lds, g, S, E); }
            SEAM(pb + 8);
        }
    }

__global__ void __launch_bounds__(512, 2) encoder_fwd(Params P) {
    extern __shared__ __attribute__((aligned(16))) unsigned char lds_raw[];
    LAS unsigned char* lds = (LAS unsigned char*)lds_raw;
    const int tid = threadIdx.x; constexpr int lane = 0, wave = 0;
    if (tid < 4) ((LAS unsigned*)(lds + LDS_MISC))[tid] = 0u;
    __syncthreads();
    unsigned* barw = (unsigned*)(P.ws + WS_CTL) + CW_BAR;
    XcdBarrier bar = xcd_barrier_post(barw, (volatile LAS unsigned*)(lds + LDS_MISC));
    const int lo = P.ph_lo, hi = P.ph_hi;

    if (EN(0) && RUN(0)) { prologue_phase(P, lds, wave, lane); if (REP(0)) prologue_phase(P, lds, wave, lane); asm volatile("s_waitcnt vmcnt(0) lgkmcnt(0)" ::: "memory"); __syncthreads(); }

    run_layer<0>(P, lds, lds_raw, bar, lo, hi, wave, lane);
    run_layer<1>(P, lds, lds_raw, bar, lo, hi, wave, lane);
    run_layer<2>(P, lds, lds_raw, bar, lo, hi, wave, lane);
    run_layer<3>(P, lds, lds_raw, bar, lo, hi, wave, lane);
#undef SITE_PTRS
#undef RUN
#undef SEAM
}

#ifndef MK_PER_PHASE
#define MK_PER_PHASE 0
#endif
extern "C" void kernel_launch(void* const* d_in, const int* in_sizes, int n_in, void* d_out, int out_size, void* d_ws, size_t ws_size, hipStream_t stream) {
    static int grid = 0;
    if (grid == 0) {
        if (n_in != 20 || out_size != TREAL * DM || ws_size < WS_END) { fprintf(stderr, "kernel_launch: unexpected shapes: n_in %d out %d ws %zu (need %zu)\n", n_in, out_size, ws_size, (size_t)WS_END); grid = -1; return; }
        int dev = 0, cus = 0, per_cu = 0;
        if (hipGetDevice(&dev) != hipSuccess || hipDeviceGetAttribute(&cus, hipDeviceAttributeMultiprocessorCount, dev) != hipSuccess) { grid = -1; return; }
        if (hipFuncSetAttribute((const void*)encoder_fwd, hipFuncAttributeMaxDynamicSharedMemorySize, LDS_BYTES) != hipSuccess) { fprintf(stderr, "kernel_launch: hipFuncSetAttribute failed\n"); grid = -1; return; }
        if (hipOccupancyMaxActiveBlocksPerMultiprocessor(&per_cu, (const void*)encoder_fwd, 512, LDS_BYTES) != hipSuccess || per_cu < 1) { fprintf(stderr, "kernel_launch: occupancy query says %d blocks per CU\n", per_cu); (void)hipGetLastError(); grid = -1; return; }
        grid = cus;
    }
    if (grid < 0) return;
    (void)in_sizes;
    if (hipMemsetAsync((char*)d_ws + WS_CTL, 0, CTL_ZERO_BYTES, stream) != hipSuccess) { fprintf(stderr, "kernel_launch: memset failed\n"); return; }
    Params p; memset(&p, 0, sizeof(p));
    for (int i = 0; i < 20; ++i) p.in[i] = (const float*)d_in[i];
    p.out = (float*)d_out; p.ws = (unsigned char*)d_ws;
#if MK_PER_PHASE
    for (int ph = 0; ph < N_PHASES; ++ph) { p.ph_lo = ph; p.ph_hi = ph + 1; hipLaunchKernelGGL(encoder_fwd, dim3(grid), dim3(512), LDS_BYTES, stream, p); }
#else
    p.ph_lo = 0; p.ph_hi = N_PHASES;
    hipLaunchKernelGGL(encoder_fwd, dim3(grid), dim3(512), LDS_BYTES, stream, p);
#endif
    const hipError_t le = hipPeekAtLastError();
    if (le != hipSuccess) fprintf(stderr, "kernel_launch: launch failed: %s\n", hipGetErrorName(le));
}
```

```cpp
#include <hip/hip_runtime.h>
#include <cstdio>
#include <cstdint>
#include <cstring>
namespace pg8 {
#define PG8_LAS __attribute__((address_space(3)))
typedef unsigned short bf16_t;
typedef short bf16x8 __attribute__((ext_vector_type(8)));
typedef float f32x4 __attribute__((ext_vector_type(4)));
typedef unsigned u32x4 __attribute__((ext_vector_type(4)));
constexpr int BM = 256, BK = 64, HALF = 128, HTB = HALF * BK * 2  , STAGE_BYTES = 8 * HTB, NXCD = 8, WGM = 4;

__host__ __device__ __forceinline__ int lds_byte(int r, int c) { const int st = (r >> 4) * 2 + (c >> 5), rr = r & 15, cc = c & 31, ob = rr * 64 + cc * 2; return st * 1024 + (ob ^ (((ob >> 9) & 1) << 5)); }
__host__ __device__ __forceinline__ void stage_rc(int b, int& R, int& C) { const int st = b / 1024, sb = b % 1024, swz = sb ^ (((sb >> 9) & 1) << 5); R = (st >> 1) * 16 + swz / 64; C = (st & 1) * 32 + (swz % 64) / 2; }
__host__ __device__ __forceinline__ int perm32(int rho) { const int n = rho >> 4, i = rho & 15; return 8 * (i >> 2) + 4 * n + (i & 3); }

struct Unit { int pm, pn, ko, kt; };
struct Gemm { const bf16_t* A; const bf16_t* Bt; int M, N, K, ld; };

struct StaticOrder {
    int nM, nN, nwg, G, c, kt;
    __host__ __device__ void init(int M, int N, int G_, int c_, int K_) { nM = M / BM; nN = N / BM; nwg = nM * nN; G = G_; c = c_; kt = K_ / BK; }
    __host__ __device__ bool next(int i, Unit& u) const {
        const long L = (long)i * G + c; if (L >= nwg) return false;
        int wgid = (int)L; { const int q = nwg / NXCD, r = nwg % NXCD, xcd = wgid % NXCD, off = wgid / NXCD; wgid = (xcd < r ? xcd * (q + 1) : r * (q + 1) + (xcd - r) * q) + off; }
        const int nig = WGM * nN, gid = wgid / nig, fm = gid * WGM, gsz = (nM - fm) < WGM ? (nM - fm) : WGM;
        u.pm = fm + ((wgid % nig) % gsz); u.pn = (wgid % nig) / gsz; u.ko = 0; u.kt = kt; return true;
    }
    __device__ __forceinline__ void a_ready(const Unit&) const {}
    __device__ __forceinline__ void done(const Unit&) const {}
};
__device__ __forceinline__ unsigned cvt_pk_bf16(float lo, float hi) { unsigned r; asm volatile("v_cvt_pk_bf16_f32 %0, %1, %2" : "=v"(r) : "v"(lo), "v"(hi)); return r; }
typedef unsigned u32x2 __attribute__((ext_vector_type(2)));
struct EpiPlain {
    static constexpr bool PERM = true, AFTER_DRAIN = false, PRE = false, TBL = false; static constexpr int NVM = 0;
    bf16_t* O; int ldc; const float* rstd;
    __device__ __forceinline__ void prefetch(const Unit& u, int wr, int fr, float (&pre)[8]) const {
#pragma unroll
        for (int i = 0; i < 8; ++i) pre[i] = rstd ? rstd[u.pm * BM + wr * 64 + fr + (i >> 2) * HALF + (i & 3) * 16] : 1.0f; }
    __device__ __forceinline__ void operator()(const f32x4 (&acc)[2][2][4][2], const Unit& u, int wr, int wc, int fr, int fq) const {
        const int row0 = u.pm * BM + wr * 64 + fr, col0 = u.pn * BM + wc * 32 + 8 * fq;
        float rsv[8];
#pragma unroll
        for (int i = 0; i < 8; ++i) rsv[i] = rstd ? rstd[row0 + (i >> 2) * HALF + (i & 3) * 16] : 1.0f;
        __builtin_amdgcn_sched_barrier(0);
#pragma unroll
        for (int ai = 0; ai < 2; ++ai)
#pragma unroll
            for (int m = 0; m < 4; ++m) { bf16_t* rowp = O + (size_t)(row0 + ai * HALF + m * 16) * ldc + col0; const float rs = rsv[ai * 4 + m];
#pragma unroll
                for (int bj = 0; bj < 2; ++bj) { const f32x4 v0 = acc[ai][bj][m][0] * rs, v1 = acc[ai][bj][m][1] * rs;
                    u32x4 w; w.x = cvt_pk_bf16(v0[0], v0[1]); w.y = cvt_pk_bf16(v0[2], v0[3]); w.z = cvt_pk_bf16(v1[0], v1[1]); w.w = cvt_pk_bf16(v1[2], v1[3]);
                    *(u32x4*)(rowp + bj * HALF) = w; } }
    }
};
struct EpiResid {
    static constexpr bool PERM = false, AFTER_DRAIN = false, PRE = false, TBL = false; static constexpr int NVM = 0;
    float* hreal; float* hmeta; int nreal; float scale;
    __device__ __forceinline__ void operator()(const f32x4 (&acc)[2][2][4][2], const Unit& u, int wr, int wc, int fr, int fq) const {
        float* base = (u.pm < nreal) ? hreal + (size_t)u.pm * BM * 2048 : hmeta;
        const int row0 = wr * 64 + fr, col0 = u.pn * BM + wc * 32 + 4 * fq;
#pragma unroll
        for (int ai = 0; ai < 2; ++ai) {
            f32x4 t[4][2][2];
#pragma unroll
            for (int m = 0; m < 4; ++m) { const float* rowp = base + (size_t)(row0 + ai * HALF + m * 16) * 2048 + col0;
#pragma unroll
                for (int bj = 0; bj < 2; ++bj)
#pragma unroll
                    for (int n = 0; n < 2; ++n) t[m][bj][n] = *(const f32x4*)(rowp + bj * HALF + n * 16); }
            __builtin_amdgcn_sched_barrier(0);
#pragma unroll
            for (int m = 0; m < 4; ++m) { float* rowp = base + (size_t)(row0 + ai * HALF + m * 16) * 2048 + col0;
#pragma unroll
                for (int bj = 0; bj < 2; ++bj)
#pragma unroll
                    for (int n = 0; n < 2; ++n) *(f32x4*)(rowp + bj * HALF + n * 16) = t[m][bj][n] + acc[ai][bj][m][n] * scale; }
            __builtin_amdgcn_sched_barrier(0);
        }
    }
};
constexpr int SS_PLANE = 49152;
struct EpiResidB {
    static constexpr bool PERM = true, AFTER_DRAIN = false, PRE = false, TBL = false; static constexpr int NVM = 16;
    bf16_t* hb; float* ss;
    __device__ __forceinline__ void operator()(const f32x4 (&acc)[2][2][4][2], const Unit& u, int wr, int wc, int fr, int fq) const {
        const int row0 = u.pm * BM + wr * 64 + fr, col0 = u.pn * BM + wc * 32 + 8 * fq;
#pragma unroll
        for (int ai = 0; ai < 2; ++ai) {
            u32x4 t[4][2];
#pragma unroll
            for (int m = 0; m < 4; ++m)
#pragma unroll
                for (int bj = 0; bj < 2; ++bj) t[m][bj] = *(const u32x4*)(hb + (size_t)(row0 + ai * HALF + m * 16) * 2048 + col0 + bj * HALF);
            __builtin_amdgcn_sched_barrier(0);
            float q[4] = {0.f, 0.f, 0.f, 0.f};
#pragma unroll
            for (int m = 0; m < 4; ++m)
#pragma unroll
                for (int bj = 0; bj < 2; ++bj) { const u32x4 h = t[m][bj]; const f32x4 a0 = acc[ai][bj][m][0], a1 = acc[ai][bj][m][1];
                    const f32x4 v0 = {__uint_as_float(h.x << 16) + a0[0], __uint_as_float(h.x & 0xffff0000u) + a0[1], __uint_as_float(h.y << 16) + a0[2], __uint_as_float(h.y & 0xffff0000u) + a0[3]};
                    const f32x4 v1 = {__uint_as_float(h.z << 16) + a1[0], __uint_as_float(h.z & 0xffff0000u) + a1[1], __uint_as_float(h.w << 16) + a1[2], __uint_as_float(h.w & 0xffff0000u) + a1[3]};
                    q[m] += (v0[0] * v0[0] + v0[1] * v0[1]) + (v0[2] * v0[2] + v0[3] * v0[3]) + (v1[0] * v1[0] + v1[1] * v1[1]) + (v1[2] * v1[2] + v1[3] * v1[3]);
                    u32x4 w; w.x = cvt_pk_bf16(v0[0], v0[1]); w.y = cvt_pk_bf16(v0[2], v0[3]); w.z = cvt_pk_bf16(v1[0], v1[1]); w.w = cvt_pk_bf16(v1[2], v1[3]);
                    *(u32x4*)(hb + (size_t)(row0 + ai * HALF + m * 16) * 2048 + col0 + bj * HALF) = w; }
            if (ss) {
#pragma unroll
                for (int m = 0; m < 4; ++m) { float s = q[m];
                    s += __int_as_float(__builtin_amdgcn_ds_swizzle(__float_as_int(s), 0x1f | (16 << 10)));
                    const auto rr = __builtin_amdgcn_permlane32_swap(__float_as_uint(s), __float_as_uint(s), false, false); s = __uint_as_float(rr[0]) + __uint_as_float(rr[1]);
                    if (fq == 0) ss[(size_t)(4 * u.pn + wc) * SS_PLANE + row0 + ai * HALF + m * 16] = s; }
            }
            __builtin_amdgcn_sched_barrier(0);
        }
    }
};
struct EpiResidFinal {
    static constexpr bool PERM = true, AFTER_DRAIN = false, PRE = false, TBL = false; static constexpr int NVM = 16;
    const bf16_t* hb; float* out;
    __device__ __forceinline__ void operator()(const f32x4 (&acc)[2][2][4][2], const Unit& u, int wr, int wc, int fr, int fq) const {
        const int row0 = u.pm * BM + wr * 64 + fr, col0 = u.pn * BM + wc * 32 + 8 * fq;
#pragma unroll
        for (int ai = 0; ai < 2; ++ai) {
            u32x4 t[4][2];
#pragma unroll
            for (int m = 0; m < 4; ++m)
#pragma unroll
                for (int bj = 0; bj < 2; ++bj) t[m][bj] = *(const u32x4*)(hb + (size_t)(row0 + ai * HALF + m * 16) * 2048 + col0 + bj * HALF);
            __builtin_amdgcn_sched_barrier(0);
#pragma unroll
            for (int m = 0; m < 4; ++m)
#pragma unroll
                for (int bj = 0; bj < 2; ++bj) { const u32x4 h = t[m][bj]; const f32x4 v0 = acc[ai][bj][m][0], v1 = acc[ai][bj][m][1]; float* op = out + (size_t)(row0 + ai * HALF + m * 16) * 2048 + col0 + bj * HALF;
                    *(f32x4*)op = (f32x4){__uint_as_float(h.x << 16) + v0[0], __uint_as_float(h.x & 0xffff0000u) + v0[1], __uint_as_float(h.y << 16) + v0[2], __uint_as_float(h.y & 0xffff0000u) + v0[3]};
                    *(f32x4*)(op + 4) = (f32x4){__uint_as_float(h.z << 16) + v1[0], __uint_as_float(h.z & 0xffff0000u) + v1[1], __uint_as_float(h.w << 16) + v1[2], __uint_as_float(h.w & 0xffff0000u) + v1[3]}; }
            __builtin_amdgcn_sched_barrier(0);
        }
    }
};
__device__ __forceinline__ float silu_mul(float g, float u) { return g * u * __builtin_amdgcn_rcpf(1.0f + __builtin_amdgcn_exp2f(-1.4426950408889634f * g)); }
struct EpiSwiglu {
    static constexpr bool PERM = true, AFTER_DRAIN = false, PRE = false, TBL = true; static constexpr int NVM = 8;
    bf16_t* O; int ldc; const float* rstd;
    __device__ __forceinline__ void table_load(const Unit& u, PG8_LAS unsigned char* t, int wid) const {
        int l2; asm volatile("v_mbcnt_lo_u32_b32 %0, -1, 0\n\tv_mbcnt_hi_u32_b32 %0, -1, %0" : "=v"(l2));
        if (wid < 4) __builtin_amdgcn_global_load_lds((const unsigned*)(rstd + u.pm * BM + wid * 64 + l2), (PG8_LAS unsigned*)(t + wid * 256), 4, 0, 0); }
    __device__ __forceinline__ void operator()(const f32x4 (&acc)[2][2][4][2], const Unit& u, int wr, int wc, int fr, int fq, const PG8_LAS float* tb) const {
        const int row0 = u.pm * BM + wr * 64 + fr, col0 = u.pn * (BM / 2) + wc * 32 + 8 * fq;
        float rsv[8];
#pragma unroll
        for (int i = 0; i < 8; ++i) rsv[i] = tb[wr * 64 + fr + (i >> 2) * HALF + (i & 3) * 16];
        __builtin_amdgcn_sched_barrier(0);
#pragma unroll
        for (int ai = 0; ai < 2; ++ai)
#pragma unroll
            for (int m = 0; m < 4; ++m) { bf16_t* rowp = O + (size_t)(row0 + ai * HALF + m * 16) * ldc + col0; const float rs = rsv[ai * 4 + m];
                const float c1 = -1.4426950408889634f * rs, irs2 = __builtin_amdgcn_rcpf(rs * rs);
                const f32x4 a0 = acc[ai][0][m][0], a1 = acc[ai][0][m][1], b0 = acc[ai][1][m][0], b1 = acc[ai][1][m][1];
#define SWG(G_, U_) ((G_) * (U_) * __builtin_amdgcn_rcpf(__builtin_fmaf(__builtin_amdgcn_exp2f((G_) * c1), irs2, irs2)))
                u32x4 w; w.x = cvt_pk_bf16(SWG(a0[0], a0[1]), SWG(a0[2], a0[3])); w.y = cvt_pk_bf16(SWG(a1[0], a1[1]), SWG(a1[2], a1[3]));
                w.z = cvt_pk_bf16(SWG(b0[0], b0[1]), SWG(b0[2], b0[3])); w.w = cvt_pk_bf16(SWG(b1[0], b1[1]), SWG(b1[2], b1[3]));
#undef SWG
                *(u32x4*)rowp = w; }
    }
};
struct EpiCin {
    static constexpr bool PERM = true, AFTER_DRAIN = false, PRE = false, TBL = false; static constexpr int NVM = 0;
    bf16_t* Bb; bf16_t* Gb; const float* rstd;
    __device__ __forceinline__ void prefetch(const Unit& u, int wr, int fr, float (&pre)[8]) const {
#pragma unroll
        for (int i = 0; i < 8; ++i) pre[i] = rstd ? rstd[u.pm * BM + wr * 64 + fr + (i >> 2) * HALF + (i & 3) * 16] : 1.0f; }
    __device__ __forceinline__ void operator()(const f32x4 (&acc)[2][2][4][2], const Unit& u, int wr, int wc, int fr, int fq) const {
        const int row0 = u.pm * BM + wr * 64 + fr;
        float rsv[8];
#pragma unroll
        for (int i = 0; i < 8; ++i) rsv[i] = rstd ? rstd[row0 + (i >> 2) * HALF + (i & 3) * 16] : 1.0f;
        __builtin_amdgcn_sched_barrier(0);
        if (u.pn < 8) {
            const int col0 = u.pn * BM + wc * 32 + 8 * fq;
#pragma unroll
            for (int ai = 0; ai < 2; ++ai)
#pragma unroll
                for (int m = 0; m < 4; ++m) { bf16_t* rowp = Bb + (size_t)(row0 + ai * HALF + m * 16) * 2048 + col0; const float rs = rsv[ai * 4 + m];
#pragma unroll
                    for (int bj = 0; bj < 2; ++bj) { const f32x4 v0 = acc[ai][bj][m][0] * rs, v1 = acc[ai][bj][m][1] * rs;
                        u32x4 w; w.x = cvt_pk_bf16(v0[0], v0[1]); w.y = cvt_pk_bf16(v0[2], v0[3]); w.z = cvt_pk_bf16(v1[0], v1[1]); w.w = cvt_pk_bf16(v1[2], v1[3]);
                        *(u32x4*)(rowp + bj * HALF) = w; } }
        } else {
            const int col0 = (u.pn - 8) * (BM / 2) + wc * 32 + 8 * fq;
#pragma unroll
            for (int ai = 0; ai < 2; ++ai)
#pragma unroll
                for (int m = 0; m < 4; ++m) { bf16_t* rowp = Gb + (size_t)(row0 + ai * HALF + m * 16) * 2048 + col0; const float rs = rsv[ai * 4 + m]; const float rs2 = rs * rs;
                    const f32x4 a0 = acc[ai][0][m][0], a1 = acc[ai][0][m][1], b0 = acc[ai][1][m][0], b1 = acc[ai][1][m][1];
                    u32x4 w; w.x = cvt_pk_bf16(a0[0] * a0[1] * rs2, a0[2] * a0[3] * rs2); w.y = cvt_pk_bf16(a1[0] * a1[1] * rs2, a1[2] * a1[3] * rs2);
                    w.z = cvt_pk_bf16(b0[0] * b0[1] * rs2, b0[2] * b0[3] * rs2); w.w = cvt_pk_bf16(b1[0] * b1[1] * rs2, b1[2] * b1[3] * rs2);
                    *(u32x4*)rowp = w; }
        }
    }
};
struct TailOrder {
    int nunits, c, pm, kchunk;
    __device__ __forceinline__ bool next(int i, Unit& u) const { if (i > 0 || c >= nunits) return false; u.pm = pm; u.pn = c & 7; u.ko = (c >> 3) * kchunk; u.kt = kchunk / BK; return true; }
    __device__ __forceinline__ void a_ready(const Unit&) const {}
    __device__ __forceinline__ void done(const Unit&) const {}
};
struct EpiTailStore {
    static constexpr bool PERM = false, AFTER_DRAIN = false, PRE = false, TBL = false; static constexpr int NVM = 0;
    float* tailp; int kchunk;
    __device__ __forceinline__ void operator()(const f32x4 (&acc)[2][2][4][2], const Unit& u, int wr, int wc, int fr, int fq) const {
        if (wr != 0) return;
        const int col0 = u.pn * BM + wc * 32 + 4 * fq; float* base = tailp + (size_t)(u.ko / kchunk) * 64 * 2048;
#pragma unroll
        for (int m = 0; m < 4; ++m) { float* rowp = base + (size_t)(m * 16 + fr) * 2048 + col0;
#pragma unroll
            for (int bj = 0; bj < 2; ++bj)
#pragma unroll
                for (int n = 0; n < 2; ++n) *(f32x4*)(rowp + bj * HALF + n * 16) = acc[0][bj][m][n]; }
    }
};
struct StaggerOrder : StaticOrder {
    int rounds, kcut;
    __device__ __forceinline__ void init2(int M, int N, int G_, int c_, int K_) {
        init(M, N, G_, c_, K_); rounds = nwg / G; const int sg = (c_ >> 3) & 7; int kc = ((kt * sg / 8) + 1) & ~1; if (kc < 4 || kt - kc < 4 || nwg % G != 0) kc = 0; kcut = kc; }
    __device__ __forceinline__ bool next(int i, Unit& u) const {
        if (kcut == 0) return StaticOrder::next(i, u);
        if (i > rounds) return false;
        if (i == rounds) { StaticOrder::next(0, u); u.ko = kcut * BK; u.kt = kt - kcut; return true; }
        StaticOrder::next(i, u); if (i == 0) u.kt = kcut; return true;
    }
};
struct EpiNone {
    static constexpr bool PERM = true, AFTER_DRAIN = false, PRE = false, TBL = false; static constexpr int NVM = 0;
    __device__ __forceinline__ void operator()(const f32x4 (&acc)[2][2][4][2], const Unit&, int, int, int, int) const {
#pragma unroll
        for (int a = 0; a < 2; ++a)
#pragma unroll
            for (int b = 0; b < 2; ++b)
#pragma unroll
                for (int m = 0; m < 4; ++m) asm volatile("" :: "v"(acc[a][b][m][0]), "v"(acc[a][b][m][1]));
    }
};
template <class Epi, class Sched, bool ALIGN_EPI = false, bool SP2 = false>
__device__ __forceinline__ void gemm_phase(PG8_LAS unsigned char* lds, const Gemm g, const Sched& S, const Epi& E) {
    int tid_l = threadIdx.x; asm volatile("" : "+v"(tid_l));
    const int tid = tid_l, wid = __builtin_amdgcn_readfirstlane(tid >> 6), lane = tid & 63, wr = wid >> 2, wc = wid & 3, fr = lane & 15, fq = lane >> 4;
    const int K = g.ld;
    unsigned voffA[2], voffB[2];
#pragma unroll
    for (int i = 0; i < 2; ++i) { int R, C; stage_rc(tid * 16 + i * 8192, R, C); const int Rb = Epi::PERM ? ((R & ~31) + perm32(R & 31)) : R;
        voffA[i] = (unsigned)(R * K + C) * 2u; voffB[i] = (unsigned)(Rb * K + C) * 2u; }
    const size_t kstep = (size_t)(BK * 2);
    const size_t hstep = (size_t)HALF * K * 2;
    const size_t tstep = 2 * hstep;
    const unsigned ldsw = (unsigned)wid * 1024u;
    const unsigned ldsbase_w = (unsigned)(size_t)lds + ldsw;
    const int aoff = lds_byte(wr * 64 + fr, fq * 8), boff = lds_byte(wc * 32 + fr, fq * 8);
#define PG8_SA(b, h) (((b) * 2 + (h)) * HTB)
#define PG8_SB(b, h) ((4 + (b) * 2 + (h)) * HTB)
#define PG8_STAGE1(ldsoff, gbase, IMM, voff32) asm volatile("s_mov_b32 m0, %2\n\ts_nop 0\n\tglobal_load_lds_dwordx4 %0, %1 offset:" #IMM :: "v"(voff32), "s"(gbase), "s"(ldsbase_w + (unsigned)(ldsoff)) : "memory", "m0")
#define PG8_STAGEI(bufoff, gbase, IMM, voff) do { PG8_STAGE1((bufoff), gbase, IMM, (voff)[0]); PG8_STAGE1((bufoff) + 8192, gbase, IMM, (voff)[1]); } while (0)
#define PG8_STAGE(bufoff, gbase, voff) PG8_STAGEI(bufoff, gbase, 0, voff)
#define PG8_LDA(dst, b, h) do { _Pragma("unroll") for (int m = 0; m < 4; ++m) _Pragma("unroll") for (int k = 0; k < 2; ++k) dst[m][k] = *(const PG8_LAS bf16x8*)(lds + PG8_SA(b, h) + aoff + m * 2048 + k * 1024); } while (0)
#define PG8_LDB(dst, b, h) do { _Pragma("unroll") for (int n = 0; n < 2; ++n) _Pragma("unroll") for (int k = 0; k < 2; ++k) dst[n][k] = *(const PG8_LAS bf16x8*)(lds + PG8_SB(b, h) + boff + n * 2048 + k * 1024); } while (0)
#define PG8_MMA(ai, bj, At, Bt) do { __builtin_amdgcn_s_setprio(1); _Pragma("unroll") for (int m = 0; m < 4; ++m) _Pragma("unroll") for (int n = 0; n < 2; ++n) _Pragma("unroll") for (int k = 0; k < 2; ++k) \
        acc[ai][bj][m][n] = __builtin_amdgcn_mfma_f32_16x16x32_bf16(Bt[n][k], At[m][k], acc[ai][bj][m][n], 0, 0, 0); __builtin_amdgcn_s_setprio(0); } while (0)
#define PG8_WAIT_V(n) asm volatile("s_waitcnt vmcnt(" #n ")" ::: "memory")
#define PG8_WAIT_L(n) asm volatile("s_waitcnt lgkmcnt(" #n ")" ::: "memory")
#define PG8_BAR __builtin_amdgcn_s_barrier()
#define PG8_SCHED __builtin_amdgcn_sched_barrier(0)
    Unit cur, nxt; int ui = 0;
    if (!S.next(0, cur)) return;
    f32x4 acc[2][2][4][2];
#pragma unroll
    for (int a = 0; a < 2; ++a)
#pragma unroll
        for (int b = 0; b < 2; ++b)
#pragma unroll
            for (int m = 0; m < 4; ++m)
#pragma unroll
                for (int n = 0; n < 2; ++n) acc[a][b][m][n] = (f32x4){0.f, 0.f, 0.f, 0.f};
    bf16x8 At[4][2], B0[2][2], B1[2][2];
    const char* cA = (const char*)g.A + (size_t)cur.pm * tstep + (size_t)cur.ko * 2; const char* cB = (const char*)g.Bt + (size_t)cur.pn * tstep + (size_t)cur.ko * 2;
    S.a_ready(cur);
    float pre[8];
    if constexpr (Epi::PRE) E.prefetch(cur, wr, fr, pre);
    PG8_LAS unsigned char* const tbl = lds + STAGE_BYTES;
    if constexpr (Epi::TBL) E.table_load(cur, tbl, wid);
    if constexpr (SP2) {
        PG8_STAGE(PG8_SB(0, 0), cB, voffB); PG8_STAGE(PG8_SB(0, 1), cB + hstep, voffB); PG8_STAGE(PG8_SA(0, 0), cA, voffA); PG8_STAGE(PG8_SA(0, 1), cA + hstep, voffA);
        if (wr == 1) PG8_BAR;
        PG8_WAIT_V(2); PG8_BAR;
        PG8_STAGE(PG8_SB(1, 0), cB + kstep, voffB); PG8_STAGE(PG8_SA(1, 0), cA + kstep, voffA); PG8_STAGE(PG8_SB(1, 1), cB + hstep + kstep, voffB);
        PG8_WAIT_V(6); PG8_BAR;
    } else {
        PG8_STAGE(PG8_SB(0, 0), cB, voffB); PG8_STAGE(PG8_SA(0, 0), cA, voffA); PG8_STAGE(PG8_SB(0, 1), cB + hstep, voffB); PG8_STAGE(PG8_SA(0, 1), cA + hstep, voffA);
        if (wr == 1) PG8_BAR;
        PG8_WAIT_V(4); PG8_BAR;
        PG8_STAGE(PG8_SB(1, 0), cB + kstep, voffB); PG8_STAGE(PG8_SA(1, 0), cA + kstep, voffA); PG8_STAGE(PG8_SB(1, 1), cB + hstep + kstep, voffB);
        PG8_WAIT_V(6); PG8_BAR;
    }
    for (;;) {
        const bool has_next = S.next(ui + 1, nxt);
        const char* nA = has_next ? (const char*)g.A + (size_t)nxt.pm * tstep + (size_t)nxt.ko * 2 : cA; const char* nB = has_next ? (const char*)g.Bt + (size_t)nxt.pn * tstep + (size_t)nxt.ko * 2 : cB;
        const int nt = cur.kt;
#define PG8_KSETUP() const bool last = (t == nt - 2); const char* a1 = cA + (size_t)(t + 1) * kstep; \
            const char* a2 = last ? nA : cA + (size_t)(t + 2) * kstep; const char* b2 = last ? nB : cB + (size_t)(t + 2) * kstep; const char* a3 = a2 + kstep; const char* b3 = b2 + kstep; \
            if (last && has_next) S.a_ready(nxt)
#define PG8_KITER_SP2(W1, W2) do { \
            PG8_LDB(B0, 0, 0); PG8_LDB(B1, 0, 1); PG8_SCHED; PG8_LDA(At, 0, 0); PG8_STAGE(PG8_SA(1, 1), a1 + hstep, voffA); \
            PG8_WAIT_V(W1); PG8_WAIT_L(0); PG8_BAR; PG8_MMA(0, 0, At, B0); PG8_MMA(0, 1, At, B1); PG8_BAR; PG8_SCHED; \
            PG8_LDA(At, 0, 1); PG8_STAGE(PG8_SB(0, 0), b2, voffB); PG8_STAGE(PG8_SB(0, 1), b2 + hstep, voffB); PG8_STAGE(PG8_SA(0, 0), a2, voffA); \
            PG8_WAIT_V(W2); PG8_WAIT_L(0); PG8_BAR; PG8_MMA(1, 0, At, B0); PG8_MMA(1, 1, At, B1); PG8_BAR; PG8_SCHED; \
            PG8_LDB(B0, 1, 0); PG8_LDB(B1, 1, 1); PG8_SCHED; PG8_LDA(At, 1, 0); PG8_STAGE(PG8_SA(0, 1), a2 + hstep, voffA); \
            PG8_WAIT_V(8); PG8_WAIT_L(0); PG8_BAR; PG8_MMA(0, 0, At, B0); PG8_MMA(0, 1, At, B1); PG8_BAR; PG8_SCHED; \
            PG8_LDA(At, 1, 1); PG8_STAGE(PG8_SB(1, 0), b3, voffB); PG8_STAGE(PG8_SB(1, 1), b3 + hstep, voffB); PG8_STAGE(PG8_SA(1, 0), a3, voffA); \
            PG8_WAIT_V(8); PG8_WAIT_L(0); PG8_BAR; PG8_MMA(1, 0, At, B0); PG8_MMA(1, 1, At, B1); PG8_BAR; PG8_SCHED; } while (0)
        int t0 = 0;
        if constexpr (SP2 && Epi::NVM == 16) { if (ui > 0) { const int t = 0; PG8_KSETUP(); PG8_KITER_SP2(24, 24); t0 = 2; } }
        if constexpr (SP2 && Epi::NVM == 8) { if (ui > 0) { const int t = 0; PG8_KSETUP(); PG8_KITER_SP2(16, 16); t0 = 2; } }
        for (int t = t0; t < nt; t += 2) {
            PG8_KSETUP();
            if constexpr (SP2) {
            PG8_KITER_SP2(8, 8);
            } else {
            PG8_LDB(B0, 0, 0); PG8_SCHED; PG8_LDA(At, 0, 0); PG8_STAGE(PG8_SA(1, 1), a1 + hstep, voffA);
            PG8_WAIT_L(8); PG8_BAR; PG8_WAIT_L(0); PG8_MMA(0, 0, At, B0); PG8_BAR; PG8_SCHED;
            PG8_LDB(B1, 0, 1); PG8_STAGE(PG8_SB(0, 0), b2, voffB);
            PG8_BAR; PG8_WAIT_L(0); PG8_MMA(0, 1, At, B1); PG8_BAR;
            PG8_LDA(At, 0, 1); PG8_STAGE(PG8_SA(0, 0), a2, voffA);
            PG8_BAR; PG8_WAIT_L(0); PG8_MMA(1, 0, At, B0); PG8_BAR; PG8_SCHED;
            PG8_STAGE(PG8_SB(0, 1), b2 + hstep, voffB);
            PG8_WAIT_V(6); PG8_BAR; PG8_MMA(1, 1, At, B1); PG8_BAR;
            PG8_LDB(B0, 1, 0); PG8_SCHED; PG8_LDA(At, 1, 0); PG8_STAGE(PG8_SA(0, 1), a2 + hstep, voffA);
            PG8_WAIT_L(8); PG8_BAR; PG8_WAIT_L(0); PG8_MMA(0, 0, At, B0); PG8_BAR; PG8_SCHED;
            PG8_LDB(B1, 1, 1); PG8_STAGE(PG8_SB(1, 0), b3, voffB);
            PG8_BAR; PG8_WAIT_L(0); PG8_MMA(0, 1, At, B1); PG8_BAR;
            PG8_LDA(At, 1, 1); PG8_STAGE(PG8_SA(1, 0), a3, voffA);
            PG8_BAR; PG8_WAIT_L(0); PG8_MMA(1, 0, At, B0); PG8_BAR; PG8_SCHED;
            PG8_STAGE(PG8_SB(1, 1), b3 + hstep, voffB);
            PG8_WAIT_V(6); PG8_BAR; PG8_MMA(1, 1, At, B1); PG8_BAR;
            }
        }
#undef PG8_KSETUP
#undef PG8_KITER_SP2
        if constexpr (ALIGN_EPI) { if (wr == 0) PG8_BAR; }
        if constexpr (!Epi::AFTER_DRAIN) { if constexpr (Epi::TBL) { E(acc, cur, wr, wc, fr, fq, (const PG8_LAS float*)(tbl + (ui & 1) * 1024)); if (has_next) E.table_load(nxt, tbl + ((ui + 1) & 1) * 1024, wid); } else if constexpr (Epi::PRE) { E(acc, cur, wr, wc, fr, fq, pre); if (has_next) E.prefetch(nxt, wr, fr, pre); } else E(acc, cur, wr, wc, fr, fq); S.done(cur); }
        if (!has_next) break;
#pragma unroll
        for (int a = 0; a < 2; ++a)
#pragma unroll
            for (int b = 0; b < 2; ++b)
#pragma unroll
                for (int m = 0; m < 4; ++m)
#pragma unroll
                    for (int n = 0; n < 2; ++n) acc[a][b][m][n] = (f32x4){0.f, 0.f, 0.f, 0.f};
        cur = nxt; cA = nA; cB = nB; ++ui;
        if constexpr (ALIGN_EPI) { if (wr == 1) PG8_BAR; }
    }
    PG8_WAIT_V(0);
    if constexpr (!ALIGN_EPI) { if (wr == 0) PG8_BAR; }
    PG8_BAR;
    if constexpr (Epi::AFTER_DRAIN) { E.fused(acc, cur, wr, wc, fr, fq, lds, wid, lane); S.done(cur); }
#undef PG8_SA
#undef PG8_SB
#undef PG8_STAGE
#undef PG8_LDA
#undef PG8_LDB
#undef PG8_MMA
#undef PG8_WAIT_V
#undef PG8_WAIT_L
#undef PG8_BAR
#undef PG8_SCHED
}
}
namespace att {
typedef unsigned short u16;
using bf16x8 = __attribute__((ext_vector_type(8))) short;
using s16x4  = __attribute__((ext_vector_type(4))) short;
using f32x16 = __attribute__((ext_vector_type(16))) float;
using u32x4  = __attribute__((ext_vector_type(4))) unsigned;
constexpr int   D = 128, KVBLK = 64, LDK = 128, LDQ = 3072, LDO = 2048;
constexpr float SCALE = 0.088388347648318440f;
constexpr float THR = 8.f;
constexpr float NEGBIG = -1e30f;
constexpr size_t SHM_V = KVBLK * D * 2, SHM_K = KVBLK * D * 2, SHM_ATTN = 2 * SHM_V + 2 * SHM_K + 8 * 64 * 4;
#define KSWZ(row, colB) ((row) * 256 + ((colB) ^ (((row) & 7) << 4)))
#define SBAR() __builtin_amdgcn_sched_barrier(0)
__device__ __forceinline__ int crow(int r, int hi) { return (r & 3) + 8 * (r >> 2) + 4 * hi; }
__device__ __forceinline__ unsigned cvtpk(float lo, float hi) { unsigned r; asm volatile("v_cvt_pk_bf16_f32 %0, %1, %2" : "=v"(r) : "v"(lo), "v"(hi)); return r; }

__device__ __forceinline__ void partialSM(f32x16& p0, f32x16& p1, float& m_reg, float& mn, float& alpha) {
  constexpr float C = SCALE * 1.4426950408889634f;
  float pmax = p0[0]; for (int r = 1; r < 16; ++r) pmax = fmaxf(pmax, p0[r]); for (int r = 0; r < 16; ++r) pmax = fmaxf(pmax, p1[r]);
  { auto rr = __builtin_amdgcn_permlane32_swap(__float_as_uint(pmax), __float_as_uint(pmax), false, false);
    pmax = fmaxf(__uint_as_float(rr[0]), __uint_as_float(rr[1])); }
  if (__builtin_expect(__all(pmax - m_reg <= THR / SCALE), 1)) { mn = m_reg; alpha = 1.f; }
  else { mn = fmaxf(m_reg, pmax); alpha = __builtin_amdgcn_exp2f((m_reg - mn) * C); m_reg = mn; }
  float mnC = -mn * C;
  for (int r = 0; r < 16; ++r) p0[r] = fmaf(p0[r], C, mnC); for (int r = 0; r < 16; ++r) p1[r] = fmaf(p1[r], C, mnC);
  for (int r = 0; r < 16; ++r) p0[r] = __builtin_amdgcn_exp2f(p0[r]);
}
__device__ __forceinline__ void finishSM(f32x16& p0, f32x16& p1, float alpha, float& l_reg, bf16x8& pa0, bf16x8& pa1, bf16x8& pa2, bf16x8& pa3) {
  for (int r = 0; r < 16; ++r) p1[r] = __builtin_amdgcn_exp2f(p1[r]);
  float ps = 0; for (int r = 0; r < 16; ++r) ps += p0[r]; for (int r = 0; r < 16; ++r) ps += p1[r];
  { auto rr = __builtin_amdgcn_permlane32_swap(__float_as_uint(ps), __float_as_uint(ps), false, false);
    ps = __uint_as_float(rr[0]) + __uint_as_float(rr[1]); }
  l_reg = l_reg * alpha + ps;
#define PK4(P, BASE, OUT) do { unsigned a0 = cvtpk(P[BASE + 0], P[BASE + 1]), a1 = cvtpk(P[BASE + 2], P[BASE + 3]);   \
    unsigned b0 = cvtpk(P[BASE + 4], P[BASE + 5]), b1 = cvtpk(P[BASE + 6], P[BASE + 7]);                              \
    auto r0 = __builtin_amdgcn_permlane32_swap(a0, b0, false, false); auto r1 = __builtin_amdgcn_permlane32_swap(a1, b1, false, false); \
    u32x4 w = {r0[0], r1[0], r0[1], r1[1]}; OUT = *reinterpret_cast<bf16x8*>(&w); } while (0)
  PK4(p0, 0, pa0); PK4(p0, 8, pa1); PK4(p1, 0, pa2); PK4(p1, 8, pa3);
#undef PK4
}
__device__ __forceinline__ void qkt(f32x16& p0, f32x16& p1, const u16* Ks, const bf16x8* qr, int r32, int hi) {
  p0 = f32x16{}; p1 = f32x16{};
  for (int d0 = 0; d0 < 8; ++d0) { int cb = (d0 * 16 + hi * 8) * 2;
    bf16x8 b0 = *reinterpret_cast<const bf16x8*>((const char*)Ks + KSWZ(r32, cb));
    bf16x8 b1 = *reinterpret_cast<const bf16x8*>((const char*)Ks + KSWZ(32 + r32, cb));
    p0 = __builtin_amdgcn_mfma_f32_32x32x16_bf16(b0, qr[d0], p0, 0, 0, 0);
    p1 = __builtin_amdgcn_mfma_f32_32x32x16_bf16(b1, qr[d0], p1, 0, 0, 0); }
}
__device__ __forceinline__ void qkt_lds(f32x16& p0, f32x16& p1, const u16* Ks, const char* qs, int r32, int hi) {
  p0 = f32x16{}; p1 = f32x16{};
  for (int d0 = 0; d0 < 8; ++d0) { int cb = (d0 * 16 + hi * 8) * 2;
    bf16x8 q = *reinterpret_cast<const bf16x8*>(qs + d0 * 1024);
    bf16x8 b0 = *reinterpret_cast<const bf16x8*>((const char*)Ks + KSWZ(r32, cb));
    bf16x8 b1 = *reinterpret_cast<const bf16x8*>((const char*)Ks + KSWZ(32 + r32, cb));
    p0 = __builtin_amdgcn_mfma_f32_32x32x16_bf16(b0, q, p0, 0, 0, 0);
    p1 = __builtin_amdgcn_mfma_f32_32x32x16_bf16(b1, q, p1, 0, 0, 0); }
}
__device__ __forceinline__ int v_st(int k, int c) { const int kk = (k & ~0xC) | ((k & 4) << 1) | ((k & 8) >> 1); return ((kk >> 3) * 4 + (c >> 5)) * 512 + ((kk & 7) * 32 + (c & 31)) * 2; }
__device__ __forceinline__ int v_rd_base(int lane) { return ((lane & 3) << 3) | (((lane >> 2) & 3) << 6) | (((lane >> 4) & 1) << 5) | (((lane >> 5) & 1) << 8); }
constexpr int v_rd_off(int d0, int ks, int half) { return d0 * 512 + ks * 4096 + half * 2048; }
template <int OFF> __device__ __forceinline__ s16x4 tr_read(int vb) {
  s16x4 r; asm volatile("ds_read_b64_tr_b16 %0, %1 offset:%2" : "=&v"(r) : "v"(vb), "i"(OFF) : "memory"); return r;
}
template <int D0> __device__ __forceinline__ void pv_one(f32x16& od, int vb, bf16x8 pa0, bf16x8 pa1, bf16x8 pa2, bf16x8 pa3) {
  const s16x4 l0 = tr_read<v_rd_off(D0, 0, 0)>(vb), h0 = tr_read<v_rd_off(D0, 0, 1)>(vb), l1 = tr_read<v_rd_off(D0, 1, 0)>(vb), h1 = tr_read<v_rd_off(D0, 1, 1)>(vb);
  const s16x4 l2 = tr_read<v_rd_off(D0, 2, 0)>(vb), h2 = tr_read<v_rd_off(D0, 2, 1)>(vb), l3 = tr_read<v_rd_off(D0, 3, 0)>(vb), h3 = tr_read<v_rd_off(D0, 3, 1)>(vb);
  asm volatile("s_waitcnt lgkmcnt(0)" ::: "memory"); SBAR();
#define PK(L, H) (bf16x8){L[0], L[1], L[2], L[3], H[0], H[1], H[2], H[3]}
  od = __builtin_amdgcn_mfma_f32_32x32x16_bf16(pa0, PK(l0, h0), od, 0, 0, 0);
  od = __builtin_amdgcn_mfma_f32_32x32x16_bf16(pa1, PK(l1, h1), od, 0, 0, 0);
  od = __builtin_amdgcn_mfma_f32_32x32x16_bf16(pa2, PK(l2, h2), od, 0, 0, 0);
  od = __builtin_amdgcn_mfma_f32_32x32x16_bf16(pa3, PK(l3, h3), od, 0, 0, 0);
#undef PK
}
__device__ __forceinline__ void pv_d0(f32x16* o, int vb, bf16x8 pa0, bf16x8 pa1, bf16x8 pa2, bf16x8 pa3) {
  pv_one<0>(o[0], vb, pa0, pa1, pa2, pa3); pv_one<1>(o[1], vb, pa0, pa1, pa2, pa3); pv_one<2>(o[2], vb, pa0, pa1, pa2, pa3); pv_one<3>(o[3], vb, pa0, pa1, pa2, pa3);
}
__device__ __forceinline__ void mask_meta_tile(f32x16& p0, f32x16& p1) {
#pragma unroll
  for (int r = 8; r < 16; ++r) p0[r] = NEGBIG;
#pragma unroll
  for (int r = 0; r < 16; ++r) p1[r] = NEGBIG;
}
__device__ __forceinline__ void mask_win_tile(f32x16& p0, f32x16& p1, float dlt  , float slopeS, bool ismeta) {
  if (!ismeta) {
#pragma unroll
    for (int r = 0; r < 16; ++r) { const float c = (float)((r & 3) + 8 * (r >> 2)); const float d0 = fabsf(dlt - c), d1 = fabsf(dlt - 32.f - c);
      p0[r] = (d0 <= 128.f) ? fmaf(-slopeS, d0, p0[r]) : NEGBIG; p1[r] = (d1 <= 128.f) ? fmaf(-slopeS, d1, p1[r]) : NEGBIG; }
  } else {
#pragma unroll
    for (int r = 0; r < 16; ++r) { const float c = (float)((r & 3) + 8 * (r >> 2));
      p0[r] = (dlt - c >= 0.f) ? p0[r] : NEGBIG; p1[r] = (dlt - 32.f - c >= 0.f) ? p1[r] : NEGBIG; }
  }
}

template <int MODE>
__device__ __forceinline__ void attn_item(const u16* __restrict__ Qw, const u16* __restrict__ Kh, const u16* __restrict__ Vh, u16* __restrict__ Ow, bool metaq, bool store,
                                          int NT, int ktlo, int tq, float slopeS, float sinkL2, char* lds, bool mask0, float* __restrict__ po, float* __restrict__ pml) {
  int tid_l = threadIdx.x; asm volatile("" : "+v"(tid_l));
  const int tid = tid_l, wid = tid >> 6, lane = tid & 63, r32 = lane & 31, hi = lane >> 5;
  constexpr int NS = (MODE == 0) ? 3 : 2;
  u16* V_lds = (u16*)lds; u16* K_lds = (u16*)(lds + NS * SHM_V);
  float* ws = (float*)(lds + NS * (SHM_V + SHM_K)) + wid * 64; float* li_l = ws; float* al_l = ws + 32;
  float m_reg = -1e30f, l_reg = 0; f32x16 o[4] = {}; bf16x8 qr[8];
  char* qs = lds + SHM_ATTN + wid * 8192 + lane * 16;
#pragma unroll
  for (int d0 = 0; d0 < 8; ++d0) qr[d0] = *reinterpret_cast<const bf16x8*>(Qw + d0 * 16);
#define QKT(P0, P1, KS) do { if (MODE == 1) qkt_lds(P0, P1, KS, qs, r32, hi); else qkt(P0, P1, KS, qr, r32, hi); } while (0)
  const int sr = tid >> 4, sc = (tid & 15) * 8, vst0 = v_st(sr, sc), vst1 = v_st(32 + sr, sc);
  const int vb0 = (int)(uintptr_t)V_lds + v_rd_base(lane);
  constexpr int SD = 2;
  struct { bf16x8 vs0, vs1, ks0, ks1; } sr_[SD];
#define KROW(t) ((MODE == 0 || (t)) ? 64 * (ktlo + (t)) : 0)
#define SLOAD(i, tt) do { const int k0_ = KROW(tt); sr_[i].vs0 = *reinterpret_cast<const bf16x8*>(&Vh[(long)(k0_ + sr) * LDK + sc]); sr_[i].vs1 = *reinterpret_cast<const bf16x8*>(&Vh[(long)(k0_ + 32 + sr) * LDK + sc]); \
    sr_[i].ks0 = *reinterpret_cast<const bf16x8*>(&Kh[(long)(k0_ + sr) * LDK + sc]); sr_[i].ks1 = *reinterpret_cast<const bf16x8*>(&Kh[(long)(k0_ + 32 + sr) * LDK + sc]); } while (0)
#define SWRITE(b, i) do { *(bf16x8*)((char*)V_lds + (b) * SHM_V + vst0) = sr_[i].vs0;          \
    *(bf16x8*)((char*)V_lds + (b) * SHM_V + vst1) = sr_[i].vs1; int kc = sc * 2;               \
    *(bf16x8*)((char*)K_lds + (b) * SHM_K + KSWZ(sr, kc)) = sr_[i].ks0;                       \
    *(bf16x8*)((char*)K_lds + (b) * SHM_K + KSWZ(32 + sr, kc)) = sr_[i].ks1; } while (0)
#define SWAIT() do { if (SD == 2) asm volatile("s_waitcnt vmcnt(4)" ::: "memory"); else asm volatile("s_waitcnt vmcnt(0)" ::: "memory"); } while (0)
#define RESC(a) do { if (__any((a) < 1.f)) { if (hi == 0) al_l[r32] = (a); asm volatile("s_waitcnt lgkmcnt(0)" ::: "memory"); \
    for (int d = 0; d < 4; ++d) for (int r = 0; r < 16; ++r) o[d][r] *= al_l[crow(r, hi)]; } } while (0)
  const float tqf = (float)(tq - 4 * hi);
#define WMASK(P0, P1, tt) do { if (MODE == 1) mask_win_tile(P0, P1, tqf - (float)(64 * (ktlo + (tt) - 1)), slopeS, metaq); } while (0)
  f32x16 pA0, pA1, pB0, pB1; float mnA, mnB, alA, alB; bf16x8 pa0, pa1, pa2, pa3;
  constexpr int SE = 0, SO = SD - 1;
  SLOAD(SE, 0);
  __builtin_amdgcn_sched_barrier(0);
  if (MODE == 1) {
    __builtin_amdgcn_sched_barrier(0);
#pragma unroll
    for (int d0 = 0; d0 < 8; ++d0) *reinterpret_cast<bf16x8*>(qs + d0 * 1024) = qr[d0];
    __builtin_amdgcn_sched_barrier(0); }
  __syncthreads();
  asm volatile("s_waitcnt vmcnt(0)" ::: "memory"); SWRITE(0, SE); __syncthreads();
  QKT(pA0, pA1, K_lds); if (mask0) mask_meta_tile(pA0, pA1); partialSM(pA0, pA1, m_reg, mnA, alA);
  SLOAD(SO, 1); if (SD == 2) SLOAD(SE, 2);
  SWAIT(); SWRITE(1, SO); __syncthreads();
  if (MODE == 0) {
    int sj = 1, slast = 1;
    for (int j = 1; j + 1 < NT; j += 2) {
      const int s0_ = sj, s1_ = sj == 2 ? 0 : sj + 1, s2_ = s1_ == 2 ? 0 : s1_ + 1;
      SBAR(); QKT(pB0, pB1, (u16*)((char*)K_lds + s0_ * SHM_K));
      finishSM(pA0, pA1, alA, l_reg, pa0, pa1, pa2, pa3); SBAR();
      { const int tn = (j + 2 < NT) ? j + 2 : NT - 1; SLOAD(SO, tn); } SBAR();
      pv_d0(o, vb0 + s2_ * (int)SHM_V, pa0, pa1, pa2, pa3); partialSM(pB0, pB1, m_reg, mnB, alB);
      SWAIT(); SWRITE(s1_, SE);
      RESC(alB); __syncthreads();
      SBAR(); QKT(pA0, pA1, (u16*)((char*)K_lds + s1_ * SHM_K));
      finishSM(pB0, pB1, alB, l_reg, pa0, pa1, pa2, pa3); SBAR();
      { const int tn = (j + 3 < NT) ? j + 3 : NT - 1; SLOAD(SE, tn); } SBAR();
      pv_d0(o, vb0 + s0_ * (int)SHM_V, pa0, pa1, pa2, pa3); partialSM(pA0, pA1, m_reg, mnA, alA);
      SWAIT(); SWRITE(s2_, SO);
      RESC(alA); __syncthreads();
      sj = s2_; slast = s1_;
    }
    finishSM(pA0, pA1, alA, l_reg, pa0, pa1, pa2, pa3); SBAR();
    pv_d0(o, vb0 + slast * (int)SHM_V, pa0, pa1, pa2, pa3);
  } else {
  for (int j = 1; j + 1 < NT; j += 2) {
    SBAR(); QKT(pB0, pB1, (u16*)((char*)K_lds + SHM_K)); WMASK(pB0, pB1, j);
    finishSM(pA0, pA1, alA, l_reg, pa0, pa1, pa2, pa3); SBAR();
    { const int tn = (j + SD < NT) ? j + SD : NT - 1; SLOAD(SO, tn); } SBAR();
    pv_d0(o, vb0, pa0, pa1, pa2, pa3); partialSM(pB0, pB1, m_reg, mnB, alB);
    __syncthreads(); SWAIT(); SWRITE(0, SE);
    RESC(alB); __syncthreads();
    SBAR(); QKT(pA0, pA1, K_lds); WMASK(pA0, pA1, j + 1);
    finishSM(pB0, pB1, alB, l_reg, pa0, pa1, pa2, pa3); SBAR();
    { const int tn = (j + 1 + SD < NT) ? j + 1 + SD : NT - 1; SLOAD(SE, tn); } SBAR();
    pv_d0(o, vb0 + (int)SHM_V, pa0, pa1, pa2, pa3); partialSM(pA0, pA1, m_reg, mnA, alA);
    __syncthreads(); SWAIT(); SWRITE(1, SO);
    RESC(alA); __syncthreads();
  }
  finishSM(pA0, pA1, alA, l_reg, pa0, pa1, pa2, pa3); SBAR();
  pv_d0(o, vb0, pa0, pa1, pa2, pa3);
  }
  if (MODE == 1) l_reg += __builtin_amdgcn_exp2f(sinkL2 - m_reg * (SCALE * 1.4426950408889634f));
  if (MODE == 0 && po != nullptr) {
    if (store) {
      if (hi == 0) { pml[2 * r32] = m_reg; pml[2 * r32 + 1] = l_reg; }
#pragma unroll
      for (int r = 0; r < 16; ++r) { const int orow = crow(r, hi);
#pragma unroll
        for (int d0 = 0; d0 < 4; ++d0) po[orow * 128 + d0 * 32 + r32] = o[d0][r]; }
    }
  } else {
  if (hi == 0) li_l[r32] = l_reg; asm volatile("s_waitcnt lgkmcnt(0)" ::: "memory");
  float rli[16];
#pragma unroll
  for (int r = 0; r < 16; ++r) rli[r] = __builtin_amdgcn_rcpf(li_l[crow(r, hi)]);
  if (store) {
    const bool odd = (r32 & 1) != 0;
#pragma unroll
    for (int r = 0; r < 16; r += 2) { const int orow = crow(r, hi) + (odd ? 1 : 0); const long ro = metaq ? (long)(orow & 15) * LDO + (orow >> 4) * 128 : (long)orow * LDO;
#pragma unroll
      for (int d0 = 0; d0 < 4; ++d0) { const float va = o[d0][r] * rli[r], vb = o[d0][r + 1] * rli[r + 1];
        const float snd = odd ? va : vb;
        const float rcv = __int_as_float(__builtin_amdgcn_update_dpp(0, __float_as_int(snd), 0xB1  , 0xF, 0xF, true));
        *(unsigned*)(Ow + ro + d0 * 32 + (r32 & ~1)) = cvtpk(odd ? rcv : va, odd ? vb : rcv); } }
  }
  }
#undef KROW
#undef QKT
#undef SLOAD
#undef SWRITE
#undef SWAIT
#undef RESC
#undef WMASK
}
}
typedef unsigned short u16;
typedef float f32x4 __attribute__((ext_vector_type(4)));
typedef float f32x2 __attribute__((ext_vector_type(2)));
typedef unsigned u32x4 __attribute__((ext_vector_type(4)));
typedef unsigned u32x2 __attribute__((ext_vector_type(2)));
typedef short bf16x8 __attribute__((ext_vector_type(8)));
typedef short s16x4 __attribute__((ext_vector_type(4)));
#define LAS __attribute__((address_space(3)))

constexpr int DM = 2048, NH = 16, NKV = 4, HD = 128, QKVD = 3072, DFF = 5632, NMETA = 16, NSEQ = 4;
constexpr int TREAL = 49152, MROW0 = TREAL, TTOK = TREAL + NSEQ * NMETA  , TPAD = 49408  ;
constexpr float EPS = 1e-6f;
__host__ __device__ constexpr int seq_S(int s) { return s < 2 ? 8192 : 16384; }
__host__ __device__ constexpr int seq_R0(int s) { return s == 0 ? 0 : s == 1 ? 8192 : s == 2 ? 16384 : 32768; }
__host__ __device__ constexpr int seq_K0(int s) { return s == 0 ? 0 : s == 1 ? 8256 : s == 2 ? 16512 : 32960; }
__host__ __device__ constexpr int seq_Y0(int s) { return s == 0 ? 0 : s == 1 ? 8208 : s == 2 ? 16416 : 32816; }
constexpr int P_N1 = 76, P_N2 = 108, S_N1 = 100, S_N2 = 164;
constexpr int FA_P_J = 160, FA_P_KK = 160, FB_P_J = 224, FB_P_KK = 112, FA_S_J = 224, FA_S_KK = 208, FB_S_J = 352, FB_S_KK = 176;

constexpr size_t MiB = 1u << 20;
constexpr size_t WS_CTL = 0, CTL_ZERO_BYTES = 1 * MiB;
constexpr size_t WS_ROPE = 1 * MiB;
constexpr size_t WS_FC = WS_ROPE + 64 * 1024;
constexpr size_t WS_FA_P = WS_FC + 256 * 1024, WS_FB_P = WS_FA_P + 128 * 1024, WS_FA_S = WS_FB_P + 128 * 1024, WS_FB_S = WS_FA_S + 128 * 1024;
constexpr size_t WS_HMETA = 2 * MiB;
constexpr size_t WS_W = 4 * MiB;
constexpr size_t W_AQKV = 0, W_AWO = W_AQKV + (size_t)QKVD * DM, W_BW = W_AWO + (size_t)DM * DM, W_CIN = W_BW + (size_t)DM * DM, W_COUT = W_CIN + (size_t)3 * DM * DM,
                 W_DQKV = W_COUT + (size_t)DM * DM, W_DWO = W_DQKV + (size_t)QKVD * DM, W_FIN = W_DWO + (size_t)DM * DM, W_FOUT = W_FIN + (size_t)4 * 2 * DFF * DM, W_END = W_FOUT + (size_t)4 * DFF * DM;
constexpr size_t WS_HB = WS_W + 352 * MiB;
constexpr size_t WS_BIG = WS_HB + 193 * MiB;
constexpr size_t BIG_QKV = 0, BIG_KC = 290 * MiB, BIG_VC = 339 * MiB;
constexpr size_t BIG_PO = 400 * MiB, BIG_PML = 410 * MiB;
constexpr size_t BIG_SS = 560 * MiB, BIG_RSTD = 570 * MiB;
constexpr size_t BIG_TAILP = 540 * MiB;
constexpr size_t BIG_ACT = 0;
constexpr size_t BIG_BB = 0, BIG_GB = 193 * MiB;
constexpr size_t BIG_Z = 0, BIG_Y = 385 * MiB;
constexpr size_t WS_END = WS_BIG + 770 * MiB;
static_assert(W_END * 2 <= 352 * MiB && (size_t)TPAD * DM * 2 <= 193 * MiB && (size_t)TPAD * QKVD * 2 <= 290 * MiB && (size_t)TPAD * 512 * 2 <= 49 * MiB, "ws map");
static_assert((size_t)TPAD * DFF * 2 <= 770 * MiB && (size_t)TTOK * 4096 * 2 <= 385 * MiB, "ws map");
constexpr int CW_BAR = 4096;

constexpr int LDS_STAGE = 133120;
constexpr int LDS_MISC = LDS_STAGE;
constexpr int LDS_BYTES = LDS_STAGE + 256;

#define XB_TMO      128
#define XB_XCNT(j)  (256  + 64 * (j))
#define XB_XSUB(j)  (1280 + 64 * (j))
#define XB_XGEN(j)  (2304 + 64 * (j))
#define XB_TOP      3328
#define XB_TOPGEN   3392
#define XCD_BAR_WORDS 3456
#define XB_SPIN_CAP (1u << 18)
__device__ __forceinline__ unsigned xb_ld(unsigned* p)              { return __hip_atomic_load(p, __ATOMIC_RELAXED, __HIP_MEMORY_SCOPE_AGENT); }
__device__ __forceinline__ unsigned xb_add(unsigned* p, unsigned v) { return __hip_atomic_fetch_add(p, v, __ATOMIC_RELAXED, __HIP_MEMORY_SCOPE_AGENT); }
__device__ __forceinline__ unsigned xb_xcc_id() { return (unsigned)__builtin_amdgcn_s_getreg((3 << 11) | 20) & 0xFu; }
#define XB_SPIN(cond, bar) do { unsigned _sp = 0; while (cond) { __builtin_amdgcn_s_sleep(1); \
    if ((++_sp & 255u) == 0u) { if (xb_ld(&(bar)[XB_TMO])) break; if (_sp > XB_SPIN_CAP) { atomicAdd(&(bar)[XB_TMO], 1u); break; } } } } while (0)
struct XcdBarrier { unsigned* bar; unsigned x; volatile LAS unsigned* st; };
__device__ __forceinline__ XcdBarrier xcd_barrier_post(unsigned* bar, volatile LAS unsigned* st) {
    XcdBarrier b; b.bar = bar; b.x = xb_xcc_id(); b.st = st;
    if (threadIdx.x == 0) (void)xb_add(&bar[XB_XCNT(b.x)], 1u);
    return b;
}
__device__ __forceinline__ void xcd_barrier_complete(unsigned* bar, unsigned x, unsigned& nloc, unsigned& nx) {
    const unsigned G = gridDim.x * gridDim.y * gridDim.z;
    unsigned sum, cnt, mine, sp = 0u;
    for (;;) {
        sum = 0u; cnt = 0u; mine = 0u;
#pragma unroll
        for (unsigned j = 0; j < 16; ++j) { const unsigned c = xb_ld(&bar[XB_XCNT(j)]); sum += c; cnt += (c > 0u) ? 1u : 0u; mine = (j == x) ? c : mine; }
        if (sum == G) break;
        __builtin_amdgcn_s_sleep(1);
        if ((++sp & 255u) == 0u) { if (xb_ld(&bar[XB_TMO])) break; if (sp > XB_SPIN_CAP) { atomicAdd(&bar[XB_TMO], 1u); break; } }
    }
    nloc = mine > 0u ? mine : 1u; nx = cnt > 0u ? cnt : 1u;
}
__device__ __forceinline__ void xcd_barrier(const XcdBarrier& b) {
    asm volatile("s_waitcnt vmcnt(0)" ::: "memory");
    __syncthreads();
    if (threadIdx.x == 0) {
        unsigned* bar = b.bar;
        __builtin_amdgcn_s_waitcnt(0);
        unsigned nloc = b.st[0], nx = b.st[1];
        if (nloc == 0u) { xcd_barrier_complete(bar, b.x, nloc, nx); b.st[0] = nloc; b.st[1] = nx; }
        const unsigned old = xb_add(&bar[XB_XSUB(b.x)], 1u);
        const unsigned gen = old / nloc;
        if (old + 1u == (gen + 1u) * nloc) {
            __builtin_amdgcn_fence(__ATOMIC_RELEASE, "agent");
            asm volatile("s_waitcnt vmcnt(0)" ::: "memory");
            const unsigned og = xb_add(&bar[XB_TOP], 1u);
            const unsigned tg = og / nx;
            if (og + 1u == (tg + 1u) * nx) xb_add(&bar[XB_TOPGEN], 1u);
            else XB_SPIN(xb_ld(&bar[XB_TOPGEN]) == tg, bar);
            __builtin_amdgcn_fence(__ATOMIC_ACQUIRE, "agent");
            xb_add(&bar[XB_XGEN(b.x)], 1u);
            asm volatile("s_waitcnt vmcnt(0)" ::: "memory");
        } else {
            XB_SPIN(xb_ld(&bar[XB_XGEN(b.x)]) == gen, bar);
            __builtin_amdgcn_fence(__ATOMIC_ACQUIRE, "agent");
            asm volatile("s_waitcnt vmcnt(0)" ::: "memory");
        }
    }
    __syncthreads();
}

struct Job { const float* src; u16* dst; const float* gain; int K, ld, col0, ncols, split, mult, roff, item0; };
struct Params {
    const float* in[20]; float* out; unsigned char* ws;
    int ph_lo, ph_hi;
};
enum { I_XP = 0, I_XS, I_META, I_LNMIX, I_LNFFN, I_AWQKV, I_AQN, I_AKN, I_AWO, I_BW, I_CWIN, I_CCONV, I_CWOUT, I_DWQKV, I_DQN, I_DKN, I_DSINK, I_DWO, I_FIN, I_FOUT };

#define GAS __attribute__((address_space(1)))
#define LAUNDER_PTR(T, name, src) GAS char* name##_g = (GAS char*)(src); asm volatile("" : "+s"(name##_g)); T name = (T)name##_g
template <int M> __device__ __forceinline__ float swz_xor(float v) { return __int_as_float(__builtin_amdgcn_ds_swizzle(__float_as_int(v), 0x1f | (M << 10))); }
__device__ __forceinline__ float wave_sum(float v) {
    v += swz_xor<1>(v); v += swz_xor<2>(v); v += swz_xor<4>(v); v += swz_xor<8>(v); v += swz_xor<16>(v);
    const auto rr = __builtin_amdgcn_permlane32_swap(__float_as_uint(v), __float_as_uint(v), false, false);
    return __uint_as_float(rr[0]) + __uint_as_float(rr[1]);
}
__device__ __forceinline__ unsigned pk2(float lo, float hi) { unsigned r; asm volatile("v_cvt_pk_bf16_f32 %0, %1, %2" : "=v"(r) : "v"(lo), "v"(hi)); return r; }
__device__ __forceinline__ float bflo(unsigned w) { return __uint_as_float(w << 16); }
__device__ __forceinline__ float bfhi(unsigned w) { return __uint_as_float(w & 0xffff0000u); }
__device__ __forceinline__ int rowmap(int s, int l) { return l < NMETA ? MROW0 + NMETA * s + l : seq_R0(s) + l - NMETA; }

__device__ __forceinline__ void transpose_item(const Job& jb, LAS float* scr, int item, int lane) {
    const int nblk = jb.ncols / 64, kb = item / nblk, nb = item % nblk, k0 = 64 * kb, n0 = 64 * nb;
    const float* W = jb.src + jb.col0;
#pragma unroll 8
    for (int kk = 0; kk < 64; ++kk) scr[kk * 65 + lane] = W[(size_t)(k0 + kk) * jb.ld + n0 + lane];
    asm volatile("s_waitcnt lgkmcnt(0)" ::: "memory");
    const int c = lane & 7;
    f32x4 ga = {1.f, 1.f, 1.f, 1.f}, gb = ga;
    if (jb.gain) { ga = *(const f32x4*)(jb.gain + k0 + 8 * c); gb = *(const f32x4*)(jb.gain + k0 + 8 * c + 4); }
#pragma unroll
    for (int j = 0; j < 8; ++j) { const int n = (lane >> 3) + 8 * j; const LAS float* s = scr + (8 * c) * 65 + n;
        u32x4 o; o.x = pk2(s[0 * 65] * ga.x, s[1 * 65] * ga.y); o.y = pk2(s[2 * 65] * ga.z, s[3 * 65] * ga.w); o.z = pk2(s[4 * 65] * gb.x, s[5 * 65] * gb.y); o.w = pk2(s[6 * 65] * gb.z, s[7 * 65] * gb.w);
        const int nn = n0 + n; int drow;
        if (jb.mult == 1) drow = jb.roff + nn;
        else { const int part = nn / jb.split, jj = nn % jb.split, o = jj & 127;
            drow = jb.roff + (jj >> 7) * 256 + ((o >> 2) & 1) * 128 + (o >> 5) * 32 + ((o >> 3) & 3) * 8 + (o & 3) * 2 + part; }
        *(u32x4*)(jb.dst + (size_t)drow * jb.K + k0 + 8 * c) = o; }
    asm volatile("s_waitcnt lgkmcnt(0)" ::: "memory");
}
__device__ __forceinline__ u16 f2bf(float f) { return (u16)(pk2(f, f) & 0xffffu); }
__device__ __forceinline__ void gen_FA(u16* F, int N1, int Jp, int KKp, int gt, int ngt) {
    for (int e = gt; e < KKp * Jp; e += ngt) { const int kk = e / Jp, j = e % Jp; float v = 0.f;
        if (kk < 2 * N1 && j < 2 * N1) { const int po = kk >= N1, pi = j >= N1, k1 = kk - po * N1, l1 = j - pi * N1; float sn, cs; sincospif(2.0f * (float)((k1 * l1) % N1) / (float)N1, &sn, &cs);
            v = (po == pi) ? cs : (po ? -sn : sn); }
        F[e] = f2bf(v); }
}
__device__ __forceinline__ void gen_FB(u16* F, int N2, int Jp, int KKp, float scale, int gt, int ngt) {
    for (int e = gt; e < KKp * Jp; e += ngt) { const int kk = e / Jp, j = e % Jp; float v = 0.f;
        if (kk < N2 && j < 2 * N2) { const int pi = j >= N2, l2 = j - pi * N2; float sn, cs; sincospif(2.0f * (float)((kk * l2) % N2) / (float)N2, &sn, &cs); v = (pi ? sn : cs) * scale; }
        F[e] = f2bf(v); }
}
__device__ __forceinline__ void prologue_phase(const Params& P, LAS unsigned char* lds, int wave_, int lane_) {
    int tid_q = threadIdx.x; asm volatile("" : "+v"(tid_q)); const int lane = tid_q & 63, wave = __builtin_amdgcn_readfirstlane(tid_q >> 6); (void)lane_; (void)wave_;
    LAUNDER_PTR(unsigned char*, ws, P.ws);
    LAS float* scr = (LAS float*)(lds + wave * 16640);
    const int gw = blockIdx.x * 8 + wave, NGW = gridDim.x * 8;
    u16* Wb = (u16*)(ws + WS_W);
    constexpr int IT_S = 32 * 32  , IT_QKV = 32 * 48, IT_CU = 32 * 64, IT_FIN = 32 * 176, IT_FOUT = 88 * 32;
    constexpr int O1 = IT_QKV, O2 = O1 + IT_S, O3 = O2 + IT_S, O4 = O3 + IT_S, O5 = O4 + IT_CU, O6 = O5 + IT_S, O7 = O6 + IT_QKV, O8 = O7 + IT_S, O9 = O8 + 4 * IT_FIN, O10 = O9 + 4 * IT_FOUT;
    for (int it = gw; it < O10; it += NGW) {
        Job jb;
        if (it < O1)      jb = Job{P.in[I_AWQKV], Wb + W_AQKV, P.in[I_LNMIX], DM, QKVD, 0, QKVD, QKVD, 1, 0, 0};
        else if (it < O2) jb = Job{P.in[I_AWO], Wb + W_AWO, nullptr, DM, DM, 0, DM, DM, 1, 0, O1};
        else if (it < O3) jb = Job{P.in[I_BW], Wb + W_BW, nullptr, DM, DM, 0, DM, DM, 1, 0, O2};
        else if (it < O4) jb = Job{P.in[I_CWIN], Wb + W_CIN, P.in[I_LNMIX] + 2 * DM, DM, 3 * DM, 0, DM, DM, 1, 0, O3};
        else if (it < O5) jb = Job{P.in[I_CWIN], Wb + W_CIN, P.in[I_LNMIX] + 2 * DM, DM, 3 * DM, DM, 2 * DM, DM, 2, DM, O4};
        else if (it < O6) jb = Job{P.in[I_CWOUT], Wb + W_COUT, nullptr, DM, DM, 0, DM, DM, 1, 0, O5};
        else if (it < O7) jb = Job{P.in[I_DWQKV], Wb + W_DQKV, P.in[I_LNMIX] + 3 * DM, DM, QKVD, 0, QKVD, QKVD, 1, 0, O6};
        else if (it < O8) jb = Job{P.in[I_DWO], Wb + W_DWO, nullptr, DM, DM, 0, DM, DM, 1, 0, O7};
        else if (it < O9) { const int l = (it - O8) / IT_FIN; jb = Job{P.in[I_FIN] + (size_t)l * DM * 2 * DFF, Wb + W_FIN + (size_t)l * 2 * DFF * DM, P.in[I_LNFFN] + l * DM, DM, 2 * DFF, 0, 2 * DFF, DFF, 2, 0, O8 + l * IT_FIN}; }
        else { const int l = (it - O9) / IT_FOUT; jb = Job{P.in[I_FOUT] + (size_t)l * DFF * DM, Wb + W_FOUT + (size_t)l * DFF * DM, nullptr, DFF, DM, 0, DM, DM, 1, 0, O9 + l * IT_FOUT}; }
        transpose_item(jb, scr, it - jb.item0, lane);
    }
    const int gt = blockIdx.x * 512 + threadIdx.x, ngt = gridDim.x * 512;
    { float2* tab = (float2*)(ws + WS_ROPE);
      for (int e = gt; e < 256 * 32; e += ngt) { const int pos = e >> 5, i = e & 31; const double ang = (double)pos * pow(10000.0, -(double)i / 32.0); tab[e] = make_float2((float)cos(ang), (float)sin(ang)); } }
    { u16* fc = (u16*)(ws + WS_FC);
      for (int e = gt; e < 512 * 256; e += ngt) { const int n = e >> 8, c = e & 255, cp = n & 255; float sn, cs; sincospif(2.0f * (float)((c * cp) & 255) / 256.0f, &sn, &cs); fc[e] = f2bf(n < 256 ? cs : -sn); } }
    gen_FA((u16*)(ws + WS_FA_P), P_N1, FA_P_J, FA_P_KK, gt, ngt);
    gen_FA((u16*)(ws + WS_FA_S), S_N1, FA_S_J, FA_S_KK, gt, ngt);
    gen_FB((u16*)(ws + WS_FB_P), P_N2, FB_P_J, FB_P_KK, 1.0f / sqrtf(256.0f * 8208.0f), gt, ngt);
    gen_FB((u16*)(ws + WS_FB_S), S_N2, FB_S_J, FB_S_KK, 1.0f / sqrtf(256.0f * 16400.0f), gt, ngt);
}

template <bool EMBED>
__device__ __forceinline__ void norm_phase(const Params& P, const float* gain, int nks  , int wave_, int lane_) {
    int tid_q = threadIdx.x; asm volatile("" : "+v"(tid_q)); const int lane = tid_q & 63, wave = __builtin_amdgcn_readfirstlane(tid_q >> 6); (void)lane_; (void)wave_;
    LAUNDER_PTR(unsigned char*, ws, P.ws);
    LAUNDER_PTR(float*, outp, P.out); u16* X = (u16*)outp; u16* HB = (u16*)(ws + WS_HB); float* hmeta = (float*)(ws + WS_HMETA);
    const int gw = blockIdx.x * 8 + wave, NGW = gridDim.x * 8;
    LAUNDER_PTR(const float*, gainp, gain);
    f32x4 g[8];
#pragma unroll
    for (int j = 0; j < 8; ++j) g[j] = ((const f32x4*)gainp)[lane + 64 * j];
    for (int r = gw; r < TTOK; r += NGW) {
        f32x4 v[8];
        if (r < TREAL) {
            if (EMBED) { const float* src = r < 16384 ? P.in[I_XP] + (size_t)r * DM : P.in[I_XS] + (size_t)(r - 16384) * DM;
#pragma unroll
                for (int j = 0; j < 8; ++j) v[j] = ((const f32x4*)src)[lane + 64 * j];
                u32x2* hb = (u32x2*)(HB + (size_t)r * DM);
#pragma unroll
                for (int j = 0; j < 8; ++j) { u32x2 w; w.x = pk2(v[j].x, v[j].y); w.y = pk2(v[j].z, v[j].w); hb[lane + 64 * j] = w;
                    v[j] = (f32x4){bflo(w.x), bfhi(w.x), bflo(w.y), bfhi(w.y)}; }
            } else { const u32x2* hb = (const u32x2*)(HB + (size_t)r * DM);
#pragma unroll
                for (int j = 0; j < 8; ++j) { const u32x2 w = hb[lane + 64 * j]; v[j] = (f32x4){bflo(w.x), bfhi(w.x), bflo(w.y), bfhi(w.y)}; } }
        } else {
            float* hdst = hmeta + (size_t)(r - TREAL) * DM; const float* src = EMBED ? P.in[I_META] + (size_t)((r - TREAL) & 15) * DM : hdst;
#pragma unroll
            for (int j = 0; j < 8; ++j) v[j] = ((const f32x4*)src)[lane + 64 * j];
            if (!EMBED) {
                const float* tp = (const float*)(ws + WS_BIG + BIG_TAILP) + (size_t)(r - TREAL) * DM;
                for (int ks = 0; ks < nks; ++ks) {
#pragma unroll
                    for (int j = 0; j < 8; ++j) v[j] += ((const f32x4*)(tp + (size_t)ks * 64 * DM))[lane + 64 * j]; }
            }
#pragma unroll
            for (int j = 0; j < 8; ++j) ((f32x4*)hdst)[lane + 64 * j] = v[j];
        }
        float ss = 0.f;
#pragma unroll
        for (int j = 0; j < 8; ++j) ss += (v[j].x * v[j].x + v[j].y * v[j].y) + (v[j].z * v[j].z + v[j].w * v[j].w);
        const float rstd = 1.0f / sqrtf(wave_sum(ss) * (1.0f / DM) + EPS);
        u32x2* o = (u32x2*)(X + (size_t)r * DM);
#pragma unroll
        for (int j = 0; j < 8; ++j) { u32x2 w; w.x = pk2(v[j].x * rstd * g[j].x, v[j].y * rstd * g[j].y); w.y = pk2(v[j].z * rstd * g[j].z, v[j].w * rstd * g[j].w); o[lane + 64 * j] = w; }
    }
}

__device__ __forceinline__ void embed_phase(const Params& P) {
    int tid_q = threadIdx.x; asm volatile("" : "+v"(tid_q)); const int lane = tid_q & 63, wave = __builtin_amdgcn_readfirstlane(tid_q >> 6);
    LAUNDER_PTR(unsigned char*, ws, P.ws);
    u16* HB = (u16*)(ws + WS_HB); float* hmeta = (float*)(ws + WS_HMETA); float* rstdp = (float*)(ws + WS_BIG + BIG_RSTD);
    const int gw = blockIdx.x * 8 + wave, NGW = gridDim.x * 8;
    for (int r = gw; r < TTOK; r += NGW) {
        const float* src = r < 16384 ? P.in[I_XP] + (size_t)r * DM : r < TREAL ? P.in[I_XS] + (size_t)(r - 16384) * DM : P.in[I_META] + (size_t)((r - TREAL) & 15) * DM;
        f32x4 v[8]; float ss = 0.f;
#pragma unroll
        for (int j = 0; j < 8; ++j) v[j] = ((const f32x4*)src)[lane + 64 * j];
        if (r >= TREAL) {
#pragma unroll
            for (int j = 0; j < 8; ++j) ((f32x4*)(hmeta + (size_t)(r - TREAL) * DM))[lane + 64 * j] = v[j];
        }
        u32x2* hb = (u32x2*)(HB + (size_t)r * DM);
#pragma unroll
        for (int j = 0; j < 8; ++j) { u32x2 w; w.x = pk2(v[j].x, v[j].y); w.y = pk2(v[j].z, v[j].w); hb[lane + 64 * j] = w;
            ss += (v[j].x * v[j].x + v[j].y * v[j].y) + (v[j].z * v[j].z + v[j].w * v[j].w); }
        const float rstd = 1.0f / sqrtf(wave_sum(ss) * (1.0f / DM) + EPS);
        if (lane == 0) rstdp[r] = rstd;
    }
}
__device__ __forceinline__ void stats_phase(const Params& P, int nks) {
    int tid_q = threadIdx.x; asm volatile("" : "+v"(tid_q)); const int lane = tid_q & 63, wave = __builtin_amdgcn_readfirstlane(tid_q >> 6);
    LAUNDER_PTR(unsigned char*, ws, P.ws);
    u16* HB = (u16*)(ws + WS_HB); float* hmeta = (float*)(ws + WS_HMETA); float* rstdp = (float*)(ws + WS_BIG + BIG_RSTD); const float* SS = (const float*)(ws + WS_BIG + BIG_SS);
    for (int r = blockIdx.x * 512 + tid_q; r < TREAL; r += gridDim.x * 512) {
        float s = 0.f, pv[32];
#pragma unroll
        for (int j = 0; j < 32; ++j) pv[j] = SS[(size_t)j * TREAL + r];
        __builtin_amdgcn_sched_barrier(0);
#pragma unroll
        for (int j = 0; j < 32; j += 4) s += (pv[j] + pv[j + 1]) + (pv[j + 2] + pv[j + 3]);
        rstdp[r] = 1.0f / sqrtf(s * (1.0f / DM) + EPS);
    }
    const int gw = blockIdx.x * 8 + wave;
    const int mrow = (int)(gridDim.x * 8) - 1 - gw;
    if (mrow < NSEQ * NMETA) {
        float* hrow = hmeta + (size_t)mrow * DM; const float* tp = (const float*)(ws + WS_BIG + BIG_TAILP) + (size_t)mrow * DM;
        f32x4 v[8]; float ss = 0.f;
#pragma unroll
        for (int j = 0; j < 8; ++j) v[j] = ((const f32x4*)hrow)[lane + 64 * j];
        for (int ks = 0; ks < nks; ++ks) {
#pragma unroll
            for (int j = 0; j < 8; ++j) v[j] += ((const f32x4*)(tp + (size_t)ks * 64 * DM))[lane + 64 * j]; }
        u32x2* hb = (u32x2*)(HB + (size_t)(TREAL + mrow) * DM);
#pragma unroll
        for (int j = 0; j < 8; ++j) { ((f32x4*)hrow)[lane + 64 * j] = v[j]; u32x2 w; w.x = pk2(v[j].x, v[j].y); w.y = pk2(v[j].z, v[j].w); hb[lane + 64 * j] = w;
            ss += (v[j].x * v[j].x + v[j].y * v[j].y) + (v[j].z * v[j].z + v[j].w * v[j].w); }
        const float rstd = 1.0f / sqrtf(wave_sum(ss) * (1.0f / DM) + EPS);
        if (lane == 0) rstdp[TREAL + mrow] = rstd;
    }
}

__device__ __forceinline__ size_t kc_off(int s, int kvh, int lrow) { return ((size_t)seq_K0(s) * 4 + (size_t)kvh * (64 + seq_S(s)) + lrow) * HD; }
template <bool ROPE>
__device__ __forceinline__ void qkprep_phase(const Params& P, const float* qgain, const float* kgain, int wave_, int lane_) {
    int tid_q = threadIdx.x; asm volatile("" : "+v"(tid_q)); const int lane = tid_q & 63, wave = __builtin_amdgcn_readfirstlane(tid_q >> 6); (void)lane_; (void)wave_;
    LAUNDER_PTR(unsigned char*, ws, P.ws);
    u16* QKV = (u16*)(ws + WS_BIG + BIG_QKV); u16* Kc = (u16*)(ws + WS_BIG + BIG_KC); u16* Vc = (u16*)(ws + WS_BIG + BIG_VC);
    const float2* tab = (const float2*)(ws + WS_ROPE);
    const int gw = blockIdx.x * 8 + wave, NGW = gridDim.x * 8;
    const int li = lane & 15, hg = lane >> 4;
    float qg[8], kg[8];
#pragma unroll
    for (int e = 0; e < 8; ++e) { qg[e] = qgain[8 * li + e]; kg[e] = kgain[8 * li + e]; }
    __syncthreads();
#define QK_GLD(dst_, ptr_) asm volatile("global_load_dwordx4 %0, %1, off" : "=v"(dst_) : "v"(ptr_) : "memory")
#define QK_ROWINFO(r_, krow_, rowpos_, colpos_, s_) do { if ((r_) < TREAL) { s_ = (r_) < 8192 ? 0 : (r_) < 16384 ? 1 : (r_) < 32768 ? 2 : 3; const int p_ = (r_) - seq_R0(s_); krow_ = 64 + p_; rowpos_ = p_ >> 6; colpos_ = p_ & 63; } \
        else { const int m_ = (r_) - TREAL; s_ = m_ >> 4; krow_ = m_ & 15; rowpos_ = 0; colpos_ = 0; } } while (0)
#define QK_LOADROW(buf_, tb_, r_) do { int kr_, rp_, cp_, s2_; QK_ROWINFO(r_, kr_, rp_, cp_, s2_); (void)kr_; (void)s2_; const u16* q_ = QKV + (size_t)(r_) * QKVD; \
        _Pragma("unroll") for (int it = 0; it < 5; ++it) QK_GLD(buf_[it], q_ + (it * 4 + hg) * HD + 8 * li); QK_GLD(buf_[5], q_ + 2560 + 8 * lane); \
        if (ROPE) { const int pos_ = (li & 8) ? cp_ : rp_; const float2* t_ = tab + pos_ * 32 + 8 * (li & 3); _Pragma("unroll") for (int e = 0; e < 4; ++e) QK_GLD(tb_[e], t_ + 2 * e); } } while (0)
    u32x4 cb[6], nb[6], ct[4], nt[4];
#define QK_ROW(CB, CT, NB, NT, WAIT0) do { \
        const int rn = r + NGW; \
        if (WAIT0) asm volatile("s_waitcnt vmcnt(0)" ::: "memory"); else asm volatile("s_waitcnt vmcnt(6)" ::: "memory");     \
        _Pragma("unroll") for (int i = 0; i < 6; ++i) asm volatile("" : "+v"(CB[i])); \
        if (ROPE) { _Pragma("unroll") for (int i = 0; i < 4; ++i) asm volatile("" : "+v"(CT[i])); } \
        if (rn < TTOK) QK_LOADROW(NB, NT, rn); \
        int krow, rowpos, colpos, s; QK_ROWINFO(r, krow, rowpos, colpos, s); (void)rowpos; (void)colpos; \
        u16* qrow = QKV + (size_t)r * QKVD; \
        float cs[8], sn[8]; \
        if (ROPE) { _Pragma("unroll") for (int e = 0; e < 4; ++e) { cs[2 * e] = __uint_as_float(CT[e].x); sn[2 * e] = __uint_as_float(CT[e].y); cs[2 * e + 1] = __uint_as_float(CT[e].z); sn[2 * e + 1] = __uint_as_float(CT[e].w); } } \
        _Pragma("unroll") for (int it = 0; it < 5; ++it) { \
            u16* ptr = qrow + (it * 4 + hg) * HD + 8 * li; \
            const u32x4 w = CB[it]; \
            float x[8] = {bflo(w.x), bfhi(w.x), bflo(w.y), bfhi(w.y), bflo(w.z), bfhi(w.z), bflo(w.w), bfhi(w.w)}; \
            float ss = 0.f; \
            _Pragma("unroll") for (int e = 0; e < 8; ++e) ss += x[e] * x[e]; \
            ss += swz_xor<1>(ss); ss += swz_xor<2>(ss); ss += swz_xor<4>(ss); ss += swz_xor<8>(ss); \
            const float rs = 1.0f / sqrtf(ss * (1.0f / HD) + EPS); \
            float y[8]; \
            _Pragma("unroll") for (int e = 0; e < 8; ++e) y[e] = x[e] * rs * (it < 4 ? qg[e] : kg[e]); \
            if (ROPE) { _Pragma("unroll") for (int e = 0; e < 8; ++e) { const float yp = swz_xor<4>(y[e]); y[e] = (li & 4) ? (yp * sn[e] + y[e] * cs[e]) : (y[e] * cs[e] - yp * sn[e]); } } \
            u32x4 o; o.x = pk2(y[0], y[1]); o.y = pk2(y[2], y[3]); o.z = pk2(y[4], y[5]); o.w = pk2(y[6], y[7]); \
            if (it < 4) *(u32x4*)ptr = o; \
            else *(u32x4*)(Kc + kc_off(s, hg, krow) + 8 * li) = o; \
        } \
        *(u32x4*)(Vc + kc_off(s, lane >> 4, krow) + 8 * (lane & 15)) = CB[5]; \
    } while (0)
    int r = gw;
    if (r < TTOK) { QK_LOADROW(cb, ct, r); QK_ROW(cb, ct, nb, nt, true); r += NGW; }
    for (; r < TTOK; r += 2 * NGW) {
        QK_ROW(nb, nt, cb, ct, false);
        r += NGW; if (r >= TTOK) break;
        QK_ROW(cb, ct, nb, nt, false);
        r -= NGW;
    }
#undef QK_ROW
    for (int mrow = gw; mrow < 4 * NMETA; mrow += NGW) { const int s = mrow >> 4, mi = mrow & 15; const u32x4 z = {0u, 0u, 0u, 0u};
#pragma unroll
        for (int q = 0; q < 3; ++q) { const size_t pr = kc_off(s, lane >> 4, 16 + 3 * mi + q) + 8 * (lane & 15); *(u32x4*)(Kc + pr) = z; *(u32x4*)(Vc + pr) = z; } }
#undef QK_GLD
#undef QK_ROWINFO
#undef QK_LOADROW
}

template <int MODE>
__device__ __forceinline__ void attn_phase(const Params& P, const float* sinks, char* lds, int wave_, int lane_) {
    int tid_q = threadIdx.x; asm volatile("" : "+v"(tid_q)); const int lane = tid_q & 63, wave = __builtin_amdgcn_readfirstlane(tid_q >> 6); (void)lane_; (void)wave_;
    LAUNDER_PTR(unsigned char*, ws, P.ws);
    const u16* QKV = (const u16*)(ws + WS_BIG + BIG_QKV); const u16* Kc = (const u16*)(ws + WS_BIG + BIG_KC); const u16* Vc = (const u16*)(ws + WS_BIG + BIG_VC);
    LAUNDER_PTR(float*, outp, P.out); u16* X = (u16*)outp;
    const int r32 = lane & 31, hi = lane >> 5, G = gridDim.x;
    constexpr int NITEMS = (MODE == 0) ? 3072 + 240 : 3088;
    for (int e = blockIdx.x; e < NITEMS; e += G) {
        int s, kvh, hgp = 0, qb = 0, chunk = 0, y = 0; bool meta = false;
        if (e < 2048) { const int k = e >> 8, bb = e & 255, x = bb & 7, i = bb >> 3, id = i + 32 * k; s = 2 + (x >> 2); kvh = x & 3; hgp = id >> 6; qb = id & 63; }
        else if (e < 3072) { const int e2 = e - 2048, k = e2 >> 8, bb = e2 & 255, x = bb & 7, i = bb >> 3, id = i + 32 * k; s = x >> 2; kvh = x & 3; hgp = id >> 5; qb = id & 31; }
        else { const int e3 = e - 3072; if (MODE == 0) { y = e3 / 15; chunk = e3 - 15 * y; } else y = e3; const int x = y & 7; s = (y < 8 ? 0 : 2) + (x >> 2); kvh = x & 3; meta = true; }
        const int S = seq_S(s);
        const u16* Kh = Kc + kc_off(s, kvh, 0); const u16* Vh = Vc + kc_off(s, kvh, 0);
        const u16* Qw; u16* Ow; int NT, ktlo = 0, tq = 0, head; bool store = true, mask0 = true; float* po = nullptr; float* pml = nullptr;
        if (!meta) {
            head = kvh * 4 + hgp; const int row = seq_R0(s) + 256 * qb + 32 * wave;
            Qw = QKV + (size_t)(row + r32) * QKVD + head * HD + hi * 8; Ow = X + (size_t)row * DM + head * HD;
            if (MODE == 0) NT = 1 + S / 64;
            else { const int t0 = 4 * qb - 2 < 0 ? 0 : 4 * qb - 2, t1 = 4 * qb + 5 > S / 64 - 1 ? S / 64 - 1 : 4 * qb + 5; ktlo = t0; NT = 2 + t1 - t0; tq = 256 * qb + 32 * wave + r32; }
        } else {
            const int w1 = wave & 1, gl = r32 >> 4, mi = r32 & 15; head = kvh * 4 + 2 * w1 + gl; store = wave < 2;
            Qw = QKV + (size_t)(MROW0 + NMETA * s + mi) * QKVD + head * HD + hi * 8; Ow = X + (size_t)(MROW0 + NMETA * s) * DM + (kvh * 4 + 2 * w1) * HD;
            if (MODE == 0) {
                if (s < 2) { ktlo = chunk < 12 ? 9 * chunk : 108 + 7 * (chunk - 12); NT = chunk < 12 ? 9 : 7; } else { ktlo = 17 * chunk; NT = chunk < 14 ? 17 : 19; }
                mask0 = (chunk == 0);
                po = (float*)(ws + WS_BIG + BIG_PO) + ((size_t)(y * 15 + chunk) * 64 + 32 * w1) * 128; pml = (float*)(ws + WS_BIG + BIG_PML) + ((size_t)(y * 15 + chunk) * 64 + 32 * w1) * 2;
            } else { NT = 3; tq = 112 + mi; }
        }
        float slopeS = 0.f, sinkL2 = 0.f;
        if (MODE == 1) { slopeS = exp2f(-0.5f * (float)(head + 1)) * (1.0f / att::SCALE); slopeS = __int_as_float(__builtin_amdgcn_readfirstlane(__float_as_int(slopeS)));
            sinkL2 = sinks[head] * 1.4426950408889634f; }
        att::attn_item<MODE>(Qw, Kh, Vh, Ow, meta, store, NT, ktlo, tq, slopeS, sinkL2, lds, mask0, po, pml);
    }
}
__device__ __forceinline__ void metacombine_phase(const Params& P) {
    int tid_q = threadIdx.x; asm volatile("" : "+v"(tid_q)); const int lane = tid_q & 63, wave = __builtin_amdgcn_readfirstlane(tid_q >> 6);
    LAUNDER_PTR(unsigned char*, ws, P.ws);
    const float* PO = (const float*)(ws + WS_BIG + BIG_PO); const float* PML = (const float*)(ws + WS_BIG + BIG_PML); LAUNDER_PTR(float*, outp, P.out); u16* X = (u16*)outp;
    constexpr float C = att::SCALE * 1.4426950408889634f;
    for (int it = blockIdx.x * 8 + wave; it < 16 * 64; it += gridDim.x * 8) {
        const int y = it >> 6, rr = it & 63, x = y & 7, s = (y < 8 ? 0 : 2) + (x >> 2), kvh = x & 3, head = kvh * 4 + (rr >> 4), mi = rr & 15;
        float mc[15], lc[15], M = -3e38f;
#pragma unroll
        for (int c = 0; c < 15; ++c) { const float2 v = *(const float2*)(PML + ((size_t)(y * 15 + c) * 64 + rr) * 2); mc[c] = v.x; lc[c] = v.y; M = fmaxf(M, v.x); }
        float L = 0.f, o0 = 0.f, o1 = 0.f;
#pragma unroll
        for (int c = 0; c < 15; ++c) { const float w = __builtin_amdgcn_exp2f((mc[c] - M) * C); L += w * lc[c];
            const float2 ov = *(const float2*)(PO + ((size_t)(y * 15 + c) * 64 + rr) * 128 + 2 * lane); o0 += w * ov.x; o1 += w * ov.y; }
        const float rl = 1.0f / L;
        *(unsigned*)(X + (size_t)(MROW0 + NMETA * s + mi) * DM + head * HD + 2 * lane) = pk2(o0 * rl, o1 * rl);
    }
}

constexpr int DFT_RS = 256;
__device__ __forceinline__ int dft_swz(int j) { return (j & 3) | ((j >> 1) & 4); }
template <int STEP, int N1, int N2, int KS  , int NMB  >
__device__ __forceinline__ void dft_run(const Params& P, size_t f_off, int s0, int boff  , LAS unsigned char* lds, int wave_, int lane_) {
    (void)lane_; (void)wave_;
    LAUNDER_PTR(unsigned char*, ws, P.ws); const u16* F = (const u16*)(ws + f_off);
    constexpr int L = N1 * N2, JP = KS * 32, J = STEP == 0 ? 2 * N1 : 2 * N2, KK = STEP == 0 ? 2 * N1 : N2, NB = STEP == 0 ? N2 : N1  ;
    const u16* Z = (const u16*)(ws + WS_BIG + BIG_Z); u16* Y = (u16*)(ws + WS_BIG + BIG_Y); LAUNDER_PTR(float*, outp, P.out); u16* X = (u16*)outp;
    int tid_l = threadIdx.x; asm volatile("" : "+v"(tid_l));
    const int tid = tid_l, lane = tid_l & 63, wave = __builtin_amdgcn_readfirstlane(tid_l >> 6), fi = tid_l & 15, fg = (tid_l & 63) >> 4; (void)lane;
    bf16x8 Ff[2][KS];
#pragma unroll
    for (int q = 0; q < 2; ++q)
#pragma unroll
        for (int ks = 0; ks < KS; ++ks) { const int mb = wave + 8 * q; Ff[q][ks] = (mb < NMB) ? *(const bf16x8*)(F + (size_t)(mb * 16 + fi) * JP + ks * 32 + 8 * fg) : (bf16x8){0, 0, 0, 0, 0, 0, 0, 0}; }
    for (int c = tid; c < (JP - J) * 16; c += 512) *(LAS u32x4*)(lds + (J + c / 16) * DFT_RS + (c % 16) * 16) = (u32x4){0u, 0u, 0u, 0u};
    const int trrow = (fi >> 2) + 8 * fg;
    const int trbase = trrow * DFT_RS + (fi & 3) * 8, sw0 = dft_swz(trrow) << 5;
    constexpr int NCH = STEP == 0 ? (J * 16 + 511) / 512 : (N2 * 16 + 511) / 512;
    u32x4 sa[NCH], sb[STEP == 0 ? 1 : NCH];
    const int NIT = 2 * NB * 16;
#define DFT_GLD(dst_, ptr_) asm volatile("global_load_dwordx4 %0, %1, off" : "=v"(dst_) : "v"(ptr_) : "memory")
#define DFT_BAR() do { asm volatile("s_waitcnt lgkmcnt(0)" ::: "memory"); __builtin_amdgcn_s_barrier(); } while (0)
    const int nst = 8 * (((wave < NMB && wave * 16 < KK) ? 1 : 0) + ((wave + 8 < NMB && (wave + 8) * 16 < KK) ? 1 : 0));
    int pend = 0;
#define DFT_LOAD(e_) do { const int s_ = s0 + (e_) / (NB * 16), rem_ = (e_) % (NB * 16), beta_ = rem_ >> 4, gh_ = rem_ & 15, colb_ = (gh_ >> 1) * 512 + (gh_ & 1) * 128; \
        _Pragma("unroll") for (int i = 0; i < NCH; ++i) { const int c = tid + 512 * i; \
            if (STEP == 0) { if (c < J * 16) { const int j = c >> 4, ch = c & 15, part = j >= N1, l1 = j - part * N1; DFT_GLD(sa[i], Z + (size_t)rowmap(s_, N2 * l1 + beta_) * 4096 + colb_ + part * 256 + ch * 8); } } \
            else { if (c < N2 * 16) { const int l2 = c >> 4, ch = c & 15; const u16* src = Y + (size_t)(seq_Y0(s_) + beta_ * N2 + l2) * 4096 + colb_ + ch * 8; DFT_GLD(sa[i], src); DFT_GLD(sb[i], src + 256); } } } } while (0)
    __syncthreads();
    int e = (int)((blockIdx.x + (unsigned)boff) % gridDim.x);
    if (e < NIT) DFT_LOAD(e);
    for (; e < NIT; e += gridDim.x) {
        const int s = s0 + e / (NB * 16), rem = e % (NB * 16), beta = rem >> 4, gh = rem & 15, colb = (gh >> 1) * 512 + (gh & 1) * 128;
        DFT_BAR();
        if (pend == 16) asm volatile("s_waitcnt vmcnt(16)" ::: "memory"); else if (pend == 8) asm volatile("s_waitcnt vmcnt(8)" ::: "memory"); else asm volatile("s_waitcnt vmcnt(0)" ::: "memory");
#pragma unroll
        for (int i = 0; i < NCH; ++i) { asm volatile("" : "+v"(sa[i])); if (STEP == 1) asm volatile("" : "+v"(sb[i])); }
        pend = nst;
#pragma unroll
        for (int i = 0; i < NCH; ++i) { const int c = tid + 512 * i;
            if (STEP == 0) { if (c < J * 16) { const int j = c >> 4, ch = c & 15; *(LAS u32x4*)(lds + j * DFT_RS + (((ch >> 1) ^ dft_swz(j)) << 5) + (ch & 1) * 16) = sa[i]; } }
            else if (c < N2 * 16) { const int l2 = c >> 4, ch = c & 15; const u32x4 a = sa[i], b = sb[i];
                float sn, cs; sincospif(2.0f * (float)((beta * l2) % L) / (float)L, &sn, &cs);
                u32x4 ore, oim;
#define TW(F_) { const float r0 = bflo(a.F_), r1 = bfhi(a.F_), i0 = bflo(b.F_), i1 = bfhi(b.F_); ore.F_ = pk2(r0 * cs + i0 * sn, r1 * cs + i1 * sn); oim.F_ = pk2(i0 * cs - r0 * sn, i1 * cs - r1 * sn); }
                TW(x) TW(y) TW(z) TW(w)
#undef TW
                *(LAS u32x4*)(lds + l2 * DFT_RS + (((ch >> 1) ^ dft_swz(l2)) << 5) + (ch & 1) * 16) = ore; *(LAS u32x4*)(lds + (N2 + l2) * DFT_RS + (((ch >> 1) ^ dft_swz(N2 + l2)) << 5) + (ch & 1) * 16) = oim; } }
        DFT_BAR();
        if (e + (int)gridDim.x < NIT) DFT_LOAD(e + (int)gridDim.x);
#pragma unroll
        for (int q = 0; q < 2; ++q) {
            const int mb = wave + 8 * q;
            if (mb < NMB) {
                f32x4 acc[8];
#pragma unroll
                for (int nb = 0; nb < 8; ++nb) acc[nb] = (f32x4){0.f, 0.f, 0.f, 0.f};
#pragma unroll
                for (int ks = 0; ks < KS; ++ks) {
                    LAS unsigned char* ap = lds + trbase + ks * 32 * DFT_RS;
#pragma unroll
                    for (int h = 0; h < 2; ++h) {
                        s16x4 a0[4], a1[4];
#pragma unroll
                        for (int n4 = 0; n4 < 4; ++n4) { const int nb = 4 * h + n4; a0[n4] = __builtin_amdgcn_ds_read_tr16_b64_v4i16((LAS s16x4*)(ap + ((nb * 32) ^ sw0))); a1[n4] = __builtin_amdgcn_ds_read_tr16_b64_v4i16((LAS s16x4*)(ap + ((nb * 32) ^ sw0) + 4 * DFT_RS)); }
#pragma unroll
                        for (int n4 = 0; n4 < 4; ++n4) { const int nb = 4 * h + n4; const bf16x8 af = {a0[n4][0], a0[n4][1], a0[n4][2], a0[n4][3], a1[n4][0], a1[n4][1], a1[n4][2], a1[n4][3]};
                            acc[nb] = __builtin_amdgcn_mfma_f32_16x16x32_bf16(af, Ff[q][ks], acc[nb], 0, 0, 0); }
                    }
                }
                const int kk = mb * 16 + fi;
                if (kk < KK) {
                    u16* dst;
                    if (STEP == 0) { const int part = kk >= N1, k1 = kk - part * N1; dst = Y + (size_t)(seq_Y0(s) + k1 * N2 + beta) * 4096 + colb + part * 256 + 4 * fg; }
                    else { dst = X + (size_t)rowmap(s, beta + N1 * kk) * DM + (gh >> 1) * 256 + (gh & 1) * 128 + 4 * fg; }
#pragma unroll
                    for (int nb = 0; nb < 8; ++nb) { u32x2 w; w.x = pk2(acc[nb][0], acc[nb][1]); w.y = pk2(acc[nb][2], acc[nb][3]); *(u32x2*)(dst + nb * 16) = w; }
                }
            }
        }
    }
#undef DFT_LOAD
#undef DFT_GLD
#undef DFT_BAR
    __syncthreads();
}

__device__ __forceinline__ void conv_phase(const Params& P, const float* cw  , int wave_, int lane_) {
    int tid_q = threadIdx.x; asm volatile("" : "+v"(tid_q)); const int lane = tid_q & 63, wave = __builtin_amdgcn_readfirstlane(tid_q >> 6); (void)lane_; (void)wave_;
    LAUNDER_PTR(unsigned char*, ws, P.ws);
    const u16* Bb = (const u16*)(ws + WS_BIG + BIG_BB); const u16* Gb = (const u16*)(ws + WS_BIG + BIG_GB); LAUNDER_PTR(float*, outp, P.out); u16* X = (u16*)outp;
    const int gw = blockIdx.x * 8 + wave, NGW = gridDim.x * 8;
    f32x4 w0[4][2], w1[4][2], w2[4][2];
#pragma unroll
    for (int j = 0; j < 4; ++j)
#pragma unroll
        for (int h = 0; h < 2; ++h) { const int c = 8 * lane + 512 * j + 4 * h; w0[j][h] = *(const f32x4*)(cw + c); w1[j][h] = *(const f32x4*)(cw + DM + c); w2[j][h] = *(const f32x4*)(cw + 2 * DM + c); }
    const int per = (TTOK + NGW - 1) / NGW, rbeg = gw * per, rend = rbeg + per < TTOK ? rbeg + per : TTOK;
    for (int r = rbeg; r < rend; ++r) {
        int prev, next;
        if (r < TREAL) { const int s = r < 8192 ? 0 : r < 16384 ? 1 : r < 32768 ? 2 : 3; const int p = r - seq_R0(s); prev = p > 0 ? r - 1 : MROW0 + NMETA * s + 15; next = p < seq_S(s) - 1 ? r + 1 : -1; }
        else { const int m = r - TREAL, s = m >> 4, i = m & 15; prev = i > 0 ? r - 1 : -1; next = i < 15 ? r + 1 : seq_R0(s); }
        u32x4 bv[4], g0[4], g1[4], g2[4]; const u32x4 zero = {0u, 0u, 0u, 0u};
#pragma unroll
        for (int j = 0; j < 4; ++j) { const int c = 8 * lane + 512 * j;
            bv[j] = *(const u32x4*)(Bb + (size_t)r * DM + c); g1[j] = *(const u32x4*)(Gb + (size_t)r * DM + c);
            g0[j] = prev >= 0 ? *(const u32x4*)(Gb + (size_t)prev * DM + c) : zero; g2[j] = next >= 0 ? *(const u32x4*)(Gb + (size_t)next * DM + c) : zero; }
#pragma unroll
        for (int j = 0; j < 4; ++j) { const int c = 8 * lane + 512 * j; u32x4 o;
#define CV(F_, H, I0, I1) o.F_ = pk2(bflo(bv[j].F_) * (w0[j][H][I0] * bflo(g0[j].F_) + w1[j][H][I0] * bflo(g1[j].F_) + w2[j][H][I0] * bflo(g2[j].F_)), bfhi(bv[j].F_) * (w0[j][H][I1] * bfhi(g0[j].F_) + w1[j][H][I1] * bfhi(g1[j].F_) + w2[j][H][I1] * bfhi(g2[j].F_)));
            CV(x, 0, 0, 1) CV(y, 0, 2, 3) CV(z, 1, 0, 1) CV(w, 1, 2, 3)
#undef CV
            *(u32x4*)(X + (size_t)r * DM + c) = o; }
    }
}

template <int KIND, int KS = 8>
__device__ __forceinline__ void thin_meta_gemm(const Params& P, size_t w_off, int N, LAS unsigned char* lds) {
    int tid_l = threadIdx.x; asm volatile("" : "+v"(tid_l));
    const int tid = tid_l, lane = tid & 63, wave = __builtin_amdgcn_readfirstlane(tid >> 6), fi = lane & 15, fg = lane >> 4, k0 = wave * (KS * 32);
    constexpr int LDK = KS * 256;
    LAUNDER_PTR(unsigned char*, ws, P.ws); LAUNDER_PTR(float*, outp, P.out);
    const u16* A = (KIND != 3) ? (const u16*)(ws + WS_HB) + (size_t)TREAL * DM : (KS == 8) ? (const u16*)outp + (size_t)TREAL * DM : (const u16*)(ws + WS_BIG) + (size_t)TREAL * DFF;
    const u16* Bt = (const u16*)(ws + WS_W) + w_off; const float* rstd = (const float*)(ws + WS_BIG + BIG_RSTD) + TREAL;
    u16* BIG = (u16*)(ws + WS_BIG);
    LAS float* red = (LAS float*)lds;
    for (int blk = blockIdx.x; blk < N / 16; blk += gridDim.x) {
        const int c0 = blk * 16;
        f32x4 acc[4];
#pragma unroll
        for (int nbk = 0; nbk < 4; ++nbk) acc[nbk] = (f32x4){0.f, 0.f, 0.f, 0.f};
#pragma unroll
        for (int ks = 0; ks < KS; ++ks) {
            const bf16x8 wf = *(const bf16x8*)(Bt + (size_t)(c0 + fi) * LDK + k0 + ks * 32 + 8 * fg);
#pragma unroll
            for (int nbk = 0; nbk < 4; ++nbk) { const bf16x8 af = *(const bf16x8*)(A + (size_t)(nbk * 16 + fi) * LDK + k0 + ks * 32 + 8 * fg);
                acc[nbk] = __builtin_amdgcn_mfma_f32_16x16x32_bf16(wf, af, acc[nbk], 0, 0, 0); }
        }
#pragma unroll
        for (int nbk = 0; nbk < 4; ++nbk)
#pragma unroll
            for (int rg = 0; rg < 4; ++rg) red[((wave * 4 + nbk) * 4 + rg) * 64 + lane] = acc[nbk][rg];
        __syncthreads();
        { const int row = tid & 63, p = tid >> 6, l = (p >> 1) * 16 + (row & 15), nbk = row >> 4, rg = 2 * (p & 1);
          float v0 = 0.f, v1 = 0.f;
#pragma unroll
          for (int w = 0; w < 8; ++w) { v0 += red[((w * 4 + nbk) * 4 + rg) * 64 + l]; v1 += red[((w * 4 + nbk) * 4 + rg + 1) * 64 + l]; }
          const float rs = (KIND == 3) ? 1.0f : rstd[row]; const int c = c0 + 2 * p; const size_t orow = (size_t)(TREAL + row);
          if (KIND == 0) *(unsigned*)(BIG + orow * QKVD + c) = pk2(v0 * rs, v1 * rs);
          else if (KIND == 3) { float* hm = (float*)(ws + WS_HMETA) + (size_t)row * DM + c; const f32x2 h = *(const f32x2*)hm; *(f32x2*)hm = (f32x2){h.x + v0, h.y + v1}; }
          else {
              const bool plain = (KIND == 1) && c < DM; const int cc = (KIND == 1) ? c - DM : c, cl = cc & 255;
              const int o = (cc >> 8) * 128 + ((cl >> 5) & 3) * 32 + ((cl >> 3) & 3) * 8 + (cl >> 7) * 4 + ((cl >> 1) & 3);
              if (plain) *(unsigned*)(BIG + orow * DM + c) = pk2(v0 * rs, v1 * rs);
              else if (KIND == 1) { const float gq = v0 * v1 * rs * rs; ((u16*)(ws + WS_BIG + BIG_GB))[orow * DM + o] = (u16)(pk2(gq, gq) & 0xffffu); }
              else { const float gs = v0 * rs, us = v1 * rs, sv = gs * us * __builtin_amdgcn_rcpf(1.0f + __builtin_amdgcn_exp2f(-1.4426950408889634f * gs)); BIG[orow * DFF + o] = (u16)(pk2(sv, sv) & 0xffffu); }
          } }
        __syncthreads();
    }
}

constexpr int PH_PER_LAYER = 9, N_PHASES = 1 + 4 * PH_PER_LAYER;
#ifndef PH_EN
#define PH_EN 0xffffffffu
#endif
#define EN(k) (((PH_EN) >> (k)) & 1u)
#define RUN(p) (lo <= (p) && (p) < hi)
#ifndef REP_MASK
#define REP_MASK 0u
#endif
#define REP(k) (((REP_MASK) >> (k)) & 1u)
#define SEAM(p) do { if ((p) + 1 < hi) { XcdBarrier b2_ = bar; { GAS unsigned* g_ = (GAS unsigned*)b2_.bar; asm volatile("" : "+s"(g_)); b2_.bar = (unsigned*)g_; } xcd_barrier(b2_); if (REP(15)) xcd_barrier(b2_); } } while (0)
#define SITE_PTRS LAUNDER_PTR(unsigned char*, ws, P.ws); LAUNDER_PTR(float*, outp, P.out); u16* Wb = (u16*)(ws + WS_W); u16* X = (u16*)outp; u16* BIG = (u16*)(ws + WS_BIG); (void)Wb; (void)X; (void)BIG
template <int layer>
__device__ __forceinline__ void run_layer(const Params& P, LAS unsigned char* lds, unsigned char* lds_raw, const XcdBarrier& bar, int lo, int hi, int wave, int lane) {

        const int pb = 1 + layer * PH_PER_LAYER;
        if (EN(1) && RUN(pb + 0)) {
            if (layer == 0) embed_phase(P);
            else if (layer == 1) norm_phase<false>(P, P.in[I_LNMIX] + layer * DM, 0, wave, lane);
            else { stats_phase(P, 0); if (REP(1)) stats_phase(P, 0); }
            SEAM(pb + 0); }
        if (RUN(pb + 1)) {
            if (EN(2) && (layer == 0 || layer == 3)) { thin_meta_gemm<0>(P, layer == 0 ? W_AQKV : W_DQKV, QKVD, lds);
                SITE_PTRS; pg8::Gemm g{(const u16*)(ws + WS_HB), Wb + (layer == 0 ? W_AQKV : W_DQKV), TREAL, QKVD, DM, DM}; pg8::StaticOrder S; S.init(TREAL, QKVD, gridDim.x, blockIdx.x, DM); pg8::EpiPlain E{BIG, QKVD, (const float*)(ws + WS_BIG + BIG_RSTD)};
                pg8::gemm_phase<pg8::EpiPlain, pg8::StaticOrder, true, true>(lds, g, S, E); if (REP(2)) pg8::gemm_phase<pg8::EpiPlain, pg8::StaticOrder, true, true>(lds, g, S, E); }
            else if (EN(2) && layer == 1) { SITE_PTRS; pg8::Gemm g{X, (const u16*)(ws + WS_FC), TTOK * 8, 512, 256, 256}; pg8::StaticOrder S; S.init(TTOK * 8, 512, gridDim.x, blockIdx.x, 256); pg8::EpiPlain E{BIG, 512, nullptr};
                pg8::gemm_phase<pg8::EpiPlain, pg8::StaticOrder, true, true>(lds, g, S, E); if (REP(3)) pg8::gemm_phase<pg8::EpiPlain, pg8::StaticOrder, true, true>(lds, g, S, E); }
            else if (EN(3)) { thin_meta_gemm<1>(P, W_CIN, 3 * DM, lds);
                SITE_PTRS; pg8::Gemm g{(const u16*)(ws + WS_HB), Wb + W_CIN, TREAL, 3 * DM, DM, DM}; pg8::StaticOrder S; S.init(TREAL, 3 * DM, gridDim.x, blockIdx.x, DM); pg8::EpiCin E{BIG, (u16*)(ws + WS_BIG + BIG_GB), (const float*)(ws + WS_BIG + BIG_RSTD)};
                pg8::gemm_phase<pg8::EpiCin, pg8::StaticOrder, true, true>(lds, g, S, E); if (REP(4)) pg8::gemm_phase<pg8::EpiCin, pg8::StaticOrder, true, true>(lds, g, S, E); }
            SEAM(pb + 1);
        }
        if (RUN(pb + 2)) {
            if (EN(4) && layer == 0) qkprep_phase<true>(P, P.in[I_AQN], P.in[I_AKN], wave, lane);
            else if (EN(4) && layer == 3) qkprep_phase<false>(P, P.in[I_DQN], P.in[I_DKN], wave, lane);
            else if (EN(5) && layer == 1) { dft_run<0, P_N1, P_N2, FA_P_J / 32, FA_P_KK / 16>(P, WS_FA_P, 0, 0, lds, wave, lane);
                                   dft_run<0, S_N1, S_N2, FA_S_J / 32, FA_S_KK / 16>(P, WS_FA_S, 2, (int)(gridDim.x - (2 * P_N2 * 16) % gridDim.x), lds, wave, lane);
                if (REP(5)) { dft_run<0, P_N1, P_N2, FA_P_J / 32, FA_P_KK / 16>(P, WS_FA_P, 0, 0, lds, wave, lane); dft_run<0, S_N1, S_N2, FA_S_J / 32, FA_S_KK / 16>(P, WS_FA_S, 2, (int)(gridDim.x - (2 * P_N2 * 16) % gridDim.x), lds, wave, lane); } }
            else if (EN(6)) { conv_phase(P, P.in[I_CCONV], wave, lane); if (REP(6)) conv_phase(P, P.in[I_CCONV], wave, lane); }
            SEAM(pb + 2);
        }
        if (RUN(pb + 3)) {
            if (EN(7) && layer == 0) { attn_phase<0>(P, nullptr, (char*)lds_raw, wave, lane); if (REP(7)) attn_phase<0>(P, nullptr, (char*)lds_raw, wave, lane); }
            else if (EN(8) && layer == 3) { attn_phase<1>(P, P.in[I_DSINK], (char*)lds_raw, wave, lane); if (REP(8)) attn_phase<1>(P, P.in[I_DSINK], (char*)lds_raw, wave, lane); }
            else if (EN(9) && layer == 1) { dft_run<1, P_N1, P_N2, FB_P_J / 32, FB_P_KK / 16>(P, WS_FB_P, 0, 0, lds, wave, lane);
                                   dft_run<1, S_N1, S_N2, FB_S_J / 32, FB_S_KK / 16>(P, WS_FB_S, 2, (int)(gridDim.x - (2 * P_N1 * 16) % gridDim.x), lds, wave, lane);
                if (REP(9)) { dft_run<1, P_N1, P_N2, FB_P_J / 32, FB_P_KK / 16>(P, WS_FB_P, 0, 0, lds, wave, lane); dft_run<1, S_N1, S_N2, FB_S_J / 32, FB_S_KK / 16>(P, WS_FB_S, 2, (int)(gridDim.x - (2 * P_N1 * 16) % gridDim.x), lds, wave, lane); } }
            if (layer != 2) SEAM(pb + 3);
        }
        if (layer == 0 && EN(7) && RUN(pb + 4)) { metacombine_phase(P); SEAM(pb + 4); }
        if (EN(10) && RUN(pb + 5)) {
            SITE_PTRS;
            const size_t wo = layer == 0 ? W_AWO : layer == 1 ? W_BW : layer == 2 ? W_COUT : W_DWO;
            if (layer < 3) thin_meta_gemm<3, 8>(P, wo, DM, lds);
            { pg8::Gemm g{X, Wb + wo, TREAL, DM, DM, DM}; pg8::StaticOrder S; S.init(TREAL, DM, gridDim.x, blockIdx.x, DM); const pg8::EpiResidB E{(u16*)(ws + WS_HB), (float*)(ws + WS_BIG + BIG_SS)};
              pg8::gemm_phase<pg8::EpiResidB, pg8::StaticOrder, true, true>(lds, g, S, E); }
            if (REP(10)) { pg8::Gemm g{X, Wb + wo, TREAL, DM, DM, DM}; pg8::StaticOrder S; S.init(TREAL, DM, gridDim.x, blockIdx.x, DM); pg8::EpiPlain E{(u16*)(ws + WS_BIG + 600 * MiB), DM, nullptr};
              pg8::gemm_phase<pg8::EpiPlain, pg8::StaticOrder, true, true>(lds, g, S, E); }
            SEAM(pb + 5);
        }
        if (EN(1) && RUN(pb + 6)) { stats_phase(P, 0); if (REP(1)) stats_phase(P, 0); SEAM(pb + 6); }
        if (EN(11) && RUN(pb + 7)) {
            SITE_PTRS;
            constexpr int MF = TREAL;
            if (layer < 3) thin_meta_gemm<2>(P, W_FIN + (size_t)layer * 2 * DFF * DM, 2 * DFF, lds);
            pg8::Gemm g{(const u16*)(ws + WS_HB), Wb + W_FIN + (size_t)layer * 2 * DFF * DM, MF, 2 * DFF, DM, DM}; pg8::StaticOrder S; S.init(MF, 2 * DFF, gridDim.x, blockIdx.x, DM); pg8::EpiSwiglu E{BIG, DFF, (const float*)(ws + WS_BIG + BIG_RSTD)};
            pg8::gemm_phase<pg8::EpiSwiglu, pg8::StaticOrder, true, true>(lds, g, S, E); if (REP(11)) pg8::gemm_phase<pg8::EpiSwiglu, pg8::StaticOrder, true, true>(lds, g, S, E); if (REP(16)) { pg8::EpiNone E0; pg8::gemm_phase<pg8::EpiNone, pg8::StaticOrder, true, true>(lds, g, S, E0); }
            SEAM(pb + 7);
        }
        if (EN(12) && RUN(pb + 8)) {
            if (layer < 3) thin_meta_gemm<3, 22>(P, W_FOUT + (size_t)layer * DFF * DM, DM, lds);
            SITE_PTRS;
            { pg8::Gemm g{BIG, Wb + W_FOUT + (size_t)layer * DFF * DM, TREAL, DM, DFF, DFF}; pg8::StaticOrder S; S.init(TREAL, DM, gridDim.x, blockIdx.x, DFF); if (layer < 3) { const pg8::EpiResidB E{(u16*)(ws + WS_HB), layer == 0 ? nullptr : (float*)(ws + WS_BIG + BIG_SS)}; pg8::gemm_phase<pg8::EpiResidB, pg8::StaticOrder, true, true>(lds, g, S, E); }
              else { const pg8::EpiResidFinal E{(const u16*)(ws + WS_HB), outp}; pg8::gemm_phase<pg8::EpiResidFinal, pg8::StaticOrder, true, true>(lds, g, S, E); } }
            if (REP(12)) { pg8::Gemm g{BIG, Wb + W_FOUT + (size_t)layer * DFF * DM, TREAL, DM, DFF, DFF}; pg8::StaticOrder S; S.init(TREAL, DM, gridDim.x, blockIdx.x, DFF); pg8::EpiPlain E{X, DM, nullptr};
              pg8::gemm_phase<pg8::EpiPlain, pg8::StaticOrder, true, true>(lds, g, S, E); }
            SEAM(pb + 8);
        }
    }

__global__ void __launch_bounds__(512, 2) encoder_fwd(Params P) {
    extern __shared__ __attribute__((aligned(16))) unsigned char lds_raw[];
    LAS unsigned char* lds = (LAS unsigned char*)lds_raw;
    const int tid = threadIdx.x; constexpr int lane = 0, wave = 0;
    if (tid < 4) ((LAS unsigned*)(lds + LDS_MISC))[tid] = 0u;
    __syncthreads();
    unsigned* barw = (unsigned*)(P.ws + WS_CTL) + CW_BAR;
    XcdBarrier bar = xcd_barrier_post(barw, (volatile LAS unsigned*)(lds + LDS_MISC));
    const int lo = P.ph_lo, hi = P.ph_hi;

    if (EN(0) && RUN(0)) { prologue_phase(P, lds, wave, lane); if (REP(0)) prologue_phase(P, lds, wave, lane); asm volatile("s_waitcnt vmcnt(0) lgkmcnt(0)" ::: "memory"); __syncthreads(); }

    run_layer<0>(P, lds, lds_raw, bar, lo, hi, wave, lane);
    run_layer<1>(P, lds, lds_raw, bar, lo, hi, wave, lane);
    run_layer<2>(P, lds, lds_raw, bar, lo, hi, wave, lane);
    run_layer<3>(P, lds, lds_raw, bar, lo, hi, wave, lane);
#undef SITE_PTRS
#undef RUN
#undef SEAM
}

#ifndef MK_PER_PHASE
#define MK_PER_PHASE 0
#endif
extern "C" void kernel_launch(void* const* d_in, const int* in_sizes, int n_in, void* d_out, int out_size, void* d_ws, size_t ws_size, hipStream_t stream) {
    static int grid = 0;
    if (grid == 0) {
        if (n_in != 20 || out_size != TREAL * DM || ws_size < WS_END) { fprintf(stderr, "kernel_launch: unexpected shapes: n_in %d out %d ws %zu (need %zu)\n", n_in, out_size, ws_size, (size_t)WS_END); grid = -1; return; }
        int dev = 0, cus = 0, per_cu = 0;
        if (hipGetDevice(&dev) != hipSuccess || hipDeviceGetAttribute(&cus, hipDeviceAttributeMultiprocessorCount, dev) != hipSuccess) { grid = -1; return; }
        if (hipFuncSetAttribute((const void*)encoder_fwd, hipFuncAttributeMaxDynamicSharedMemorySize, LDS_BYTES) != hipSuccess) { fprintf(stderr, "kernel_launch: hipFuncSetAttribute failed\n"); grid = -1; return; }
        if (hipOccupancyMaxActiveBlocksPerMultiprocessor(&per_cu, (const void*)encoder_fwd, 512, LDS_BYTES) != hipSuccess || per_cu < 1) { fprintf(stderr, "kernel_launch: occupancy query says %d blocks per CU\n", per_cu); (void)hipGetLastError(); grid = -1; return; }
        grid = cus;
    }
    if (grid < 0) return;
    (void)in_sizes;
    if (hipMemsetAsync((char*)d_ws + WS_CTL, 0, CTL_ZERO_BYTES, stream) != hipSuccess) { fprintf(stderr, "kernel_launch: memset failed\n"); return; }
    Params p; memset(&p, 0, sizeof(p));
    for (int i = 0; i < 20; ++i) p.in[i] = (const float*)d_in[i];
    p.out = (float*)d_out; p.ws = (unsigned char*)d_ws;
#if MK_PER_PHASE
    for (int ph = 0; ph < N_PHASES; ++ph) { p.ph_lo = ph; p.ph_hi = ph + 1; hipLaunchKernelGGL(encoder_fwd, dim3(grid), dim3(512), LDS_BYTES, stream, p); }
#else
    p.ph_lo = 0; p.ph_hi = N_PHASES;
    hipLaunchKernelGGL(encoder_fwd, dim3(grid), dim3(512), LDS_BYTES, stream, p);
#endif
    const hipError_t le = hipPeekAtLastError();
    if (le != hipSuccess) fprintf(stderr, "kernel_launch: launch failed: %s\n", hipGetErrorName(le));
}
```

```cpp
#include <hip/hip_runtime.h>
#include <cstdio>
#include <cstdint>
#include <cstring>
namespace pg8 {
#define PG8_LAS __attribute__((address_space(3)))
typedef unsigned short bf16_t;
typedef short bf16x8 __attribute__((ext_vector_type(8)));
typedef float f32x4 __attribute__((ext_vector_type(4)));
typedef unsigned u32x4 __attribute__((ext_vector_type(4)));
constexpr int BM = 256, BK = 64, HALF = 128, HTB = HALF * BK * 2  , STAGE_BYTES = 8 * HTB, NXCD = 8, WGM = 4;

__host__ __device__ __forceinline__ int lds_byte(int r, int c) { const int st = (r >> 4) * 2 + (c >> 5), rr = r & 15, cc = c & 31, ob = rr * 64 + cc * 2; return st * 1024 + (ob ^ (((ob >> 9) & 1) << 5)); }
__host__ __device__ __forceinline__ void stage_rc(int b, int& R, int& C) { const int st = b / 1024, sb = b % 1024, swz = sb ^ (((sb >> 9) & 1) << 5); R = (st >> 1) * 16 + swz / 64; C = (st & 1) * 32 + (swz % 64) / 2; }
__host__ __device__ __forceinline__ int perm32(int rho) { const int n = rho >> 4, i = rho & 15; return 8 * (i >> 2) + 4 * n + (i & 3); }

struct Unit { int pm, pn, ko, kt; };
struct Gemm { const bf16_t* A; const bf16_t* Bt; int M, N, K, ld; };

struct StaticOrder {
    int nM, nN, nwg, G, c, kt;
    __host__ __device__ void init(int M, int N, int G_, int c_, int K_) { nM = M / BM; nN = N / BM; nwg = nM * nN; G = G_; c = c_; kt = K_ / BK; }
    __host__ __device__ bool next(int i, Unit& u) const {
        const long L = (long)i * G + c; if (L >= nwg) return false;
        int wgid = (int)L; { const int q = nwg / NXCD, r = nwg % NXCD, xcd = wgid % NXCD, off = wgid / NXCD; wgid = (xcd < r ? xcd * (q + 1) : r * (q + 1) + (xcd - r) * q) + off; }
        const int nig = WGM * nN, gid = wgid / nig, fm = gid * WGM, gsz = (nM - fm) < WGM ? (nM - fm) : WGM;
        u.pm = fm + ((wgid % nig) % gsz); u.pn = (wgid % nig) / gsz; u.ko = 0; u.kt = kt; return true;
    }
    __device__ __forceinline__ void a_ready(const Unit&) const {}
    __device__ __forceinline__ void done(const Unit&) const {}
};
__device__ __forceinline__ unsigned cvt_pk_bf16(float lo, float hi) { unsigned r; asm volatile("v_cvt_pk_bf16_f32 %0, %1, %2" : "=v"(r) : "v"(lo), "v"(hi)); return r; }
typedef unsigned u32x2 __attribute__((ext_vector_type(2)));
struct EpiPlain {
    static constexpr bool PERM = true, AFTER_DRAIN = false, PRE = false, TBL = false; static constexpr int NVM = 0;
    bf16_t* O; int ldc; const float* rstd;
    __device__ __forceinline__ void prefetch(const Unit& u, int wr, int fr, float (&pre)[8]) const {
#pragma unroll
        for (int i = 0; i < 8; ++i) pre[i] = rstd ? rstd[u.pm * BM + wr * 64 + fr + (i >> 2) * HALF + (i & 3) * 16] : 1.0f; }
    __device__ __forceinline__ void operator()(const f32x4 (&acc)[2][2][4][2], const Unit& u, int wr, int wc, int fr, int fq) const {
        const int row0 = u.pm * BM + wr * 64 + fr, col0 = u.pn * BM + wc * 32 + 8 * fq;
        float rsv[8];
#pragma unroll
        for (int i = 0; i < 8; ++i) rsv[i] = rstd ? rstd[row0 + (i >> 2) * HALF + (i & 3) * 16] : 1.0f;
        __builtin_amdgcn_sched_barrier(0);
#pragma unroll
        for (int ai = 0; ai < 2; ++ai)
#pragma unroll
            for (int m = 0; m < 4; ++m) { bf16_t* rowp = O + (size_t)(row0 + ai * HALF + m * 16) * ldc + col0; const float rs = rsv[ai * 4 + m];
#pragma unroll
                for (int bj = 0; bj < 2; ++bj) { const f32x4 v0 = acc[ai][bj][m][0] * rs, v1 = acc[ai][bj][m][1] * rs;
                    u32x4 w; w.x = cvt_pk_bf16(v0[0], v0[1]); w.y = cvt_pk_bf16(v0[2], v0[3]); w.z = cvt_pk_bf16(v1[0], v1[1]); w.w = cvt_pk_bf16(v1[2], v1[3]);
                    *(u32x4*)(rowp + bj * HALF) = w; } }
    }
};
struct EpiResid {
    static constexpr bool PERM = false, AFTER_DRAIN = false, PRE = false, TBL = false; static constexpr int NVM = 0;
    float* hreal; float* hmeta; int nreal; float scale;
    __device__ __forceinline__ void operator()(const f32x4 (&acc)[2][2][4][2], const Unit& u, int wr, int wc, int fr, int fq) const {
        float* base = (u.pm < nreal) ? hreal + (size_t)u.pm * BM * 2048 : hmeta;
        const int row0 = wr * 64 + fr, col0 = u.pn * BM + wc * 32 + 4 * fq;
#pragma unroll
        for (int ai = 0; ai < 2; ++ai) {
            f32x4 t[4][2][2];
#pragma unroll
            for (int m = 0; m < 4; ++m) { const float* rowp = base + (size_t)(row0 + ai * HALF + m * 16) * 2048 + col0;
#pragma unroll
                for (int bj = 0; bj < 2; ++bj)
#pragma unroll
                    for (int n = 0; n < 2; ++n) t[m][bj][n] = *(const f32x4*)(rowp + bj * HALF + n * 16); }
            __builtin_amdgcn_sched_barrier(0);
#pragma unroll
            for (int m = 0; m < 4; ++m) { float* rowp = base + (size_t)(row0 + ai * HALF + m * 16) * 2048 + col0;
#pragma unroll
                for (int bj = 0; bj < 2; ++bj)
#pragma unroll
                    for (int n = 0; n < 2; ++n) *(f32x4*)(rowp + bj * HALF + n * 16) = t[m][bj][n] + acc[ai][bj][m][n] * scale; }
            __builtin_amdgcn_sched_barrier(0);
        }
    }
};
constexpr int SS_PLANE = 49152;
struct EpiResidB {
    static constexpr bool PERM = true, AFTER_DRAIN = false, PRE = false, TBL = false; static constexpr int NVM = 16;
    bf16_t* hb; float* ss;
    __device__ __forceinline__ void operator()(const f32x4 (&acc)[2][2][4][2], const Unit& u, int wr, int wc, int fr, int fq) const {
        const int row0 = u.pm * BM + wr * 64 + fr, col0 = u.pn * BM + wc * 32 + 8 * fq;
#pragma unroll
        for (int ai = 0; ai < 2; ++ai) {
            u32x4 t[4][2];
#pragma unroll
            for (int m = 0; m < 4; ++m)
#pragma unroll
                for (int bj = 0; bj < 2; ++bj) t[m][bj] = *(const u32x4*)(hb + (size_t)(row0 + ai * HALF + m * 16) * 2048 + col0 + bj * HALF);
            __builtin_amdgcn_sched_barrier(0);
            float q[4] = {0.f, 0.f, 0.f, 0.f};
#pragma unroll
            for (int m = 0; m < 4; ++m)
#pragma unroll
                for (int bj = 0; bj < 2; ++bj) { const u32x4 h = t[m][bj]; const f32x4 a0 = acc[ai][bj][m][0], a1 = acc[ai][bj][m][1];
                    const f32x4 v0 = {__uint_as_float(h.x << 16) + a0[0], __uint_as_float(h.x & 0xffff0000u) + a0[1], __uint_as_float(h.y << 16) + a0[2], __uint_as_float(h.y & 0xffff0000u) + a0[3]};
                    const f32x4 v1 = {__uint_as_float(h.z << 16) + a1[0], __uint_as_float(h.z & 0xffff0000u) + a1[1], __uint_as_float(h.w << 16) + a1[2], __uint_as_float(h.w & 0xffff0000u) + a1[3]};
                    q[m] += (v0[0] * v0[0] + v0[1] * v0[1]) + (v0[2] * v0[2] + v0[3] * v0[3]) + (v1[0] * v1[0] + v1[1] * v1[1]) + (v1[2] * v1[2] + v1[3] * v1[3]);
                    u32x4 w; w.x = cvt_pk_bf16(v0[0], v0[1]); w.y = cvt_pk_bf16(v0[2], v0[3]); w.z = cvt_pk_bf16(v1[0], v1[1]); w.w = cvt_pk_bf16(v1[2], v1[3]);
                    *(u32x4*)(hb + (size_t)(row0 + ai * HALF + m * 16) * 2048 + col0 + bj * HALF) = w; }
            if (ss) {
#pragma unroll
                for (int m = 0; m < 4; ++m) { float s = q[m];
                    s += __int_as_float(__builtin_amdgcn_ds_swizzle(__float_as_int(s), 0x1f | (16 << 10)));
                    const auto rr = __builtin_amdgcn_permlane32_swap(__float_as_uint(s), __float_as_uint(s), false, false); s = __uint_as_float(rr[0]) + __uint_as_float(rr[1]);
                    if (fq == 0) ss[(size_t)(4 * u.pn + wc) * SS_PLANE + row0 + ai * HALF + m * 16] = s; }
            }
            __builtin_amdgcn_sched_barrier(0);
        }
    }
};
struct EpiResidFinal {
    static constexpr bool PERM = true, AFTER_DRAIN = false, PRE = false, TBL = false; static constexpr int NVM = 16;
    const bf16_t* hb; float* out;
    __device__ __forceinline__ void operator()(const f32x4 (&acc)[2][2][4][2], const Unit& u, int wr, int wc, int fr, int fq) const {
        const int row0 = u.pm * BM + wr * 64 + fr, col0 = u.pn * BM + wc * 32 + 8 * fq;
#pragma unroll
        for (int ai = 0; ai < 2; ++ai) {
            u32x4 t[4][2];
#pragma unroll
            for (int m = 0; m < 4; ++m)
#pragma unroll
                for (int bj = 0; bj < 2; ++bj) t[m][bj] = *(const u32x4*)(hb + (size_t)(row0 + ai * HALF + m * 16) * 2048 + col0 + bj * HALF);
            __builtin_amdgcn_sched_barrier(0);
#pragma unroll
            for (int m = 0; m < 4; ++m)
#pragma unroll
                for (int bj = 0; bj < 2; ++bj) { const u32x4 h = t[m][bj]; const f32x4 v0 = acc[ai][bj][m][0], v1 = acc[ai][bj][m][1]; float* op = out + (size_t)(row0 + ai * HALF + m * 16) * 2048 + col0 + bj * HALF;
                    *(f32x4*)op = (f32x4){__uint_as_float(h.x << 16) + v0[0], __uint_as_float(h.x & 0xffff0000u) + v0[1], __uint_as_float(h.y << 16) + v0[2], __uint_as_float(h.y & 0xffff0000u) + v0[3]};
                    *(f32x4*)(op + 4) = (f32x4){__uint_as_float(h.z << 16) + v1[0], __uint_as_float(h.z & 0xffff0000u) + v1[1], __uint_as_float(h.w << 16) + v1[2], __uint_as_float(h.w & 0xffff0000u) + v1[3]}; }
            __builtin_amdgcn_sched_barrier(0);
        }
    }
};
__device__ __forceinline__ float silu_mul(float g, float u) { return g * u * __builtin_amdgcn_rcpf(1.0f + __builtin_amdgcn_exp2f(-1.4426950408889634f * g)); }
struct EpiSwiglu {
    static constexpr bool PERM = true, AFTER_DRAIN = false, PRE = false, TBL = true; static constexpr int NVM = 8;
    bf16_t* O; int ldc; const float* rstd;
    __device__ __forceinline__ void table_load(const Unit& u, PG8_LAS unsigned char* t, int wid) const {
        int l2; asm volatile("v_mbcnt_lo_u32_b32 %0, -1, 0\n\tv_mbcnt_hi_u32_b32 %0, -1, %0" : "=v"(l2));
        if (wid < 4) __builtin_amdgcn_global_load_lds((const unsigned*)(rstd + u.pm * BM + wid * 64 + l2), (PG8_LAS unsigned*)(t + wid * 256), 4, 0, 0); }
    __device__ __forceinline__ void operator()(const f32x4 (&acc)[2][2][4][2], const Unit& u, int wr, int wc, int fr, int fq, const PG8_LAS float* tb) const {
        const int row0 = u.pm * BM + wr * 64 + fr, col0 = u.pn * (BM / 2) + wc * 32 + 8 * fq;
        float rsv[8];
#pragma unroll
        for (int i = 0; i < 8; ++i) rsv[i] = tb[wr * 64 + fr + (i >> 2) * HALF + (i & 3) * 16];
        __builtin_amdgcn_sched_barrier(0);
#pragma unroll
        for (int ai = 0; ai < 2; ++ai)
#pragma unroll
            for (int m = 0; m < 4; ++m) { bf16_t* rowp = O + (size_t)(row0 + ai * HALF + m * 16) * ldc + col0; const float rs = rsv[ai * 4 + m];
                const float c1 = -1.4426950408889634f * rs, irs2 = __builtin_amdgcn_rcpf(rs * rs);
                const f32x4 a0 = acc[ai][0][m][0], a1 = acc[ai][0][m][1], b0 = acc[ai][1][m][0], b1 = acc[ai][1][m][1];
#define SWG(G_, U_) ((G_) * (U_) * __builtin_amdgcn_rcpf(__builtin_fmaf(__builtin_amdgcn_exp2f((G_) * c1), irs2, irs2)))
                u32x4 w; w.x = cvt_pk_bf16(SWG(a0[0], a0[1]), SWG(a0[2], a0[3])); w.y = cvt_pk_bf16(SWG(a1[0], a1[1]), SWG(a1[2], a1[3]));
                w.z = cvt_pk_bf16(SWG(b0[0], b0[1]), SWG(b0[2], b0[3])); w.w = cvt_pk_bf16(SWG(b1[0], b1[1]), SWG(b1[2], b1[3]));
#undef SWG
                *(u32x4*)rowp = w; }
    }
};
struct EpiCin {
    static constexpr bool PERM = true, AFTER_DRAIN = false, PRE = false, TBL = false; static constexpr int NVM = 0;
    bf16_t* Bb; bf16_t* Gb; const float* rstd;
    __device__ __forceinline__ void prefetch(const Unit& u, int wr, int fr, float (&pre)[8]) const {
#pragma unroll
        for (int i = 0; i < 8; ++i) pre[i] = rstd ? rstd[u.pm * BM + wr * 64 + fr + (i >> 2) * HALF + (i & 3) * 16] : 1.0f; }
    __device__ __forceinline__ void operator()(const f32x4 (&acc)[2][2][4][2], const Unit& u, int wr, int wc, int fr, int fq) const {
        const int row0 = u.pm * BM + wr * 64 + fr;
        float rsv[8];
#pragma unroll
        for (int i = 0; i < 8; ++i) rsv[i] = rstd ? rstd[row0 + (i >> 2) * HALF + (i & 3) * 16] : 1.0f;
        __builtin_amdgcn_sched_barrier(0);
        if (u.pn < 8) {
            const int col0 = u.pn * BM + wc * 32 + 8 * fq;
#pragma unroll
            for (int ai = 0; ai < 2; ++ai)
#pragma unroll
                for (int m = 0; m < 4; ++m) { bf16_t* rowp = Bb + (size_t)(row0 + ai * HALF + m * 16) * 2048 + col0; const float rs = rsv[ai * 4 + m];
#pragma unroll
                    for (int bj = 0; bj < 2; ++bj) { const f32x4 v0 = acc[ai][bj][m][0] * rs, v1 = acc[ai][bj][m][1] * rs;
                        u32x4 w; w.x = cvt_pk_bf16(v0[0], v0[1]); w.y = cvt_pk_bf16(v0[2], v0[3]); w.z = cvt_pk_bf16(v1[0], v1[1]); w.w = cvt_pk_bf16(v1[2], v1[3]);
                        *(u32x4*)(rowp + bj * HALF) = w; } }
        } else {
            const int col0 = (u.pn - 8) * (BM / 2) + wc * 32 + 8 * fq;
#pragma unroll
            for (int ai = 0; ai < 2; ++ai)
#pragma unroll
                for (int m = 0; m < 4; ++m) { bf16_t* rowp = Gb + (size_t)(row0 + ai * HALF + m * 16) * 2048 + col0; const float rs = rsv[ai * 4 + m]; const float rs2 = rs * rs;
                    const f32x4 a0 = acc[ai][0][m][0], a1 = acc[ai][0][m][1], b0 = acc[ai][1][m][0], b1 = acc[ai][1][m][1];
                    u32x4 w; w.x = cvt_pk_bf16(a0[0] * a0[1] * rs2, a0[2] * a0[3] * rs2); w.y = cvt_pk_bf16(a1[0] * a1[1] * rs2, a1[2] * a1[3] * rs2);
                    w.z = cvt_pk_bf16(b0[0] * b0[1] * rs2, b0[2] * b0[3] * rs2); w.w = cvt_pk_bf16(b1[0] * b1[1] * rs2, b1[2] * b1[3] * rs2);
                    *(u32x4*)rowp = w; }
        }
    }
};
struct TailOrder {
    int nunits, c, pm, kchunk;
    __device__ __forceinline__ bool next(int i, Unit& u) const { if (i > 0 || c >= nunits) return false; u.pm = pm; u.pn = c & 7; u.ko = (c >> 3) * kchunk; u.kt = kchunk / BK; return true; }
    __device__ __forceinline__ void a_ready(const Unit&) const {}
    __device__ __forceinline__ void done(const Unit&) const {}
};
struct EpiTailStore {
    static constexpr bool PERM = false, AFTER_DRAIN = false, PRE = false, TBL = false; static constexpr int NVM = 0;
    float* tailp; int kchunk;
    __device__ __forceinline__ void operator()(const f32x4 (&acc)[2][2][4][2], const Unit& u, int wr, int wc, int fr, int fq) const {
        if (wr != 0) return;
        const int col0 = u.pn * BM + wc * 32 + 4 * fq; float* base = tailp + (size_t)(u.ko / kchunk) * 64 * 2048;
#pragma unroll
        for (int m = 0; m < 4; ++m) { float* rowp = base + (size_t)(m * 16 + fr) * 2048 + col0;
#pragma unroll
            for (int bj = 0; bj < 2; ++bj)
#pragma unroll
                for (int n = 0; n < 2; ++n) *(f32x4*)(rowp + bj * HALF + n * 16) = acc[0][bj][m][n]; }
    }
};
struct StaggerOrder : StaticOrder {
    int rounds, kcut;
    __device__ __forceinline__ void init2(int M, int N, int G_, int c_, int K_) {
        init(M, N, G_, c_, K_); rounds = nwg / G; const int sg = (c_ >> 3) & 7; int kc = ((kt * sg / 8) + 1) & ~1; if (kc < 4 || kt - kc < 4 || nwg % G != 0) kc = 0; kcut = kc; }
    __device__ __forceinline__ bool next(int i, Unit& u) const {
        if (kcut == 0) return StaticOrder::next(i, u);
        if (i > rounds) return false;
        if (i == rounds) { StaticOrder::next(0, u); u.ko = kcut * BK; u.kt = kt - kcut; return true; }
        StaticOrder::next(i, u); if (i == 0) u.kt = kcut; return true;
    }
};
struct EpiNone {
    static constexpr bool PERM = true, AFTER_DRAIN = false, PRE = false, TBL = false; static constexpr int NVM = 0;
    __device__ __forceinline__ void operator()(const f32x4 (&acc)[2][2][4][2], const Unit&, int, int, int, int) const {
#pragma unroll
        for (int a = 0; a < 2; ++a)
#pragma unroll
            for (int b = 0; b < 2; ++b)
#pragma unroll
                for (int m = 0; m < 4; ++m) asm volatile("" :: "v"(acc[a][b][m][0]), "v"(acc[a][b][m][1]));
    }
};
template <class Epi, class Sched, bool ALIGN_EPI = false, bool SP2 = false>
__device__ __forceinline__ void gemm_phase(PG8_LAS unsigned char* lds, const Gemm g, const Sched& S, const Epi& E) {
    int tid_l = threadIdx.x; asm volatile("" : "+v"(tid_l));
    const int tid = tid_l, wid = __builtin_amdgcn_readfirstlane(tid >> 6), lane = tid & 63, wr = wid >> 2, wc = wid & 3, fr = lane & 15, fq = lane >> 4;
    const int K = g.ld;
    unsigned voffA[2], voffB[2];
#pragma unroll
    for (int i = 0; i < 2; ++i) { int R, C; stage_rc(tid * 16 + i * 8192, R, C); const int Rb = Epi::PERM ? ((R & ~31) + perm32(R & 31)) : R;
        voffA[i] = (unsigned)(R * K + C) * 2u; voffB[i] = (unsigned)(Rb * K + C) * 2u; }
    const size_t kstep = (size_t)(BK * 2);
    const size_t hstep = (size_t)HALF * K * 2;
    const size_t tstep = 2 * hstep;
    const unsigned ldsw = (unsigned)wid * 1024u;
    const unsigned ldsbase_w = (unsigned)(size_t)lds + ldsw;
    const int aoff = lds_byte(wr * 64 + fr, fq * 8), boff = lds_byte(wc * 32 + fr, fq * 8);
#define PG8_SA(b, h) (((b) * 2 + (h)) * HTB)
#define PG8_SB(b, h) ((4 + (b) * 2 + (h)) * HTB)
#define PG8_STAGE1(ldsoff, gbase, IMM, voff32) asm volatile("s_mov_b32 m0, %2\n\ts_nop 0\n\tglobal_load_lds_dwordx4 %0, %1 offset:" #IMM :: "v"(voff32), "s"(gbase), "s"(ldsbase_w + (unsigned)(ldsoff)) : "memory", "m0")
#define PG8_STAGEI(bufoff, gbase, IMM, voff) do { PG8_STAGE1((bufoff), gbase, IMM, (voff)[0]); PG8_STAGE1((bufoff) + 8192, gbase, IMM, (voff)[1]); } while (0)
#define PG8_STAGE(bufoff, gbase, voff) PG8_STAGEI(bufoff, gbase, 0, voff)
#define PG8_LDA(dst, b, h) do { _Pragma("unroll") for (int m = 0; m < 4; ++m) _Pragma("unroll") for (int k = 0; k < 2; ++k) dst[m][k] = *(const PG8_LAS bf16x8*)(lds + PG8_SA(b, h) + aoff + m * 2048 + k * 1024); } while (0)
#define PG8_LDB(dst, b, h) do { _Pragma("unroll") for (int n = 0; n < 2; ++n) _Pragma("unroll") for (int k = 0; k < 2; ++k) dst[n][k] = *(const PG8_LAS bf16x8*)(lds + PG8_SB(b, h) + boff + n * 2048 + k * 1024); } while (0)
#define PG8_MMA(ai, bj, At, Bt) do { __builtin_amdgcn_s_setprio(1); _Pragma("unroll") for (int m = 0; m < 4; ++m) _Pragma("unroll") for (int n = 0; n < 2; ++n) _Pragma("unroll") for (int k = 0; k < 2; ++k) \
        acc[ai][bj][m][n] = __builtin_amdgcn_mfma_f32_16x16x32_bf16(Bt[n][k], At[m][k], acc[ai][bj][m][n], 0, 0, 0); __builtin_amdgcn_s_setprio(0); } while (0)
#define PG8_WAIT_V(n) asm volatile("s_waitcnt vmcnt(" #n ")" ::: "memory")
#define PG8_WAIT_L(n) asm volatile("s_waitcnt lgkmcnt(" #n ")" ::: "memory")
#define PG8_BAR __builtin_amdgcn_s_barrier()
#define PG8_SCHED __builtin_amdgcn_sched_barrier(0)
    Unit cur, nxt; int ui = 0;
    if (!S.next(0, cur)) return;
    f32x4 acc[2][2][4][2];
#pragma unroll
    for (int a = 0; a < 2; ++a)
#pragma unroll
        for (int b = 0; b < 2; ++b)
#pragma unroll
            for (int m = 0; m < 4; ++m)
#pragma unroll
                for (int n = 0; n < 2; ++n) acc[a][b][m][n] = (f32x4){0.f, 0.f, 0.f, 0.f};
    bf16x8 At[4][2], B0[2][2], B1[2][2];
    const char* cA = (const char*)g.A + (size_t)cur.pm * tstep + (size_t)cur.ko * 2; const char* cB = (const char*)g.Bt + (size_t)cur.pn * tstep + (size_t)cur.ko * 2;
    S.a_ready(cur);
    float pre[8];
    if constexpr (Epi::PRE) E.prefetch(cur, wr, fr, pre);
    PG8_LAS unsigned char* const tbl = lds + STAGE_BYTES;
    if constexpr (Epi::TBL) E.table_load(cur, tbl, wid);
    if constexpr (SP2) {
        PG8_STAGE(PG8_SB(0, 0), cB, voffB); PG8_STAGE(PG8_SB(0, 1), cB + hstep, voffB); PG8_STAGE(PG8_SA(0, 0), cA, voffA); PG8_STAGE(PG8_SA(0, 1), cA + hstep, voffA);
        if (wr == 1) PG8_BAR;
        PG8_WAIT_V(2); PG8_BAR;
        PG8_STAGE(PG8_SB(1, 0), cB + kstep, voffB); PG8_STAGE(PG8_SA(1, 0), cA + kstep, voffA); PG8_STAGE(PG8_SB(1, 1), cB + hstep + kstep, voffB);
        PG8_WAIT_V(6); PG8_BAR;
    } else {
        PG8_STAGE(PG8_SB(0, 0), cB, voffB); PG8_STAGE(PG8_SA(0, 0), cA, voffA); PG8_STAGE(PG8_SB(0, 1), cB + hstep, voffB); PG8_STAGE(PG8_SA(0, 1), cA + hstep, voffA);
        if (wr == 1) PG8_BAR;
        PG8_WAIT_V(4); PG8_BAR;
        PG8_STAGE(PG8_SB(1, 0), cB + kstep, voffB); PG8_STAGE(PG8_SA(1, 0), cA + kstep, voffA); PG8_STAGE(PG8_SB(1, 1), cB + hstep + kstep, voffB);
        PG8_WAIT_V(6); PG8_BAR;
    }
    for (;;) {
        const bool has_next = S.next(ui + 1, nxt);
        const char* nA = has_next ? (const char*)g.A + (size_t)nxt.pm * tstep + (size_t)nxt.ko * 2 : cA; const char* nB = has_next ? (const char*)g.Bt + (size_t)nxt.pn * tstep + (size_t)nxt.ko * 2 : cB;
        const int nt = cur.kt;
#define PG8_KSETUP() const bool last = (t == nt - 2); const char* a1 = cA + (size_t)(t + 1) * kstep; \
            const char* a2 = last ? nA : cA + (size_t)(t + 2) * kstep; const char* b2 = last ? nB : cB + (size_t)(t + 2) * kstep; const char* a3 = a2 + kstep; const char* b3 = b2 + kstep; \
            if (last && has_next) S.a_ready(nxt)
#define PG8_KITER_SP2(W1, W2) do { \
            PG8_LDB(B0, 0, 0); PG8_LDB(B1, 0, 1); PG8_SCHED; PG8_LDA(At, 0, 0); PG8_STAGE(PG8_SA(1, 1), a1 + hstep, voffA); \
            PG8_WAIT_V(W1); PG8_WAIT_L(0); PG8_BAR; PG8_MMA(0, 0, At, B0); PG8_MMA(0, 1, At, B1); PG8_BAR; PG8_SCHED; \
            PG8_LDA(At, 0, 1); PG8_STAGE(PG8_SB(0, 0), b2, voffB); PG8_STAGE(PG8_SB(0, 1), b2 + hstep, voffB); PG8_STAGE(PG8_SA(0, 0), a2, voffA); \
            PG8_WAIT_V(W2); PG8_WAIT_L(0); PG8_BAR; PG8_MMA(1, 0, At, B0); PG8_MMA(1, 1, At, B1); PG8_BAR; PG8_SCHED; \
            PG8_LDB(B0, 1, 0); PG8_LDB(B1, 1, 1); PG8_SCHED; PG8_LDA(At, 1, 0); PG8_STAGE(PG8_SA(0, 1), a2 + hstep, voffA); \
            PG8_WAIT_V(8); PG8_WAIT_L(0); PG8_BAR; PG8_MMA(0, 0, At, B0); PG8_MMA(0, 1, At, B1); PG8_BAR; PG8_SCHED; \
            PG8_LDA(At, 1, 1); PG8_STAGE(PG8_SB(1, 0), b3, voffB); PG8_STAGE(PG8_SB(1, 1), b3 + hstep, voffB); PG8_STAGE(PG8_SA(1, 0), a3, voffA); \
            PG8_WAIT_V(8); PG8_WAIT_L(0); PG8_BAR; PG8_MMA(1, 0, At, B0); PG8_MMA(1, 1, At, B1); PG8_BAR; PG8_SCHED; } while (0)
        int t0 = 0;
        if constexpr (SP2 && Epi::NVM == 16) { if (ui > 0) { const int t = 0; PG8_KSETUP(); PG8_KITER_SP2(24, 24); t0 = 2; } }
        if constexpr (SP2 && Epi::NVM == 8) { if (ui > 0) { const int t = 0; PG8_KSETUP(); PG8_KITER_SP2(16, 16); t0 = 2; } }
        for (int t = t0; t < nt; t += 2) {
            PG8_KSETUP();
            if constexpr (SP2) {
            PG8_KITER_SP2(8, 8);
            } else {
            PG8_LDB(B0, 0, 0); PG8_SCHED; PG8_LDA(At, 0, 0); PG8_STAGE(PG8_SA(1, 1), a1 + hstep, voffA);
            PG8_WAIT_L(8); PG8_BAR; PG8_WAIT_L(0); PG8_MMA(0, 0, At, B0); PG8_BAR; PG8_SCHED;
            PG8_LDB(B1, 0, 1); PG8_STAGE(PG8_SB(0, 0), b2, voffB);
            PG8_BAR; PG8_WAIT_L(0); PG8_MMA(0, 1, At, B1); PG8_BAR;
            PG8_LDA(At, 0, 1); PG8_STAGE(PG8_SA(0, 0), a2, voffA);
            PG8_BAR; PG8_WAIT_L(0); PG8_MMA(1, 0, At, B0); PG8_BAR; PG8_SCHED;
            PG8_STAGE(PG8_SB(0, 1), b2 + hstep, voffB);
            PG8_WAIT_V(6); PG8_BAR; PG8_MMA(1, 1, At, B1); PG8_BAR;
            PG8_LDB(B0, 1, 0); PG8_SCHED; PG8_LDA(At, 1, 0); PG8_STAGE(PG8_SA(0, 1), a2 + hstep, voffA);
            PG8_WAIT_L(8); PG8_BAR; PG8_WAIT_L(0); PG8_MMA(0, 0, At, B0); PG8_BAR; PG8_SCHED;
            PG8_LDB(B1, 1, 1); PG8_STAGE(PG8_SB(1, 0), b3, voffB);
            PG8_BAR; PG8_WAIT_L(0); PG8_MMA(0, 1, At, B1); PG8_BAR;
            PG8_LDA(At, 1, 1); PG8_STAGE(PG8_SA(1, 0), a3, voffA);
            PG8_BAR; PG8_WAIT_L(0); PG8_MMA(1, 0, At, B0); PG8_BAR; PG8_SCHED;
            PG8_STAGE(PG8_SB(1, 1), b3 + hstep, voffB);
            PG8_WAIT_V(6); PG8_BAR; PG8_MMA(1, 1, At, B1); PG8_BAR;
            }
        }
#undef PG8_KSETUP
#undef PG8_KITER_SP2
        if constexpr (ALIGN_EPI) { if (wr == 0) PG8_BAR; }
        if constexpr (!Epi::AFTER_DRAIN) { if constexpr (Epi::TBL) { E(acc, cur, wr, wc, fr, fq, (const PG8_LAS float*)(tbl + (ui & 1) * 1024)); if (has_next) E.table_load(nxt, tbl + ((ui + 1) & 1) * 1024, wid); } else if constexpr (Epi::PRE) { E(acc, cur, wr, wc, fr, fq, pre); if (has_next) E.prefetch(nxt, wr, fr, pre); } else E(acc, cur, wr, wc, fr, fq); S.done(cur); }
        if (!has_next) break;
#pragma unroll
        for (int a = 0; a < 2; ++a)
#pragma unroll
            for (int b = 0; b < 2; ++b)
#pragma unroll
                for (int m = 0; m < 4; ++m)
#pragma unroll
                    for (int n = 0; n < 2; ++n) acc[a][b][m][n] = (f32x4){0.f, 0.f, 0.f, 0.f};
        cur = nxt; cA = nA; cB = nB; ++ui;
        if constexpr (ALIGN_EPI) { if (wr == 1) PG8_BAR; }
    }
    PG8_WAIT_V(0);
    if constexpr (!ALIGN_EPI) { if (wr == 0) PG8_BAR; }
    PG8_BAR;
    if constexpr (Epi::AFTER_DRAIN) { E.fused(acc, cur, wr, wc, fr, fq, lds, wid, lane); S.done(cur); }
#undef PG8_SA
#undef PG8_SB
#undef PG8_STAGE
#undef PG8_LDA
#undef PG8_LDB
#undef PG8_MMA
#undef PG8_WAIT_V
#undef PG8_WAIT_L
#undef PG8_BAR
#undef PG8_SCHED
}
}
namespace att {
typedef unsigned short u16;
using bf16x8 = __attribute__((ext_vector_type(8))) short;
using s16x4  = __attribute__((ext_vector_type(4))) short;
using f32x16 = __attribute__((ext_vector_type(16))) float;
using u32x4  = __attribute__((ext_vector_type(4))) unsigned;
constexpr int   D = 128, KVBLK = 64, LDK = 128, LDQ = 3072, LDO = 2048;
constexpr float SCALE = 0.088388347648318440f;
constexpr float THR = 8.f;
constexpr float NEGBIG = -1e30f;
constexpr size_t SHM_V = KVBLK * D * 2, SHM_K = KVBLK * D * 2, SHM_ATTN = 2 * SHM_V + 2 * SHM_K + 8 * 64 * 4;
#define KSWZ(row, colB) ((row) * 256 + ((colB) ^ (((row) & 7) << 4)))
#define SBAR() __builtin_amdgcn_sched_barrier(0)
__device__ __forceinline__ int crow(int r, int hi) { return (r & 3) + 8 * (r >> 2) + 4 * hi; }
__device__ __forceinline__ unsigned cvtpk(float lo, float hi) { unsigned r; asm volatile("v_cvt_pk_bf16_f32 %0, %1, %2" : "=v"(r) : "v"(lo), "v"(hi)); return r; }

__device__ __forceinline__ void partialSM(f32x16& p0, f32x16& p1, float& m_reg, float& mn, float& alpha) {
  constexpr float C = SCALE * 1.4426950408889634f;
  float pmax = p0[0]; for (int r = 1; r < 16; ++r) pmax = fmaxf(pmax, p0[r]); for (int r = 0; r < 16; ++r) pmax = fmaxf(pmax, p1[r]);
  { auto rr = __builtin_amdgcn_permlane32_swap(__float_as_uint(pmax), __float_as_uint(pmax), false, false);
    pmax = fmaxf(__uint_as_float(rr[0]), __uint_as_float(rr[1])); }
  if (__builtin_expect(__all(pmax - m_reg <= THR / SCALE), 1)) { mn = m_reg; alpha = 1.f; }
  else { mn = fmaxf(m_reg, pmax); alpha = __builtin_amdgcn_exp2f((m_reg - mn) * C); m_reg = mn; }
  float mnC = -mn * C;
  for (int r = 0; r < 16; ++r) p0[r] = fmaf(p0[r], C, mnC); for (int r = 0; r < 16; ++r) p1[r] = fmaf(p1[r], C, mnC);
  for (int r = 0; r < 16; ++r) p0[r] = __builtin_amdgcn_exp2f(p0[r]);
}
__device__ __forceinline__ void finishSM(f32x16& p0, f32x16& p1, float alpha, float& l_reg, bf16x8& pa0, bf16x8& pa1, bf16x8& pa2, bf16x8& pa3) {
  for (int r = 0; r < 16; ++r) p1[r] = __builtin_amdgcn_exp2f(p1[r]);
  float ps = 0; for (int r = 0; r < 16; ++r) ps += p0[r]; for (int r = 0; r < 16; ++r) ps += p1[r];
  { auto rr = __builtin_amdgcn_permlane32_swap(__float_as_uint(ps), __float_as_uint(ps), false, false);
    ps = __uint_as_float(rr[0]) + __uint_as_float(rr[1]); }
  l_reg = l_reg * alpha + ps;
#define PK4(P, BASE, OUT) do { unsigned a0 = cvtpk(P[BASE + 0], P[BASE + 1]), a1 = cvtpk(P[BASE + 2], P[BASE + 3]);   \
    unsigned b0 = cvtpk(P[BASE + 4], P[BASE + 5]), b1 = cvtpk(P[BASE + 6], P[BASE + 7]);                              \
    auto r0 = __builtin_amdgcn_permlane32_swap(a0, b0, false, false); auto r1 = __builtin_amdgcn_permlane32_swap(a1, b1, false, false); \
    u32x4 w = {r0[0], r1[0], r0[1], r1[1]}; OUT = *reinterpret_cast<bf16x8*>(&w); } while (0)
  PK4(p0, 0, pa0); PK4(p0, 8, pa1); PK4(p1, 0, pa2); PK4(p1, 8, pa3);
#undef PK4
}
__device__ __forceinline__ void qkt(f32x16& p0, f32x16& p1, const u16* Ks, const bf16x8* qr, int r32, int hi) {
  p0 = f32x16{}; p1 = f32x16{};
  for (int d0 = 0; d0 < 8; ++d0) { int cb = (d0 * 16 + hi * 8) * 2;
    bf16x8 b0 = *reinterpret_cast<const bf16x8*>((const char*)Ks + KSWZ(r32, cb));
    bf16x8 b1 = *reinterpret_cast<const bf16x8*>((const char*)Ks + KSWZ(32 + r32, cb));
    p0 = __builtin_amdgcn_mfma_f32_32x32x16_bf16(b0, qr[d0], p0, 0, 0, 0);
    p1 = __builtin_amdgcn_mfma_f32_32x32x16_bf16(b1, qr[d0], p1, 0, 0, 0); }
}
__device__ __forceinline__ void qkt_lds(f32x16& p0, f32x16& p1, const u16* Ks, const char* qs, int r32, int hi) {
  p0 = f32x16{}; p1 = f32x16{};
  for (int d0 = 0; d0 < 8; ++d0) { int cb = (d0 * 16 + hi * 8) * 2;
    bf16x8 q = *reinterpret_cast<const bf16x8*>(qs + d0 * 1024);
    bf16x8 b0 = *reinterpret_cast<const bf16x8*>((const char*)Ks + KSWZ(r32, cb));
    bf16x8 b1 = *reinterpret_cast<const bf16x8*>((const char*)Ks + KSWZ(32 + r32, cb));
    p0 = __builtin_amdgcn_mfma_f32_32x32x16_bf16(b0, q, p0, 0, 0, 0);
    p1 = __builtin_amdgcn_mfma_f32_32x32x16_bf16(b1, q, p1, 0, 0, 0); }
}
__device__ __forceinline__ int v_st(int k, int c) { const int kk = (k & ~0xC) | ((k & 4) << 1) | ((k & 8) >> 1); return ((kk >> 3) * 4 + (c >> 5)) * 512 + ((kk & 7) * 32 + (c & 31)) * 2; }
__device__ __forceinline__ int v_rd_base(int lane) { return ((lane & 3) << 3) | (((lane >> 2) & 3) << 6) | (((lane >> 4) & 1) << 5) | (((lane >> 5) & 1) << 8); }
constexpr int v_rd_off(int d0, int ks, int half) { return d0 * 512 + ks * 4096 + half * 2048; }
template <int OFF> __device__ __forceinline__ s16x4 tr_read(int vb) {
  s16x4 r; asm volatile("ds_read_b64_tr_b16 %0, %1 offset:%2" : "=&v"(r) : "v"(vb), "i"(OFF) : "memory"); return r;
}
template <int D0> __device__ __forceinline__ void pv_one(f32x16& od, int vb, bf16x8 pa0, bf16x8 pa1, bf16x8 pa2, bf16x8 pa3) {
  const s16x4 l0 = tr_read<v_rd_off(D0, 0, 0)>(vb), h0 = tr_read<v_rd_off(D0, 0, 1)>(vb), l1 = tr_read<v_rd_off(D0, 1, 0)>(vb), h1 = tr_read<v_rd_off(D0, 1, 1)>(vb);
  const s16x4 l2 = tr_read<v_rd_off(D0, 2, 0)>(vb), h2 = tr_read<v_rd_off(D0, 2, 1)>(vb), l3 = tr_read<v_rd_off(D0, 3, 0)>(vb), h3 = tr_read<v_rd_off(D0, 3, 1)>(vb);
  asm volatile("s_waitcnt lgkmcnt(0)" ::: "memory"); SBAR();
#define PK(L, H) (bf16x8){L[0], L[1], L[2], L[3], H[0], H[1], H[2], H[3]}
  od = __builtin_amdgcn_mfma_f32_32x32x16_bf16(pa0, PK(l0, h0), od, 0, 0, 0);
  od = __builtin_amdgcn_mfma_f32_32x32x16_bf16(pa1, PK(l1, h1), od, 0, 0, 0);
  od = __builtin_amdgcn_mfma_f32_32x32x16_bf16(pa2, PK(l2, h2), od, 0, 0, 0);
  od = __builtin_amdgcn_mfma_f32_32x32x16_bf16(pa3, PK(l3, h3), od, 0, 0, 0);
#undef PK
}
__device__ __forceinline__ void pv_d0(f32x16* o, int vb, bf16x8 pa0, bf16x8 pa1, bf16x8 pa2, bf16x8 pa3) {
  pv_one<0>(o[0], vb, pa0, pa1, pa2, pa3); pv_one<1>(o[1], vb, pa0, pa1, pa2, pa3); pv_one<2>(o[2], vb, pa0, pa1, pa2, pa3); pv_one<3>(o[3], vb, pa0, pa1, pa2, pa3);
}
__device__ __forceinline__ void mask_meta_tile(f32x16& p0, f32x16& p1) {
#pragma unroll
  for (int r = 8; r < 16; ++r) p0[r] = NEGBIG;
#pragma unroll
  for (int r = 0; r < 16; ++r) p1[r] = NEGBIG;
}
__device__ __forceinline__ void mask_win_tile(f32x16& p0, f32x16& p1, float dlt  , float slopeS, bool ismeta) {
  if (!ismeta) {
#pragma unroll
    for (int r = 0; r < 16; ++r) { const float c = (float)((r & 3) + 8 * (r >> 2)); const float d0 = fabsf(dlt - c), d1 = fabsf(dlt - 32.f - c);
      p0[r] = (d0 <= 128.f) ? fmaf(-slopeS, d0, p0[r]) : NEGBIG; p1[r] = (d1 <= 128.f) ? fmaf(-slopeS, d1, p1[r]) : NEGBIG; }
  } else {
#pragma unroll
    for (int r = 0; r < 16; ++r) { const float c = (float)((r & 3) + 8 * (r >> 2));
      p0[r] = (dlt - c >= 0.f) ? p0[r] : NEGBIG; p1[r] = (dlt - 32.f - c >= 0.f) ? p1[r] : NEGBIG; }
  }
}

template <int MODE>
__device__ __forceinline__ void attn_item(const u16* __restrict__ Qw, const u16* __restrict__ Kh, const u16* __restrict__ Vh, u16* __restrict__ Ow, bool metaq, bool store,
                                          int NT, int ktlo, int tq, float slopeS, float sinkL2, char* lds, bool mask0, float* __restrict__ po, float* __restrict__ pml) {
  int tid_l = threadIdx.x; asm volatile("" : "+v"(tid_l));
  const int tid = tid_l, wid = tid >> 6, lane = tid & 63, r32 = lane & 31, hi = lane >> 5;
  constexpr int NS = (MODE == 0) ? 3 : 2;
  u16* V_lds = (u16*)lds; u16* K_lds = (u16*)(lds + NS * SHM_V);
  float* ws = (float*)(lds + NS * (SHM_V + SHM_K)) + wid * 64; float* li_l = ws; float* al_l = ws + 32;
  float m_reg = -1e30f, l_reg = 0; f32x16 o[4] = {}; bf16x8 qr[8];
  char* qs = lds + SHM_ATTN + wid * 8192 + lane * 16;
#pragma unroll
  for (int d0 = 0; d0 < 8; ++d0) qr[d0] = *reinterpret_cast<const bf16x8*>(Qw + d0 * 16);
#define QKT(P0, P1, KS) do { if (MODE == 1) qkt_lds(P0, P1, KS, qs, r32, hi); else qkt(P0, P1, KS, qr, r32, hi); } while (0)
  const int sr = tid >> 4, sc = (tid & 15) * 8, vst0 = v_st(sr, sc), vst1 = v_st(32 + sr, sc);
  const int vb0 = (int)(uintptr_t)V_lds + v_rd_base(lane);
  constexpr int SD = 2;
  struct { bf16x8 vs0, vs1, ks0, ks1; } sr_[SD];
#define KROW(t) ((MODE == 0 || (t)) ? 64 * (ktlo + (t)) : 0)
#define SLOAD(i, tt) do { const int k0_ = KROW(tt); sr_[i].vs0 = *reinterpret_cast<const bf16x8*>(&Vh[(long)(k0_ + sr) * LDK + sc]); sr_[i].vs1 = *reinterpret_cast<const bf16x8*>(&Vh[(long)(k0_ + 32 + sr) * LDK + sc]); \
    sr_[i].ks0 = *reinterpret_cast<const bf16x8*>(&Kh[(long)(k0_ + sr) * LDK + sc]); sr_[i].ks1 = *reinterpret_cast<const bf16x8*>(&Kh[(long)(k0_ + 32 + sr) * LDK + sc]); } while (0)
#define SWRITE(b, i) do { *(bf16x8*)((char*)V_lds + (b) * SHM_V + vst0) = sr_[i].vs0;          \
    *(bf16x8*)((char*)V_lds + (b) * SHM_V + vst1) = sr_[i].vs1; int kc = sc * 2;               \
    *(bf16x8*)((char*)K_lds + (b) * SHM_K + KSWZ(sr, kc)) = sr_[i].ks0;                       \
    *(bf16x8*)((char*)K_lds + (b) * SHM_K + KSWZ(32 + sr, kc)) = sr_[i].ks1; } while (0)
#define SWAIT() do { if (SD == 2) asm volatile("s_waitcnt vmcnt(4)" ::: "memory"); else asm volatile("s_waitcnt vmcnt(0)" ::: "memory"); } while (0)
#define RESC(a) do { if (__any((a) < 1.f)) { if (hi == 0) al_l[r32] = (a); asm volatile("s_waitcnt lgkmcnt(0)" ::: "memory"); \
    for (int d = 0; d < 4; ++d) for (int r = 0; r < 16; ++r) o[d][r] *= al_l[crow(r, hi)]; } } while (0)
  const float tqf = (float)(tq - 4 * hi);
#define WMASK(P0, P1, tt) do { if (MODE == 1) mask_win_tile(P0, P1, tqf - (float)(64 * (ktlo + (tt) - 1)), slopeS, metaq); } while (0)
  f32x16 pA0, pA1, pB0, pB1; float mnA, mnB, alA, alB; bf16x8 pa0, pa1, pa2, pa3;
  constexpr int SE = 0, SO = SD - 1;
  SLOAD(SE, 0);
  __builtin_amdgcn_sched_barrier(0);
  if (MODE == 1) {
    __builtin_amdgcn_sched_barrier(0);
#pragma unroll
    for (int d0 = 0; d0 < 8; ++d0) *reinterpret_cast<bf16x8*>(qs + d0 * 1024) = qr[d0];
    __builtin_amdgcn_sched_barrier(0); }
  __syncthreads();
  asm volatile("s_waitcnt vmcnt(0)" ::: "memory"); SWRITE(0, SE); __syncthreads();
  QKT(pA0, pA1, K_lds); if (mask0) mask_meta_tile(pA0, pA1); partialSM(pA0, pA1, m_reg, mnA, alA);
  SLOAD(SO, 1); if (SD == 2) SLOAD(SE, 2);
  SWAIT(); SWRITE(1, SO); __syncthreads();
  if (MODE == 0) {
    int sj = 1, slast = 1;
    for (int j = 1; j + 1 < NT; j += 2) {
      const int s0_ = sj, s1_ = sj == 2 ? 0 : sj + 1, s2_ = s1_ == 2 ? 0 : s1_ + 1;
      SBAR(); QKT(pB0, pB1, (u16*)((char*)K_lds + s0_ * SHM_K));
      finishSM(pA0, pA1, alA, l_reg, pa0, pa1, pa2, pa3); SBAR();
      { const int tn = (j + 2 < NT) ? j + 2 : NT - 1; SLOAD(SO, tn); } SBAR();
      pv_d0(o, vb0 + s2_ * (int)SHM_V, pa0, pa1, pa2, pa3); partialSM(pB0, pB1, m_reg, mnB, alB);
      SWAIT(); SWRITE(s1_, SE);
      RESC(alB); __syncthreads();
      SBAR(); QKT(pA0, pA1, (u16*)((char*)K_lds + s1_ * SHM_K));
      finishSM(pB0, pB1, alB, l_reg, pa0, pa1, pa2, pa3); SBAR();
      { const int tn = (j + 3 < NT) ? j + 3 : NT - 1; SLOAD(SE, tn); } SBAR();
      pv_d0(o, vb0 + s0_ * (int)SHM_V, pa0, pa1, pa2, pa3); partialSM(pA0, pA1, m_reg, mnA, alA);
      SWAIT(); SWRITE(s2_, SO);
      RESC(alA); __syncthreads();
      sj = s2_; slast = s1_;
    }
    finishSM(pA0, pA1, alA, l_reg, pa0, pa1, pa2, pa3); SBAR();
    pv_d0(o, vb0 + slast * (int)SHM_V, pa0, pa1, pa2, pa3);
  } else {
  const int tqw = __builtin_amdgcn_readfirstlane(tq);
#define TACT(tt) (metaq || !((64 * (ktlo + (tt) - 1) > tqw + 159) || (64 * (ktlo + (tt) - 1) + 63 < tqw - 128)))
  bool actA = true, actB = true;
#define PFILL(P0, P1) do { _Pragma("unroll") for (int r = 0; r < 16; ++r) { P0[r] = NEGBIG; P1[r] = NEGBIG; } } while (0)
  for (int j = 1; j + 1 < NT; j += 2) {
    actB = TACT(j);
    SBAR(); if (actB) { QKT(pB0, pB1, (u16*)((char*)K_lds + SHM_K)); WMASK(pB0, pB1, j); } else PFILL(pB0, pB1);
    finishSM(pA0, pA1, alA, l_reg, pa0, pa1, pa2, pa3); SBAR();
    { const int tn = (j + SD < NT) ? j + SD : NT - 1; SLOAD(SO, tn); } SBAR();
    if (actA) pv_d0(o, vb0, pa0, pa1, pa2, pa3);
    partialSM(pB0, pB1, m_reg, mnB, alB);
    __syncthreads(); SWAIT(); SWRITE(0, SE);
    RESC(alB); __syncthreads();
    actA = TACT(j + 1);
    SBAR(); if (actA) { QKT(pA0, pA1, K_lds); WMASK(pA0, pA1, j + 1); } else PFILL(pA0, pA1);
    finishSM(pB0, pB1, alB, l_reg, pa0, pa1, pa2, pa3); SBAR();
    { const int tn = (j + 1 + SD < NT) ? j + 1 + SD : NT - 1; SLOAD(SE, tn); } SBAR();
    if (actB) pv_d0(o, vb0 + (int)SHM_V, pa0, pa1, pa2, pa3);
    partialSM(pA0, pA1, m_reg, mnA, alA);
    __syncthreads(); SWAIT(); SWRITE(1, SO);
    RESC(alA); __syncthreads();
  }
  finishSM(pA0, pA1, alA, l_reg, pa0, pa1, pa2, pa3); SBAR();
  if (actA) pv_d0(o, vb0, pa0, pa1, pa2, pa3);
#undef PFILL
#undef TACT
  }
  if (MODE == 1) l_reg += __builtin_amdgcn_exp2f(sinkL2 - m_reg * (SCALE * 1.4426950408889634f));
  if (MODE == 0 && po != nullptr) {
    if (store) {
      if (hi == 0) { pml[2 * r32] = m_reg; pml[2 * r32 + 1] = l_reg; }
#pragma unroll
      for (int r = 0; r < 16; ++r) { const int orow = crow(r, hi);
#pragma unroll
        for (int d0 = 0; d0 < 4; ++d0) po[orow * 128 + d0 * 32 + r32] = o[d0][r]; }
    }
  } else {
  if (hi == 0) li_l[r32] = l_reg; asm volatile("s_waitcnt lgkmcnt(0)" ::: "memory");
  float rli[16];
#pragma unroll
  for (int r = 0; r < 16; ++r) rli[r] = __builtin_amdgcn_rcpf(li_l[crow(r, hi)]);
  if (store) {
#pragma unroll
    for (int r = 0; r < 16; ++r) { const int orow = crow(r, hi); const long ro = metaq ? (long)(orow & 15) * LDO + (orow >> 4) * 128 : (long)orow * LDO;
#pragma unroll
      for (int d0 = 0; d0 < 4; ++d0) { const float v = o[d0][r] * rli[r]; Ow[ro + d0 * 32 + r32] = (u16)(cvtpk(v, v) & 0xffffu); } }
  }
  }
#undef KROW
#undef QKT
#undef SLOAD
#undef SWRITE
#undef SWAIT
#undef RESC
#undef WMASK
}
}
typedef unsigned short u16;
typedef float f32x4 __attribute__((ext_vector_type(4)));
typedef float f32x2 __attribute__((ext_vector_type(2)));
typedef unsigned u32x4 __attribute__((ext_vector_type(4)));
typedef unsigned u32x2 __attribute__((ext_vector_type(2)));
typedef short bf16x8 __attribute__((ext_vector_type(8)));
typedef short s16x4 __attribute__((ext_vector_type(4)));
#define LAS __attribute__((address_space(3)))

constexpr int DM = 2048, NH = 16, NKV = 4, HD = 128, QKVD = 3072, DFF = 5632, NMETA = 16, NSEQ = 4;
constexpr int TREAL = 49152, MROW0 = TREAL, TTOK = TREAL + NSEQ * NMETA  , TPAD = 49408  ;
constexpr float EPS = 1e-6f;
__host__ __device__ constexpr int seq_S(int s) { return s < 2 ? 8192 : 16384; }
__host__ __device__ constexpr int seq_R0(int s) { return s == 0 ? 0 : s == 1 ? 8192 : s == 2 ? 16384 : 32768; }
__host__ __device__ constexpr int seq_K0(int s) { return s == 0 ? 0 : s == 1 ? 8256 : s == 2 ? 16512 : 32960; }
__host__ __device__ constexpr int seq_Y0(int s) { return s == 0 ? 0 : s == 1 ? 8208 : s == 2 ? 16416 : 32816; }
constexpr int P_N1 = 76, P_N2 = 108, S_N1 = 100, S_N2 = 164;
constexpr int FA_P_J = 160, FA_P_KK = 160, FB_P_J = 224, FB_P_KK = 112, FA_S_J = 224, FA_S_KK = 208, FB_S_J = 352, FB_S_KK = 176;

constexpr size_t MiB = 1u << 20;
constexpr size_t WS_CTL = 0, CTL_ZERO_BYTES = 1 * MiB;
constexpr size_t WS_ROPE = 1 * MiB;
constexpr size_t WS_FC = WS_ROPE + 64 * 1024;
constexpr size_t WS_FA_P = WS_FC + 256 * 1024, WS_FB_P = WS_FA_P + 128 * 1024, WS_FA_S = WS_FB_P + 128 * 1024, WS_FB_S = WS_FA_S + 128 * 1024;
constexpr size_t WS_HMETA = 2 * MiB;
constexpr size_t WS_W = 4 * MiB;
constexpr size_t W_AQKV = 0, W_AWO = W_AQKV + (size_t)QKVD * DM, W_BW = W_AWO + (size_t)DM * DM, W_CIN = W_BW + (size_t)DM * DM, W_COUT = W_CIN + (size_t)3 * DM * DM,
                 W_DQKV = W_COUT + (size_t)DM * DM, W_DWO = W_DQKV + (size_t)QKVD * DM, W_FIN = W_DWO + (size_t)DM * DM, W_FOUT = W_FIN + (size_t)4 * 2 * DFF * DM, W_END = W_FOUT + (size_t)4 * DFF * DM;
constexpr size_t WS_HB = WS_W + 352 * MiB;
constexpr size_t WS_BIG = WS_HB + 193 * MiB;
constexpr size_t BIG_QKV = 0, BIG_KC = 290 * MiB, BIG_VC = 339 * MiB;
constexpr size_t BIG_PO = 400 * MiB, BIG_PML = 410 * MiB;
constexpr size_t BIG_SS = 560 * MiB, BIG_RSTD = 570 * MiB;
constexpr size_t BIG_TAILP = 540 * MiB;
constexpr size_t BIG_ACT = 0;
constexpr size_t BIG_BB = 0, BIG_GB = 193 * MiB;
constexpr size_t BIG_Z = 0, BIG_Y = 385 * MiB;
constexpr size_t WS_END = WS_BIG + 770 * MiB;
static_assert(W_END * 2 <= 352 * MiB && (size_t)TPAD * DM * 2 <= 193 * MiB && (size_t)TPAD * QKVD * 2 <= 290 * MiB && (size_t)TPAD * 512 * 2 <= 49 * MiB, "ws map");
static_assert((size_t)TPAD * DFF * 2 <= 770 * MiB && (size_t)TTOK * 4096 * 2 <= 385 * MiB, "ws map");
constexpr int CW_BAR = 4096;

constexpr int LDS_STAGE = 133120;
constexpr int LDS_MISC = LDS_STAGE;
constexpr int LDS_BYTES = LDS_STAGE + 256;

#define XB_TMO      128
#define XB_XCNT(j)  (256  + 64 * (j))
#define XB_XSUB(j)  (1280 + 64 * (j))
#define XB_XGEN(j)  (2304 + 64 * (j))
#define XB_TOP      3328
#define XB_TOPGEN   3392
#define XCD_BAR_WORDS 3456
#define XB_SPIN_CAP (1u << 18)
__device__ __forceinline__ unsigned xb_ld(unsigned* p)              { return __hip_atomic_load(p, __ATOMIC_RELAXED, __HIP_MEMORY_SCOPE_AGENT); }
__device__ __forceinline__ unsigned xb_add(unsigned* p, unsigned v) { return __hip_atomic_fetch_add(p, v, __ATOMIC_RELAXED, __HIP_MEMORY_SCOPE_AGENT); }
__device__ __forceinline__ unsigned xb_xcc_id() { return (unsigned)__builtin_amdgcn_s_getreg((3 << 11) | 20) & 0xFu; }
#define XB_SPIN(cond, bar) do { unsigned _sp = 0; while (cond) { __builtin_amdgcn_s_sleep(1); \
    if ((++_sp & 255u) == 0u) { if (xb_ld(&(bar)[XB_TMO])) break; if (_sp > XB_SPIN_CAP) { atomicAdd(&(bar)[XB_TMO], 1u); break; } } } } while (0)
struct XcdBarrier { unsigned* bar; unsigned x; volatile LAS unsigned* st; };
__device__ __forceinline__ XcdBarrier xcd_barrier_post(unsigned* bar, volatile LAS unsigned* st) {
    XcdBarrier b; b.bar = bar; b.x = xb_xcc_id(); b.st = st;
    if (threadIdx.x == 0) (void)xb_add(&bar[XB_XCNT(b.x)], 1u);
    return b;
}
__device__ __forceinline__ void xcd_barrier_complete(unsigned* bar, unsigned x, unsigned& nloc, unsigned& nx) {
    const unsigned G = gridDim.x * gridDim.y * gridDim.z;
    unsigned sum, cnt, mine, sp = 0u;
    for (;;) {
        sum = 0u; cnt = 0u; mine = 0u;
#pragma unroll
        for (unsigned j = 0; j < 16; ++j) { const unsigned c = xb_ld(&bar[XB_XCNT(j)]); sum += c; cnt += (c > 0u) ? 1u : 0u; mine = (j == x) ? c : mine; }
        if (sum == G) break;
        __builtin_amdgcn_s_sleep(1);
        if ((++sp & 255u) == 0u) { if (xb_ld(&bar[XB_TMO])) break; if (sp > XB_SPIN_CAP) { atomicAdd(&bar[XB_TMO], 1u); break; } }
    }
    nloc = mine > 0u ? mine : 1u; nx = cnt > 0u ? cnt : 1u;
}
__device__ __forceinline__ void xcd_barrier(const XcdBarrier& b) {
    asm volatile("s_waitcnt vmcnt(0)" ::: "memory");
    __syncthreads();
    if (threadIdx.x == 0) {
        unsigned* bar = b.bar;
        __builtin_amdgcn_s_waitcnt(0);
        unsigned nloc = b.st[0], nx = b.st[1];
        if (nloc == 0u) { xcd_barrier_complete(bar, b.x, nloc, nx); b.st[0] = nloc; b.st[1] = nx; }
        const unsigned old = xb_add(&bar[XB_XSUB(b.x)], 1u);
        const unsigned gen = old / nloc;
        if (old + 1u == (gen + 1u) * nloc) {
            __builtin_amdgcn_fence(__ATOMIC_RELEASE, "agent");
            asm volatile("s_waitcnt vmcnt(0)" ::: "memory");
            const unsigned og = xb_add(&bar[XB_TOP], 1u);
            const unsigned tg = og / nx;
            if (og + 1u == (tg + 1u) * nx) xb_add(&bar[XB_TOPGEN], 1u);
            else XB_SPIN(xb_ld(&bar[XB_TOPGEN]) == tg, bar);
            __builtin_amdgcn_fence(__ATOMIC_ACQUIRE, "agent");
            xb_add(&bar[XB_XGEN(b.x)], 1u);
            asm volatile("s_waitcnt vmcnt(0)" ::: "memory");
        } else {
            XB_SPIN(xb_ld(&bar[XB_XGEN(b.x)]) == gen, bar);
            __builtin_amdgcn_fence(__ATOMIC_ACQUIRE, "agent");
            asm volatile("s_waitcnt vmcnt(0)" ::: "memory");
        }
    }
    __syncthreads();
}

struct Job { const float* src; u16* dst; const float* gain; int K, ld, col0, ncols, split, mult, roff, item0; };
struct Params {
    const float* in[20]; float* out; unsigned char* ws;
    int ph_lo, ph_hi;
};
enum { I_XP = 0, I_XS, I_META, I_LNMIX, I_LNFFN, I_AWQKV, I_AQN, I_AKN, I_AWO, I_BW, I_CWIN, I_CCONV, I_CWOUT, I_DWQKV, I_DQN, I_DKN, I_DSINK, I_DWO, I_FIN, I_FOUT };

#define GAS __attribute__((address_space(1)))
#define LAUNDER_PTR(T, name, src) GAS char* name##_g = (GAS char*)(src); asm volatile("" : "+s"(name##_g)); T name = (T)name##_g
template <int M> __device__ __forceinline__ float swz_xor(float v) { return __int_as_float(__builtin_amdgcn_ds_swizzle(__float_as_int(v), 0x1f | (M << 10))); }
__device__ __forceinline__ float wave_sum(float v) {
    v += swz_xor<1>(v); v += swz_xor<2>(v); v += swz_xor<4>(v); v += swz_xor<8>(v); v += swz_xor<16>(v);
    const auto rr = __builtin_amdgcn_permlane32_swap(__float_as_uint(v), __float_as_uint(v), false, false);
    return __uint_as_float(rr[0]) + __uint_as_float(rr[1]);
}
__device__ __forceinline__ unsigned pk2(float lo, float hi) { unsigned r; asm volatile("v_cvt_pk_bf16_f32 %0, %1, %2" : "=v"(r) : "v"(lo), "v"(hi)); return r; }
__device__ __forceinline__ float bflo(unsigned w) { return __uint_as_float(w << 16); }
__device__ __forceinline__ float bfhi(unsigned w) { return __uint_as_float(w & 0xffff0000u); }
__device__ __forceinline__ int rowmap(int s, int l) { return l < NMETA ? MROW0 + NMETA * s + l : seq_R0(s) + l - NMETA; }

__device__ __forceinline__ void transpose_item(const Job& jb, LAS float* scr, int item, int lane) {
    const int nblk = jb.ncols / 64, kb = item / nblk, nb = item % nblk, k0 = 64 * kb, n0 = 64 * nb;
    const float* W = jb.src + jb.col0;
#pragma unroll 8
    for (int kk = 0; kk < 64; ++kk) scr[kk * 65 + lane] = W[(size_t)(k0 + kk) * jb.ld + n0 + lane];
    asm volatile("s_waitcnt lgkmcnt(0)" ::: "memory");
    const int c = lane & 7;
    f32x4 ga = {1.f, 1.f, 1.f, 1.f}, gb = ga;
    if (jb.gain) { ga = *(const f32x4*)(jb.gain + k0 + 8 * c); gb = *(const f32x4*)(jb.gain + k0 + 8 * c + 4); }
#pragma unroll
    for (int j = 0; j < 8; ++j) { const int n = (lane >> 3) + 8 * j; const LAS float* s = scr + (8 * c) * 65 + n;
        u32x4 o; o.x = pk2(s[0 * 65] * ga.x, s[1 * 65] * ga.y); o.y = pk2(s[2 * 65] * ga.z, s[3 * 65] * ga.w); o.z = pk2(s[4 * 65] * gb.x, s[5 * 65] * gb.y); o.w = pk2(s[6 * 65] * gb.z, s[7 * 65] * gb.w);
        const int nn = n0 + n; int drow;
        if (jb.mult == 1) drow = jb.roff + nn;
        else { const int part = nn / jb.split, jj = nn % jb.split, o = jj & 127;
            drow = jb.roff + (jj >> 7) * 256 + ((o >> 2) & 1) * 128 + (o >> 5) * 32 + ((o >> 3) & 3) * 8 + (o & 3) * 2 + part; }
        *(u32x4*)(jb.dst + (size_t)drow * jb.K + k0 + 8 * c) = o; }
    asm volatile("s_waitcnt lgkmcnt(0)" ::: "memory");
}
__device__ __forceinline__ u16 f2bf(float f) { return (u16)(pk2(f, f) & 0xffffu); }
__device__ __forceinline__ void gen_FA(u16* F, int N1, int Jp, int KKp, int gt, int ngt) {
    for (int e = gt; e < KKp * Jp; e += ngt) { const int kk = e / Jp, j = e % Jp; float v = 0.f;
        if (kk < 2 * N1 && j < 2 * N1) { const int po = kk >= N1, pi = j >= N1, k1 = kk - po * N1, l1 = j - pi * N1; float sn, cs; sincospif(2.0f * (float)((k1 * l1) % N1) / (float)N1, &sn, &cs);
            v = (po == pi) ? cs : (po ? -sn : sn); }
        F[e] = f2bf(v); }
}
__device__ __forceinline__ void gen_FB(u16* F, int N2, int Jp, int KKp, float scale, int gt, int ngt) {
    for (int e = gt; e < KKp * Jp; e += ngt) { const int kk = e / Jp, j = e % Jp; float v = 0.f;
        if (kk < N2 && j < 2 * N2) { const int pi = j >= N2, l2 = j - pi * N2; float sn, cs; sincospif(2.0f * (float)((kk * l2) % N2) / (float)N2, &sn, &cs); v = (pi ? sn : cs) * scale; }
        F[e] = f2bf(v); }
}
__device__ __forceinline__ void prologue_phase(const Params& P, LAS unsigned char* lds, int wave_, int lane_) {
    int tid_q = threadIdx.x; asm volatile("" : "+v"(tid_q)); const int lane = tid_q & 63, wave = __builtin_amdgcn_readfirstlane(tid_q >> 6); (void)lane_; (void)wave_;
    LAUNDER_PTR(unsigned char*, ws, P.ws);
    LAS float* scr = (LAS float*)(lds + wave * 16640);
    const int gw = blockIdx.x * 8 + wave, NGW = gridDim.x * 8;
    u16* Wb = (u16*)(ws + WS_W);
    constexpr int IT_S = 32 * 32  , IT_QKV = 32 * 48, IT_CU = 32 * 64, IT_FIN = 32 * 176, IT_FOUT = 88 * 32;
    constexpr int O1 = IT_QKV, O2 = O1 + IT_S, O3 = O2 + IT_S, O4 = O3 + IT_S, O5 = O4 + IT_CU, O6 = O5 + IT_S, O7 = O6 + IT_QKV, O8 = O7 + IT_S, O9 = O8 + 4 * IT_FIN, O10 = O9 + 4 * IT_FOUT;
    for (int it = gw; it < O10; it += NGW) {
        Job jb;
        if (it < O1)      jb = Job{P.in[I_AWQKV], Wb + W_AQKV, P.in[I_LNMIX], DM, QKVD, 0, QKVD, QKVD, 1, 0, 0};
        else if (it < O2) jb = Job{P.in[I_AWO], Wb + W_AWO, nullptr, DM, DM, 0, DM, DM, 1, 0, O1};
        else if (it < O3) jb = Job{P.in[I_BW], Wb + W_BW, nullptr, DM, DM, 0, DM, DM, 1, 0, O2};
        else if (it < O4) jb = Job{P.in[I_CWIN], Wb + W_CIN, P.in[I_LNMIX] + 2 * DM, DM, 3 * DM, 0, DM, DM, 1, 0, O3};
        else if (it < O5) jb = Job{P.in[I_CWIN], Wb + W_CIN, P.in[I_LNMIX] + 2 * DM, DM, 3 * DM, DM, 2 * DM, DM, 2, DM, O4};
        else if (it < O6) jb = Job{P.in[I_CWOUT], Wb + W_COUT, nullptr, DM, DM, 0, DM, DM, 1, 0, O5};
        else if (it < O7) jb = Job{P.in[I_DWQKV], Wb + W_DQKV, P.in[I_LNMIX] + 3 * DM, DM, QKVD, 0, QKVD, QKVD, 1, 0, O6};
        else if (it < O8) jb = Job{P.in[I_DWO], Wb + W_DWO, nullptr, DM, DM, 0, DM, DM, 1, 0, O7};
        else if (it < O9) { const int l = (it - O8) / IT_FIN; jb = Job{P.in[I_FIN] + (size_t)l * DM * 2 * DFF, Wb + W_FIN + (size_t)l * 2 * DFF * DM, P.in[I_LNFFN] + l * DM, DM, 2 * DFF, 0, 2 * DFF, DFF, 2, 0, O8 + l * IT_FIN}; }
        else { const int l = (it - O9) / IT_FOUT; jb = Job{P.in[I_FOUT] + (size_t)l * DFF * DM, Wb + W_FOUT + (size_t)l * DFF * DM, nullptr, DFF, DM, 0, DM, DM, 1, 0, O9 + l * IT_FOUT}; }
        transpose_item(jb, scr, it - jb.item0, lane);
    }
    const int gt = blockIdx.x * 512 + threadIdx.x, ngt = gridDim.x * 512;
    { float2* tab = (float2*)(ws + WS_ROPE);
      for (int e = gt; e < 256 * 32; e += ngt) { const int pos = e >> 5, i = e & 31; const double ang = (double)pos * pow(10000.0, -(double)i / 32.0); tab[e] = make_float2((float)cos(ang), (float)sin(ang)); } }
    { u16* fc = (u16*)(ws + WS_FC);
      for (int e = gt; e < 512 * 256; e += ngt) { const int n = e >> 8, c = e & 255, cp = n & 255; float sn, cs; sincospif(2.0f * (float)((c * cp) & 255) / 256.0f, &sn, &cs); fc[e] = f2bf(n < 256 ? cs : -sn); } }
    gen_FA((u16*)(ws + WS_FA_P), P_N1, FA_P_J, FA_P_KK, gt, ngt);
    gen_FA((u16*)(ws + WS_FA_S), S_N1, FA_S_J, FA_S_KK, gt, ngt);
    gen_FB((u16*)(ws + WS_FB_P), P_N2, FB_P_J, FB_P_KK, 1.0f / sqrtf(256.0f * 8208.0f), gt, ngt);
    gen_FB((u16*)(ws + WS_FB_S), S_N2, FB_S_J, FB_S_KK, 1.0f / sqrtf(256.0f * 16400.0f), gt, ngt);
}

template <bool EMBED>
__device__ __forceinline__ void norm_phase(const Params& P, const float* gain, int nks  , int wave_, int lane_) {
    int tid_q = threadIdx.x; asm volatile("" : "+v"(tid_q)); const int lane = tid_q & 63, wave = __builtin_amdgcn_readfirstlane(tid_q >> 6); (void)lane_; (void)wave_;
    LAUNDER_PTR(unsigned char*, ws, P.ws);
    LAUNDER_PTR(float*, outp, P.out); u16* X = (u16*)outp; u16* HB = (u16*)(ws + WS_HB); float* hmeta = (float*)(ws + WS_HMETA);
    const int gw = blockIdx.x * 8 + wave, NGW = gridDim.x * 8;
    LAUNDER_PTR(const float*, gainp, gain);
    f32x4 g[8];
#pragma unroll
    for (int j = 0; j < 8; ++j) g[j] = ((const f32x4*)gainp)[lane + 64 * j];
    for (int r = gw; r < TTOK; r += NGW) {
        f32x4 v[8];
        if (r < TREAL) {
            if (EMBED) { const float* src = r < 16384 ? P.in[I_XP] + (size_t)r * DM : P.in[I_XS] + (size_t)(r - 16384) * DM;
#pragma unroll
                for (int j = 0; j < 8; ++j) v[j] = ((const f32x4*)src)[lane + 64 * j];
                u32x2* hb = (u32x2*)(HB + (size_t)r * DM);
#pragma unroll
                for (int j = 0; j < 8; ++j) { u32x2 w; w.x = pk2(v[j].x, v[j].y); w.y = pk2(v[j].z, v[j].w); hb[lane + 64 * j] = w;
                    v[j] = (f32x4){bflo(w.x), bfhi(w.x), bflo(w.y), bfhi(w.y)}; }
            } else { const u32x2* hb = (const u32x2*)(HB + (size_t)r * DM);
#pragma unroll
                for (int j = 0; j < 8; ++j) { const u32x2 w = hb[lane + 64 * j]; v[j] = (f32x4){bflo(w.x), bfhi(w.x), bflo(w.y), bfhi(w.y)}; } }
        } else {
            float* hdst = hmeta + (size_t)(r - TREAL) * DM; const float* src = EMBED ? P.in[I_META] + (size_t)((r - TREAL) & 15) * DM : hdst;
#pragma unroll
            for (int j = 0; j < 8; ++j) v[j] = ((const f32x4*)src)[lane + 64 * j];
            if (!EMBED) {
                const float* tp = (const float*)(ws + WS_BIG + BIG_TAILP) + (size_t)(r - TREAL) * DM;
                for (int ks = 0; ks < nks; ++ks) {
#pragma unroll
                    for (int j = 0; j < 8; ++j) v[j] += ((const f32x4*)(tp + (size_t)ks * 64 * DM))[lane + 64 * j]; }
            }
#pragma unroll
            for (int j = 0; j < 8; ++j) ((f32x4*)hdst)[lane + 64 * j] = v[j];
        }
        float ss = 0.f;
#pragma unroll
        for (int j = 0; j < 8; ++j) ss += (v[j].x * v[j].x + v[j].y * v[j].y) + (v[j].z * v[j].z + v[j].w * v[j].w);
        const float rstd = 1.0f / sqrtf(wave_sum(ss) * (1.0f / DM) + EPS);
        u32x2* o = (u32x2*)(X + (size_t)r * DM);
#pragma unroll
        for (int j = 0; j < 8; ++j) { u32x2 w; w.x = pk2(v[j].x * rstd * g[j].x, v[j].y * rstd * g[j].y); w.y = pk2(v[j].z * rstd * g[j].z, v[j].w * rstd * g[j].w); o[lane + 64 * j] = w; }
    }
}

__device__ __forceinline__ void embed_phase(const Params& P) {
    int tid_q = threadIdx.x; asm volatile("" : "+v"(tid_q)); const int lane = tid_q & 63, wave = __builtin_amdgcn_readfirstlane(tid_q >> 6);
    LAUNDER_PTR(unsigned char*, ws, P.ws);
    u16* HB = (u16*)(ws + WS_HB); float* hmeta = (float*)(ws + WS_HMETA); float* rstdp = (float*)(ws + WS_BIG + BIG_RSTD);
    const int gw = blockIdx.x * 8 + wave, NGW = gridDim.x * 8;
    for (int r = gw; r < TTOK; r += NGW) {
        const float* src = r < 16384 ? P.in[I_XP] + (size_t)r * DM : r < TREAL ? P.in[I_XS] + (size_t)(r - 16384) * DM : P.in[I_META] + (size_t)((r - TREAL) & 15) * DM;
        f32x4 v[8]; float ss = 0.f;
#pragma unroll
        for (int j = 0; j < 8; ++j) v[j] = ((const f32x4*)src)[lane + 64 * j];
        if (r >= TREAL) {
#pragma unroll
            for (int j = 0; j < 8; ++j) ((f32x4*)(hmeta + (size_t)(r - TREAL) * DM))[lane + 64 * j] = v[j];
        }
        u32x2* hb = (u32x2*)(HB + (size_t)r * DM);
#pragma unroll
        for (int j = 0; j < 8; ++j) { u32x2 w; w.x = pk2(v[j].x, v[j].y); w.y = pk2(v[j].z, v[j].w); hb[lane + 64 * j] = w;
            ss += (v[j].x * v[j].x + v[j].y * v[j].y) + (v[j].z * v[j].z + v[j].w * v[j].w); }
        const float rstd = 1.0f / sqrtf(wave_sum(ss) * (1.0f / DM) + EPS);
        if (lane == 0) rstdp[r] = rstd;
    }
}
__device__ __forceinline__ void stats_phase(const Params& P, int nks) {
    int tid_q = threadIdx.x; asm volatile("" : "+v"(tid_q)); const int lane = tid_q & 63, wave = __builtin_amdgcn_readfirstlane(tid_q >> 6);
    LAUNDER_PTR(unsigned char*, ws, P.ws);
    u16* HB = (u16*)(ws + WS_HB); float* hmeta = (float*)(ws + WS_HMETA); float* rstdp = (float*)(ws + WS_BIG + BIG_RSTD); const float* SS = (const float*)(ws + WS_BIG + BIG_SS);
    for (int r = blockIdx.x * 512 + tid_q; r < TREAL; r += gridDim.x * 512) {
        float s = 0.f, pv[32];
#pragma unroll
        for (int j = 0; j < 32; ++j) pv[j] = SS[(size_t)j * TREAL + r];
        __builtin_amdgcn_sched_barrier(0);
#pragma unroll
        for (int j = 0; j < 32; j += 4) s += (pv[j] + pv[j + 1]) + (pv[j + 2] + pv[j + 3]);
        rstdp[r] = 1.0f / sqrtf(s * (1.0f / DM) + EPS);
    }
    const int gw = blockIdx.x * 8 + wave;
    const int mrow = (int)(gridDim.x * 8) - 1 - gw;
    if (mrow < NSEQ * NMETA) {
        float* hrow = hmeta + (size_t)mrow * DM; const float* tp = (const float*)(ws + WS_BIG + BIG_TAILP) + (size_t)mrow * DM;
        f32x4 v[8]; float ss = 0.f;
#pragma unroll
        for (int j = 0; j < 8; ++j) v[j] = ((const f32x4*)hrow)[lane + 64 * j];
        for (int ks = 0; ks < nks; ++ks) {
#pragma unroll
            for (int j = 0; j < 8; ++j) v[j] += ((const f32x4*)(tp + (size_t)ks * 64 * DM))[lane + 64 * j]; }
        u32x2* hb = (u32x2*)(HB + (size_t)(TREAL + mrow) * DM);
#pragma unroll
        for (int j = 0; j < 8; ++j) { ((f32x4*)hrow)[lane + 64 * j] = v[j]; u32x2 w; w.x = pk2(v[j].x, v[j].y); w.y = pk2(v[j].z, v[j].w); hb[lane + 64 * j] = w;
            ss += (v[j].x * v[j].x + v[j].y * v[j].y) + (v[j].z * v[j].z + v[j].w * v[j].w); }
        const float rstd = 1.0f / sqrtf(wave_sum(ss) * (1.0f / DM) + EPS);
        if (lane == 0) rstdp[TREAL + mrow] = rstd;
    }
}

__device__ __forceinline__ size_t kc_off(int s, int kvh, int lrow) { return ((size_t)seq_K0(s) * 4 + (size_t)kvh * (64 + seq_S(s)) + lrow) * HD; }
template <bool ROPE>
__device__ __forceinline__ void qkprep_phase(const Params& P, const float* qgain, const float* kgain, int wave_, int lane_) {
    int tid_q = threadIdx.x; asm volatile("" : "+v"(tid_q)); const int lane = tid_q & 63, wave = __builtin_amdgcn_readfirstlane(tid_q >> 6); (void)lane_; (void)wave_;
    LAUNDER_PTR(unsigned char*, ws, P.ws);
    u16* QKV = (u16*)(ws + WS_BIG + BIG_QKV); u16* Kc = (u16*)(ws + WS_BIG + BIG_KC); u16* Vc = (u16*)(ws + WS_BIG + BIG_VC);
    const float2* tab = (const float2*)(ws + WS_ROPE);
    const int gw = blockIdx.x * 8 + wave, NGW = gridDim.x * 8;
    const int li = lane & 15, hg = lane >> 4;
    float qg[8], kg[8];
#pragma unroll
    for (int e = 0; e < 8; ++e) { qg[e] = qgain[8 * li + e]; kg[e] = kgain[8 * li + e]; }
    __syncthreads();
#define QK_GLD(dst_, ptr_) asm volatile("global_load_dwordx4 %0, %1, off" : "=v"(dst_) : "v"(ptr_) : "memory")
#define QK_ROWINFO(r_, krow_, rowpos_, colpos_, s_) do { if ((r_) < TREAL) { s_ = (r_) < 8192 ? 0 : (r_) < 16384 ? 1 : (r_) < 32768 ? 2 : 3; const int p_ = (r_) - seq_R0(s_); krow_ = 64 + p_; rowpos_ = p_ >> 6; colpos_ = p_ & 63; } \
        else { const int m_ = (r_) - TREAL; s_ = m_ >> 4; krow_ = m_ & 15; rowpos_ = 0; colpos_ = 0; } } while (0)
#define QK_LOADROW(buf_, tb_, r_) do { int kr_, rp_, cp_, s2_; QK_ROWINFO(r_, kr_, rp_, cp_, s2_); (void)kr_; (void)s2_; const u16* q_ = QKV + (size_t)(r_) * QKVD; \
        _Pragma("unroll") for (int it = 0; it < 5; ++it) QK_GLD(buf_[it], q_ + (it * 4 + hg) * HD + 8 * li); QK_GLD(buf_[5], q_ + 2560 + 8 * lane); \
        if (ROPE) { const int pos_ = (li & 8) ? cp_ : rp_; const float2* t_ = tab + pos_ * 32 + 8 * (li & 3); _Pragma("unroll") for (int e = 0; e < 4; ++e) QK_GLD(tb_[e], t_ + 2 * e); } } while (0)
    u32x4 cb[6], nb[6], ct[4], nt[4];
#define QK_ROW(CB, CT, NB, NT, WAIT0) do { \
        const int rn = r + NGW; \
        if (WAIT0) asm volatile("s_waitcnt vmcnt(0)" ::: "memory"); else asm volatile("s_waitcnt vmcnt(6)" ::: "memory");     \
        _Pragma("unroll") for (int i = 0; i < 6; ++i) asm volatile("" : "+v"(CB[i])); \
        if (ROPE) { _Pragma("unroll") for (int i = 0; i < 4; ++i) asm volatile("" : "+v"(CT[i])); } \
        if (rn < TTOK) QK_LOADROW(NB, NT, rn); \
        int krow, rowpos, colpos, s; QK_ROWINFO(r, krow, rowpos, colpos, s); (void)rowpos; (void)colpos; \
        u16* qrow = QKV + (size_t)r * QKVD; \
        float cs[8], sn[8]; \
        if (ROPE) { _Pragma("unroll") for (int e = 0; e < 4; ++e) { cs[2 * e] = __uint_as_float(CT[e].x); sn[2 * e] = __uint_as_float(CT[e].y); cs[2 * e + 1] = __uint_as_float(CT[e].z); sn[2 * e + 1] = __uint_as_float(CT[e].w); } } \
        _Pragma("unroll") for (int it = 0; it < 5; ++it) { \
            u16* ptr = qrow + (it * 4 + hg) * HD + 8 * li; \
            const u32x4 w = CB[it]; \
            float x[8] = {bflo(w.x), bfhi(w.x), bflo(w.y), bfhi(w.y), bflo(w.z), bfhi(w.z), bflo(w.w), bfhi(w.w)}; \
            float ss = 0.f; \
            _Pragma("unroll") for (int e = 0; e < 8; ++e) ss += x[e] * x[e]; \
            ss += swz_xor<1>(ss); ss += swz_xor<2>(ss); ss += swz_xor<4>(ss); ss += swz_xor<8>(ss); \
            const float rs = 1.0f / sqrtf(ss * (1.0f / HD) + EPS); \
            float y[8]; \
            _Pragma("unroll") for (int e = 0; e < 8; ++e) y[e] = x[e] * rs * (it < 4 ? qg[e] : kg[e]); \
            if (ROPE) { _Pragma("unroll") for (int e = 0; e < 8; ++e) { const float yp = swz_xor<4>(y[e]); y[e] = (li & 4) ? (yp * sn[e] + y[e] * cs[e]) : (y[e] * cs[e] - yp * sn[e]); } } \
            u32x4 o; o.x = pk2(y[0], y[1]); o.y = pk2(y[2], y[3]); o.z = pk2(y[4], y[5]); o.w = pk2(y[6], y[7]); \
            if (it < 4) *(u32x4*)ptr = o; \
            else *(u32x4*)(Kc + kc_off(s, hg, krow) + 8 * li) = o; \
        } \
        *(u32x4*)(Vc + kc_off(s, lane >> 4, krow) + 8 * (lane & 15)) = CB[5]; \
    } while (0)
    int r = gw;
    if (r < TTOK) { QK_LOADROW(cb, ct, r); QK_ROW(cb, ct, nb, nt, true); r += NGW; }
    for (; r < TTOK; r += 2 * NGW) {
        QK_ROW(nb, nt, cb, ct, false);
        r += NGW; if (r >= TTOK) break;
        QK_ROW(cb, ct, nb, nt, false);
        r -= NGW;
    }
#undef QK_ROW
    for (int mrow = gw; mrow < 4 * NMETA; mrow += NGW) { const int s = mrow >> 4, mi = mrow & 15; const u32x4 z = {0u, 0u, 0u, 0u};
#pragma unroll
        for (int q = 0; q < 3; ++q) { const size_t pr = kc_off(s, lane >> 4, 16 + 3 * mi + q) + 8 * (lane & 15); *(u32x4*)(Kc + pr) = z; *(u32x4*)(Vc + pr) = z; } }
#undef QK_GLD
#undef QK_ROWINFO
#undef QK_LOADROW
}

template <int MODE>
__device__ __forceinline__ void attn_phase(const Params& P, const float* sinks, char* lds, int wave_, int lane_) {
    int tid_q = threadIdx.x; asm volatile("" : "+v"(tid_q)); const int lane = tid_q & 63, wave = __builtin_amdgcn_readfirstlane(tid_q >> 6); (void)lane_; (void)wave_;
    LAUNDER_PTR(unsigned char*, ws, P.ws);
    const u16* QKV = (const u16*)(ws + WS_BIG + BIG_QKV); const u16* Kc = (const u16*)(ws + WS_BIG + BIG_KC); const u16* Vc = (const u16*)(ws + WS_BIG + BIG_VC);
    LAUNDER_PTR(float*, outp, P.out); u16* X = (u16*)outp;
    const int r32 = lane & 31, hi = lane >> 5, G = gridDim.x;
    constexpr int NITEMS = (MODE == 0) ? 3072 + 240 : 3088;
    for (int e = blockIdx.x; e < NITEMS; e += G) {
        int s, kvh, hgp = 0, qb = 0, chunk = 0, y = 0; bool meta = false;
        if (e < 2048) { const int k = e >> 8, bb = e & 255, x = bb & 7, i = bb >> 3, id = i + 32 * k; s = 2 + (x >> 2); kvh = x & 3; hgp = id >> 6; qb = id & 63; }
        else if (e < 3072) { const int e2 = e - 2048, k = e2 >> 8, bb = e2 & 255, x = bb & 7, i = bb >> 3, id = i + 32 * k; s = x >> 2; kvh = x & 3; hgp = id >> 5; qb = id & 31; }
        else { const int e3 = e - 3072; if (MODE == 0) { y = e3 / 15; chunk = e3 - 15 * y; } else y = e3; const int x = y & 7; s = (y < 8 ? 0 : 2) + (x >> 2); kvh = x & 3; meta = true; }
        const int S = seq_S(s);
        const u16* Kh = Kc + kc_off(s, kvh, 0); const u16* Vh = Vc + kc_off(s, kvh, 0);
        const u16* Qw; u16* Ow; int NT, ktlo = 0, tq = 0, head; bool store = true, mask0 = true; float* po = nullptr; float* pml = nullptr;
        if (!meta) {
            head = kvh * 4 + hgp; const int row = seq_R0(s) + 256 * qb + 32 * wave;
            Qw = QKV + (size_t)(row + r32) * QKVD + head * HD + hi * 8; Ow = X + (size_t)row * DM + head * HD;
            if (MODE == 0) NT = 1 + S / 64;
            else { const int t0 = 4 * qb - 2 < 0 ? 0 : 4 * qb - 2, t1 = 4 * qb + 5 > S / 64 - 1 ? S / 64 - 1 : 4 * qb + 5; ktlo = t0; NT = 2 + t1 - t0; tq = 256 * qb + 32 * wave + r32; }
        } else {
            const int w1 = wave & 1, gl = r32 >> 4, mi = r32 & 15; head = kvh * 4 + 2 * w1 + gl; store = wave < 2;
            Qw = QKV + (size_t)(MROW0 + NMETA * s + mi) * QKVD + head * HD + hi * 8; Ow = X + (size_t)(MROW0 + NMETA * s) * DM + (kvh * 4 + 2 * w1) * HD;
            if (MODE == 0) {
                if (s < 2) { ktlo = chunk < 12 ? 9 * chunk : 108 + 7 * (chunk - 12); NT = chunk < 12 ? 9 : 7; } else { ktlo = 17 * chunk; NT = chunk < 14 ? 17 : 19; }
                mask0 = (chunk == 0);
                po = (float*)(ws + WS_BIG + BIG_PO) + ((size_t)(y * 15 + chunk) * 64 + 32 * w1) * 128; pml = (float*)(ws + WS_BIG + BIG_PML) + ((size_t)(y * 15 + chunk) * 64 + 32 * w1) * 2;
            } else { NT = 3; tq = 112 + mi; }
        }
        float slopeS = 0.f, sinkL2 = 0.f;
        if (MODE == 1) { slopeS = exp2f(-0.5f * (float)(head + 1)) * (1.0f / att::SCALE); slopeS = __int_as_float(__builtin_amdgcn_readfirstlane(__float_as_int(slopeS)));
            sinkL2 = sinks[head] * 1.4426950408889634f; }
        att::attn_item<MODE>(Qw, Kh, Vh, Ow, meta, store, NT, ktlo, tq, slopeS, sinkL2, lds, mask0, po, pml);
    }
}
__device__ __forceinline__ void metacombine_phase(const Params& P) {
    int tid_q = threadIdx.x; asm volatile("" : "+v"(tid_q)); const int lane = tid_q & 63, wave = __builtin_amdgcn_readfirstlane(tid_q >> 6);
    LAUNDER_PTR(unsigned char*, ws, P.ws);
    const float* PO = (const float*)(ws + WS_BIG + BIG_PO); const float* PML = (const float*)(ws + WS_BIG + BIG_PML); LAUNDER_PTR(float*, outp, P.out); u16* X = (u16*)outp;
    constexpr float C = att::SCALE * 1.4426950408889634f;
    for (int it = blockIdx.x * 8 + wave; it < 16 * 64; it += gridDim.x * 8) {
        const int y = it >> 6, rr = it & 63, x = y & 7, s = (y < 8 ? 0 : 2) + (x >> 2), kvh = x & 3, head = kvh * 4 + (rr >> 4), mi = rr & 15;
        float mc[15], lc[15], M = -3e38f;
#pragma unroll
        for (int c = 0; c < 15; ++c) { const float2 v = *(const float2*)(PML + ((size_t)(y * 15 + c) * 64 + rr) * 2); mc[c] = v.x; lc[c] = v.y; M = fmaxf(M, v.x); }
        float L = 0.f, o0 = 0.f, o1 = 0.f;
#pragma unroll
        for (int c = 0; c < 15; ++c) { const float w = __builtin_amdgcn_exp2f((mc[c] - M) * C); L += w * lc[c];
            const float2 ov = *(const float2*)(PO + ((size_t)(y * 15 + c) * 64 + rr) * 128 + 2 * lane); o0 += w * ov.x; o1 += w * ov.y; }
        const float rl = 1.0f / L;
        *(unsigned*)(X + (size_t)(MROW0 + NMETA * s + mi) * DM + head * HD + 2 * lane) = pk2(o0 * rl, o1 * rl);
    }
}

constexpr int DFT_RS = 256;
__device__ __forceinline__ int dft_swz(int j) { return (j & 3) | ((j >> 1) & 4); }
template <int STEP, int N1, int N2, int KS  , int NMB  >
__device__ __forceinline__ void dft_run(const Params& P, size_t f_off, int s0, int boff  , LAS unsigned char* lds, int wave_, int lane_) {
    (void)lane_; (void)wave_;
    LAUNDER_PTR(unsigned char*, ws, P.ws); const u16* F = (const u16*)(ws + f_off);
    constexpr int L = N1 * N2, JP = KS * 32, J = STEP == 0 ? 2 * N1 : 2 * N2, KK = STEP == 0 ? 2 * N1 : N2, NB = STEP == 0 ? N2 : N1  ;
    const u16* Z = (const u16*)(ws + WS_BIG + BIG_Z); u16* Y = (u16*)(ws + WS_BIG + BIG_Y); LAUNDER_PTR(float*, outp, P.out); u16* X = (u16*)outp;
    int tid_l = threadIdx.x; asm volatile("" : "+v"(tid_l));
    const int tid = tid_l, lane = tid_l & 63, wave = __builtin_amdgcn_readfirstlane(tid_l >> 6), fi = tid_l & 15, fg = (tid_l & 63) >> 4; (void)lane;
    bf16x8 Ff[2][KS];
#pragma unroll
    for (int q = 0; q < 2; ++q)
#pragma unroll
        for (int ks = 0; ks < KS; ++ks) { const int mb = wave + 8 * q; Ff[q][ks] = (mb < NMB) ? *(const bf16x8*)(F + (size_t)(mb * 16 + fi) * JP + ks * 32 + 8 * fg) : (bf16x8){0, 0, 0, 0, 0, 0, 0, 0}; }
    for (int c = tid; c < (JP - J) * 16; c += 512) *(LAS u32x4*)(lds + (J + c / 16) * DFT_RS + (c % 16) * 16) = (u32x4){0u, 0u, 0u, 0u};
    const int trrow = (fi >> 2) + 8 * fg;
    const int trbase = trrow * DFT_RS + (fi & 3) * 8, sw0 = dft_swz(trrow) << 5;
    constexpr int NCH = STEP == 0 ? (J * 16 + 511) / 512 : (N2 * 16 + 511) / 512;
    u32x4 sa[NCH], sb[STEP == 0 ? 1 : NCH];
    const int NIT = 2 * NB * 16;
#define DFT_GLD(dst_, ptr_) asm volatile("global_load_dwordx4 %0, %1, off" : "=v"(dst_) : "v"(ptr_) : "memory")
#define DFT_BAR() do { asm volatile("s_waitcnt lgkmcnt(0)" ::: "memory"); __builtin_amdgcn_s_barrier(); } while (0)
    const int nst = 8 * (((wave < NMB && wave * 16 < KK) ? 1 : 0) + ((wave + 8 < NMB && (wave + 8) * 16 < KK) ? 1 : 0));
    int pend = 0;
#define DFT_LOAD(e_) do { const int s_ = s0 + (e_) / (NB * 16), rem_ = (e_) % (NB * 16), beta_ = rem_ >> 4, gh_ = rem_ & 15, colb_ = (gh_ >> 1) * 512 + (gh_ & 1) * 128; \
        _Pragma("unroll") for (int i = 0; i < NCH; ++i) { const int c = tid + 512 * i; \
            if (STEP == 0) { if (c < J * 16) { const int j = c >> 4, ch = c & 15, part = j >= N1, l1 = j - part * N1; DFT_GLD(sa[i], Z + (size_t)rowmap(s_, N2 * l1 + beta_) * 4096 + colb_ + part * 256 + ch * 8); } } \
            else { if (c < N2 * 16) { const int l2 = c >> 4, ch = c & 15; const u16* src = Y + (size_t)(seq_Y0(s_) + beta_ * N2 + l2) * 4096 + colb_ + ch * 8; DFT_GLD(sa[i], src); DFT_GLD(sb[i], src + 256); } } } } while (0)
    __syncthreads();
    int e = (int)((blockIdx.x + (unsigned)boff) % gridDim.x);
    if (e < NIT) DFT_LOAD(e);
    for (; e < NIT; e += gridDim.x) {
        const int s = s0 + e / (NB * 16), rem = e % (NB * 16), beta = rem >> 4, gh = rem & 15, colb = (gh >> 1) * 512 + (gh & 1) * 128;
        DFT_BAR();
        if (pend == 16) asm volatile("s_waitcnt vmcnt(16)" ::: "memory"); else if (pend == 8) asm volatile("s_waitcnt vmcnt(8)" ::: "memory"); else asm volatile("s_waitcnt vmcnt(0)" ::: "memory");
#pragma unroll
        for (int i = 0; i < NCH; ++i) { asm volatile("" : "+v"(sa[i])); if (STEP == 1) asm volatile("" : "+v"(sb[i])); }
        pend = nst;
#pragma unroll
        for (int i = 0; i < NCH; ++i) { const int c = tid + 512 * i;
            if (STEP == 0) { if (c < J * 16) { const int j = c >> 4, ch = c & 15; *(LAS u32x4*)(lds + j * DFT_RS + (((ch >> 1) ^ dft_swz(j)) << 5) + (ch & 1) * 16) = sa[i]; } }
            else if (c < N2 * 16) { const int l2 = c >> 4, ch = c & 15; const u32x4 a = sa[i], b = sb[i];
                float sn, cs; sincospif(2.0f * (float)((beta * l2) % L) / (float)L, &sn, &cs);
                u32x4 ore, oim;
#define TW(F_) { const float r0 = bflo(a.F_), r1 = bfhi(a.F_), i0 = bflo(b.F_), i1 = bfhi(b.F_); ore.F_ = pk2(r0 * cs + i0 * sn, r1 * cs + i1 * sn); oim.F_ = pk2(i0 * cs - r0 * sn, i1 * cs - r1 * sn); }
                TW(x) TW(y) TW(z) TW(w)
#undef TW
                *(LAS u32x4*)(lds + l2 * DFT_RS + (((ch >> 1) ^ dft_swz(l2)) << 5) + (ch & 1) * 16) = ore; *(LAS u32x4*)(lds + (N2 + l2) * DFT_RS + (((ch >> 1) ^ dft_swz(N2 + l2)) << 5) + (ch & 1) * 16) = oim; } }
        DFT_BAR();
        if (e + (int)gridDim.x < NIT) DFT_LOAD(e + (int)gridDim.x);
#pragma unroll
        for (int q = 0; q < 2; ++q) {
            const int mb = wave + 8 * q;
            if (mb < NMB) {
                f32x4 acc[8];
#pragma unroll
                for (int nb = 0; nb < 8; ++nb) acc[nb] = (f32x4){0.f, 0.f, 0.f, 0.f};
#pragma unroll
                for (int ks = 0; ks < KS; ++ks) {
                    LAS unsigned char* ap = lds + trbase + ks * 32 * DFT_RS;
#pragma unroll
                    for (int h = 0; h < 2; ++h) {
                        s16x4 a0[4], a1[4];
#pragma unroll
                        for (int n4 = 0; n4 < 4; ++n4) { const int nb = 4 * h + n4; a0[n4] = __builtin_amdgcn_ds_read_tr16_b64_v4i16((LAS s16x4*)(ap + ((nb * 32) ^ sw0))); a1[n4] = __builtin_amdgcn_ds_read_tr16_b64_v4i16((LAS s16x4*)(ap + ((nb * 32) ^ sw0) + 4 * DFT_RS)); }
#pragma unroll
                        for (int n4 = 0; n4 < 4; ++n4) { const int nb = 4 * h + n4; const bf16x8 af = {a0[n4][0], a0[n4][1], a0[n4][2], a0[n4][3], a1[n4][0], a1[n4][1], a1[n4][2], a1[n4][3]};
                            acc[nb] = __builtin_amdgcn_mfma_f32_16x16x32_bf16(af, Ff[q][ks], acc[nb], 0, 0, 0); }
                    }
                }
                const int kk = mb * 16 + fi;
                if (kk < KK) {
                    u16* dst;
                    if (STEP == 0) { const int part = kk >= N1, k1 = kk - part * N1; dst = Y + (size_t)(seq_Y0(s) + k1 * N2 + beta) * 4096 + colb + part * 256 + 4 * fg; }
                    else { dst = X + (size_t)rowmap(s, beta + N1 * kk) * DM + (gh >> 1) * 256 + (gh & 1) * 128 + 4 * fg; }
#pragma unroll
                    for (int nb = 0; nb < 8; ++nb) { u32x2 w; w.x = pk2(acc[nb][0], acc[nb][1]); w.y = pk2(acc[nb][2], acc[nb][3]); *(u32x2*)(dst + nb * 16) = w; }
                }
            }
        }
    }
#undef DFT_LOAD
#undef DFT_GLD
#undef DFT_BAR
    __syncthreads();
}

__device__ __forceinline__ void conv_phase(const Params& P, const float* cw  , int wave_, int lane_) {
    int tid_q = threadIdx.x; asm volatile("" : "+v"(tid_q)); const int lane = tid_q & 63, wave = __builtin_amdgcn_readfirstlane(tid_q >> 6); (void)lane_; (void)wave_;
    LAUNDER_PTR(unsigned char*, ws, P.ws);
    const u16* Bb = (const u16*)(ws + WS_BIG + BIG_BB); const u16* Gb = (const u16*)(ws + WS_BIG + BIG_GB); LAUNDER_PTR(float*, outp, P.out); u16* X = (u16*)outp;
    const int gw = blockIdx.x * 8 + wave, NGW = gridDim.x * 8;
    f32x4 w0[4][2], w1[4][2], w2[4][2];
#pragma unroll
    for (int j = 0; j < 4; ++j)
#pragma unroll
        for (int h = 0; h < 2; ++h) { const int c = 8 * lane + 512 * j + 4 * h; w0[j][h] = *(const f32x4*)(cw + c); w1[j][h] = *(const f32x4*)(cw + DM + c); w2[j][h] = *(const f32x4*)(cw + 2 * DM + c); }
    const int per = (TTOK + NGW - 1) / NGW, rbeg = gw * per, rend = rbeg + per < TTOK ? rbeg + per : TTOK;
    for (int r = rbeg; r < rend; ++r) {
        int prev, next;
        if (r < TREAL) { const int s = r < 8192 ? 0 : r < 16384 ? 1 : r < 32768 ? 2 : 3; const int p = r - seq_R0(s); prev = p > 0 ? r - 1 : MROW0 + NMETA * s + 15; next = p < seq_S(s) - 1 ? r + 1 : -1; }
        else { const int m = r - TREAL, s = m >> 4, i = m & 15; prev = i > 0 ? r - 1 : -1; next = i < 15 ? r + 1 : seq_R0(s); }
        u32x4 bv[4], g0[4], g1[4], g2[4]; const u32x4 zero = {0u, 0u, 0u, 0u};
#pragma unroll
        for (int j = 0; j < 4; ++j) { const int c = 8 * lane + 512 * j;
            bv[j] = *(const u32x4*)(Bb + (size_t)r * DM + c); g1[j] = *(const u32x4*)(Gb + (size_t)r * DM + c);
            g0[j] = prev >= 0 ? *(const u32x4*)(Gb + (size_t)prev * DM + c) : zero; g2[j] = next >= 0 ? *(const u32x4*)(Gb + (size_t)next * DM + c) : zero; }
#pragma unroll
        for (int j = 0; j < 4; ++j) { const int c = 8 * lane + 512 * j; u32x4 o;
#define CV(F_, H, I0, I1) o.F_ = pk2(bflo(bv[j].F_) * (w0[j][H][I0] * bflo(g0[j].F_) + w1[j][H][I0] * bflo(g1[j].F_) + w2[j][H][I0] * bflo(g2[j].F_)), bfhi(bv[j].F_) * (w0[j][H][I1] * bfhi(g0[j].F_) + w1[j][H][I1] * bfhi(g1[j].F_) + w2[j][H][I1] * bfhi(g2[j].F_)));
            CV(x, 0, 0, 1) CV(y, 0, 2, 3) CV(z, 1, 0, 1) CV(w, 1, 2, 3)
#undef CV
            *(u32x4*)(X + (size_t)r * DM + c) = o; }
    }
}

template <int KIND, int KS = 8>
__device__ __forceinline__ void thin_meta_gemm(const Params& P, size_t w_off, int N, LAS unsigned char* lds) {
    int tid_l = threadIdx.x; asm volatile("" : "+v"(tid_l));
    const int tid = tid_l, lane = tid & 63, wave = __builtin_amdgcn_readfirstlane(tid >> 6), fi = lane & 15, fg = lane >> 4, k0 = wave * (KS * 32);
    constexpr int LDK = KS * 256;
    LAUNDER_PTR(unsigned char*, ws, P.ws); LAUNDER_PTR(float*, outp, P.out);
    const u16* A = (KIND != 3) ? (const u16*)(ws + WS_HB) + (size_t)TREAL * DM : (KS == 8) ? (const u16*)outp + (size_t)TREAL * DM : (const u16*)(ws + WS_BIG) + (size_t)TREAL * DFF;
    const u16* Bt = (const u16*)(ws + WS_W) + w_off; const float* rstd = (const float*)(ws + WS_BIG + BIG_RSTD) + TREAL;
    u16* BIG = (u16*)(ws + WS_BIG);
    LAS float* red = (LAS float*)lds;
    for (int blk = blockIdx.x; blk < N / 16; blk += gridDim.x) {
        const int c0 = blk * 16;
        f32x4 acc[4];
#pragma unroll
        for (int nbk = 0; nbk < 4; ++nbk) acc[nbk] = (f32x4){0.f, 0.f, 0.f, 0.f};
#pragma unroll
        for (int ks = 0; ks < KS; ++ks) {
            const bf16x8 wf = *(const bf16x8*)(Bt + (size_t)(c0 + fi) * LDK + k0 + ks * 32 + 8 * fg);
#pragma unroll
            for (int nbk = 0; nbk < 4; ++nbk) { const bf16x8 af = *(const bf16x8*)(A + (size_t)(nbk * 16 + fi) * LDK + k0 + ks * 32 + 8 * fg);
                acc[nbk] = __builtin_amdgcn_mfma_f32_16x16x32_bf16(wf, af, acc[nbk], 0, 0, 0); }
        }
#pragma unroll
        for (int nbk = 0; nbk < 4; ++nbk)
#pragma unroll
            for (int rg = 0; rg < 4; ++rg) red[((wave * 4 + nbk) * 4 + rg) * 64 + lane] = acc[nbk][rg];
        __syncthreads();
        { const int row = tid & 63, p = tid >> 6, l = (p >> 1) * 16 + (row & 15), nbk = row >> 4, rg = 2 * (p & 1);
          float v0 = 0.f, v1 = 0.f;
#pragma unroll
          for (int w = 0; w < 8; ++w) { v0 += red[((w * 4 + nbk) * 4 + rg) * 64 + l]; v1 += red[((w * 4 + nbk) * 4 + rg + 1) * 64 + l]; }
          const float rs = (KIND == 3) ? 1.0f : rstd[row]; const int c = c0 + 2 * p; const size_t orow = (size_t)(TREAL + row);
          if (KIND == 0) *(unsigned*)(BIG + orow * QKVD + c) = pk2(v0 * rs, v1 * rs);
          else if (KIND == 3) { float* hm = (float*)(ws + WS_HMETA) + (size_t)row * DM + c; const f32x2 h = *(const f32x2*)hm; *(f32x2*)hm = (f32x2){h.x + v0, h.y + v1}; }
          else {
              const bool plain = (KIND == 1) && c < DM; const int cc = (KIND == 1) ? c - DM : c, cl = cc & 255;
              const int o = (cc >> 8) * 128 + ((cl >> 5) & 3) * 32 + ((cl >> 3) & 3) * 8 + (cl >> 7) * 4 + ((cl >> 1) & 3);
              if (plain) *(unsigned*)(BIG + orow * DM + c) = pk2(v0 * rs, v1 * rs);
              else if (KIND == 1) { const float gq = v0 * v1 * rs * rs; ((u16*)(ws + WS_BIG + BIG_GB))[orow * DM + o] = (u16)(pk2(gq, gq) & 0xffffu); }
              else { const float gs = v0 * rs, us = v1 * rs, sv = gs * us * __builtin_amdgcn_rcpf(1.0f + __builtin_amdgcn_exp2f(-1.4426950408889634f * gs)); BIG[orow * DFF + o] = (u16)(pk2(sv, sv) & 0xffffu); }
          } }
        __syncthreads();
    }
}

constexpr int PH_PER_LAYER = 9, N_PHASES = 1 + 4 * PH_PER_LAYER;
#ifndef PH_EN
#define PH_EN 0xffffffffu
#endif
#define EN(k) (((PH_EN) >> (k)) & 1u)
#define RUN(p) (lo <= (p) && (p) < hi)
#ifndef REP_MASK
#define REP_MASK 0u
#endif
#define REP(k) (((REP_MASK) >> (k)) & 1u)
#define SEAM(p) do { if ((p) + 1 < hi) { XcdBarrier b2_ = bar; { GAS unsigned* g_ = (GAS unsigned*)b2_.bar; asm volatile("" : "+s"(g_)); b2_.bar = (unsigned*)g_; } xcd_barrier(b2_); if (REP(15)) xcd_barrier(b2_); } } while (0)
#define SITE_PTRS LAUNDER_PTR(unsigned char*, ws, P.ws); LAUNDER_PTR(float*, outp, P.out); u16* Wb = (u16*)(ws + WS_W); u16* X = (u16*)outp; u16* BIG = (u16*)(ws + WS_BIG); (void)Wb; (void)X; (void)BIG
template <int layer>
__device__ __forceinline__ void run_layer(const Params& P, LAS unsigned char* lds, unsigned char* lds_raw, const XcdBarrier& bar, int lo, int hi, int wave, int lane) {

        const int pb = 1 + layer * PH_PER_LAYER;
        if (EN(1) && RUN(pb + 0)) {
            if (layer == 0) embed_phase(P);
            else if (layer == 1) norm_phase<false>(P, P.in[I_LNMIX] + layer * DM, 0, wave, lane);
            else { stats_phase(P, 0); if (REP(1)) stats_phase(P, 0); }
            SEAM(pb + 0); }
        if (RUN(pb + 1)) {
            if (EN(2) && (layer == 0 || layer == 3)) { thin_meta_gemm<0>(P, layer == 0 ? W_AQKV : W_DQKV, QKVD, lds);
                SITE_PTRS; pg8::Gemm g{(const u16*)(ws + WS_HB), Wb + (layer == 0 ? W_AQKV : W_DQKV), TREAL, QKVD, DM, DM}; pg8::StaticOrder S; S.init(TREAL, QKVD, gridDim.x, blockIdx.x, DM); pg8::EpiPlain E{BIG, QKVD, (const float*)(ws + WS_BIG + BIG_RSTD)};
                pg8::gemm_phase<pg8::EpiPlain, pg8::StaticOrder, true, true>(lds, g, S, E); if (REP(2)) pg8::gemm_phase<pg8::EpiPlain, pg8::StaticOrder, true, true>(lds, g, S, E); }
            else if (EN(2) && layer == 1) { SITE_PTRS; pg8::Gemm g{X, (const u16*)(ws + WS_FC), TTOK * 8, 512, 256, 256}; pg8::StaticOrder S; S.init(TTOK * 8, 512, gridDim.x, blockIdx.x, 256); pg8::EpiPlain E{BIG, 512, nullptr};
                pg8::gemm_phase<pg8::EpiPlain, pg8::StaticOrder, true, true>(lds, g, S, E); if (REP(3)) pg8::gemm_phase<pg8::EpiPlain, pg8::StaticOrder, true, true>(lds, g, S, E); }
            else if (EN(3)) { thin_meta_gemm<1>(P, W_CIN, 3 * DM, lds);
                SITE_PTRS; pg8::Gemm g{(const u16*)(ws + WS_HB), Wb + W_CIN, TREAL, 3 * DM, DM, DM}; pg8::StaticOrder S; S.init(TREAL, 3 * DM, gridDim.x, blockIdx.x, DM); pg8::EpiCin E{BIG, (u16*)(ws + WS_BIG + BIG_GB), (const float*)(ws + WS_BIG + BIG_RSTD)};
                pg8::gemm_phase<pg8::EpiCin, pg8::StaticOrder, true, true>(lds, g, S, E); if (REP(4)) pg8::gemm_phase<pg8::EpiCin, pg8::StaticOrder, true, true>(lds, g, S, E); }
            SEAM(pb + 1);
        }
        if (RUN(pb + 2)) {
            if (EN(4) && layer == 0) qkprep_phase<true>(P, P.in[I_AQN], P.in[I_AKN], wave, lane);
            else if (EN(4) && layer == 3) qkprep_phase<false>(P, P.in[I_DQN], P.in[I_DKN], wave, lane);
            else if (EN(5) && layer == 1) { dft_run<0, P_N1, P_N2, FA_P_J / 32, FA_P_KK / 16>(P, WS_FA_P, 0, 0, lds, wave, lane);
                                   dft_run<0, S_N1, S_N2, FA_S_J / 32, FA_S_KK / 16>(P, WS_FA_S, 2, (int)(gridDim.x - (2 * P_N2 * 16) % gridDim.x), lds, wave, lane);
                if (REP(5)) { dft_run<0, P_N1, P_N2, FA_P_J / 32, FA_P_KK / 16>(P, WS_FA_P, 0, 0, lds, wave, lane); dft_run<0, S_N1, S_N2, FA_S_J / 32, FA_S_KK / 16>(P, WS_FA_S, 2, (int)(gridDim.x - (2 * P_N2 * 16) % gridDim.x), lds, wave, lane); } }
            else if (EN(6)) { conv_phase(P, P.in[I_CCONV], wave, lane); if (REP(6)) conv_phase(P, P.in[I_CCONV], wave, lane); }
            SEAM(pb + 2);
        }
        if (RUN(pb + 3)) {
            if (EN(7) && layer == 0) { attn_phase<0>(P, nullptr, (char*)lds_raw, wave, lane); if (REP(7)) attn_phase<0>(P, nullptr, (char*)lds_raw, wave, lane); }
            else if (EN(8) && layer == 3) { attn_phase<1>(P, P.in[I_DSINK], (char*)lds_raw, wave, lane); if (REP(8)) attn_phase<1>(P, P.in[I_DSINK], (char*)lds_raw, wave, lane); }
            else if (EN(9) && layer == 1) { dft_run<1, P_N1, P_N2, FB_P_J / 32, FB_P_KK / 16>(P, WS_FB_P, 0, 0, lds, wave, lane);
                                   dft_run<1, S_N1, S_N2, FB_S_J / 32, FB_S_KK / 16>(P, WS_FB_S, 2, (int)(gridDim.x - (2 * P_N1 * 16) % gridDim.x), lds, wave, lane);
                if (REP(9)) { dft_run<1, P_N1, P_N2, FB_P_J / 32, FB_P_KK / 16>(P, WS_FB_P, 0, 0, lds, wave, lane); dft_run<1, S_N1, S_N2, FB_S_J / 32, FB_S_KK / 16>(P, WS_FB_S, 2, (int)(gridDim.x - (2 * P_N1 * 16) % gridDim.x), lds, wave, lane); } }
            if (layer != 2) SEAM(pb + 3);
        }
        if (layer == 0 && EN(7) && RUN(pb + 4)) { metacombine_phase(P); SEAM(pb + 4); }
        if (EN(10) && RUN(pb + 5)) {
            SITE_PTRS;
            const size_t wo = layer == 0 ? W_AWO : layer == 1 ? W_BW : layer == 2 ? W_COUT : W_DWO;
            if (layer < 3) thin_meta_gemm<3, 8>(P, wo, DM, lds);
            { pg8::Gemm g{X, Wb + wo, TREAL, DM, DM, DM}; pg8::StaticOrder S; S.init(TREAL, DM, gridDim.x, blockIdx.x, DM); const pg8::EpiResidB E{(u16*)(ws + WS_HB), (float*)(ws + WS_BIG + BIG_SS)};
              pg8::gemm_phase<pg8::EpiResidB, pg8::StaticOrder, true, true>(lds, g, S, E); }
            if (REP(10)) { pg8::Gemm g{X, Wb + wo, TREAL, DM, DM, DM}; pg8::StaticOrder S; S.init(TREAL, DM, gridDim.x, blockIdx.x, DM); pg8::EpiPlain E{(u16*)(ws + WS_BIG + 600 * MiB), DM, nullptr};
              pg8::gemm_phase<pg8::EpiPlain, pg8::StaticOrder, true, true>(lds, g, S, E); }
            SEAM(pb + 5);
        }
        if (EN(1) && RUN(pb + 6)) { stats_phase(P, 0); if (REP(1)) stats_phase(P, 0); SEAM(pb + 6); }
        if (EN(11) && RUN(pb + 7)) {
            SITE_PTRS;
            constexpr int MF = TREAL;
            if (layer < 3) thin_meta_gemm<2>(P, W_FIN + (size_t)layer * 2 * DFF * DM, 2 * DFF, lds);
            pg8::Gemm g{(const u16*)(ws + WS_HB), Wb + W_FIN + (size_t)layer * 2 * DFF * DM, MF, 2 * DFF, DM, DM}; pg8::StaticOrder S; S.init(MF, 2 * DFF, gridDim.x, blockIdx.x, DM); pg8::EpiSwiglu E{BIG, DFF, (const float*)(ws + WS_BIG + BIG_RSTD)};
            pg8::gemm_phase<pg8::EpiSwiglu, pg8::StaticOrder, true, true>(lds, g, S, E); if (REP(11)) pg8::gemm_phase<pg8::EpiSwiglu, pg8::StaticOrder, true, true>(lds, g, S, E); if (REP(16)) { pg8::EpiNone E0; pg8::gemm_phase<pg8::EpiNone, pg8::StaticOrder, true, true>(lds, g, S, E0); }
            SEAM(pb + 7);
        }
        if (EN(12) && RUN(pb + 8)) {
            if (layer < 3) thin_meta_gemm<3, 22>(P, W_FOUT + (size_t)layer * DFF * DM, DM, lds);
            SITE_PTRS;
            { pg8::Gemm g{BIG, Wb + W_FOUT + (size_t)layer * DFF * DM, TREAL, DM, DFF, DFF}; pg8::StaticOrder S; S.init(TREAL, DM, gridDim.x, blockIdx.x, DFF); if (layer < 3) { const pg8::EpiResidB E{(u16*)(ws + WS_HB), layer == 0 ? nullptr : (float*)(ws + WS_BIG + BIG_SS)}; pg8::gemm_phase<pg8::EpiResidB, pg8::StaticOrder, true, true>(lds, g, S, E); }
              else { const pg8::EpiResidFinal E{(const u16*)(ws + WS_HB), outp}; pg8::gemm_phase<pg8::EpiResidFinal, pg8::StaticOrder, true, true>(lds, g, S, E); } }
            if (REP(12)) { pg8::Gemm g{BIG, Wb + W_FOUT + (size_t)layer * DFF * DM, TREAL, DM, DFF, DFF}; pg8::StaticOrder S; S.init(TREAL, DM, gridDim.x, blockIdx.x, DFF); pg8::EpiPlain E{X, DM, nullptr};
              pg8::gemm_phase<pg8::EpiPlain, pg8::StaticOrder, true, true>(lds, g, S, E); }
            SEAM(pb + 8);
        }
    }

__global__ void __launch_bounds__(512, 2) encoder_fwd(Params P) {
    extern __shared__ __attribute__((aligned(16))) unsigned char lds_raw[];
    LAS unsigned char* lds = (LAS unsigned char*)lds_raw;
    const int tid = threadIdx.x; constexpr int lane = 0, wave = 0;
    if (tid < 4) ((LAS unsigned*)(lds + LDS_MISC))[tid] = 0u;
    __syncthreads();
    unsigned* barw = (unsigned*)(P.ws + WS_CTL) + CW_BAR;
    XcdBarrier bar = xcd_barrier_post(barw, (volatile LAS unsigned*)(lds + LDS_MISC));
    const int lo = P.ph_lo, hi = P.ph_hi;

    if (EN(0) && RUN(0)) { prologue_phase(P, lds, wave, lane); if (REP(0)) prologue_phase(P, lds, wave, lane); asm volatile("s_waitcnt vmcnt(0) lgkmcnt(0)" ::: "memory"); __syncthreads(); }

    run_layer<0>(P, lds, lds_raw, bar, lo, hi, wave, lane);
    run_layer<1>(P, lds, lds_raw, bar, lo, hi, wave, lane);
    run_layer<2>(P, lds, lds_raw, bar, lo, hi, wave, lane);
    run_layer<3>(P, lds, lds_raw, bar, lo, hi, wave, lane);
#undef SITE_PTRS
#undef RUN
#undef SEAM
}

#ifndef MK_PER_PHASE
#define MK_PER_PHASE 0
#endif
extern "C" void kernel_launch(void* const* d_in, const int* in_sizes, int n_in, void* d_out, int out_size, void* d_ws, size_t ws_size, hipStream_t stream) {
    static int grid = 0;
    if (grid == 0) {
        if (n_in != 20 || out_size != TREAL * DM || ws_size < WS_END) { fprintf(stderr, "kernel_launch: unexpected shapes: n_in %d out %d ws %zu (need %zu)\n", n_in, out_size, ws_size, (size_t)WS_END); grid = -1; return; }
        int dev = 0, cus = 0, per_cu = 0;
        if (hipGetDevice(&dev) != hipSuccess || hipDeviceGetAttribute(&cus, hipDeviceAttributeMultiprocessorCount, dev) != hipSuccess) { grid = -1; return; }
        if (hipFuncSetAttribute((const void*)encoder_fwd, hipFuncAttributeMaxDynamicSharedMemorySize, LDS_BYTES) != hipSuccess) { fprintf(stderr, "kernel_launch: hipFuncSetAttribute failed\n"); grid = -1; return; }
        if (hipOccupancyMaxActiveBlocksPerMultiprocessor(&per_cu, (const void*)encoder_fwd, 512, LDS_BYTES) != hipSuccess || per_cu < 1) { fprintf(stderr, "kernel_launch: occupancy query says %d blocks per CU\n", per_cu); (void)hipGetLastError(); grid = -1; return; }
        grid = cus;
    }
    if (grid < 0) return;
    (void)in_sizes;
    if (hipMemsetAsync((char*)d_ws + WS_CTL, 0, CTL_ZERO_BYTES, stream) != hipSuccess) { fprintf(stderr, "kernel_launch: memset failed\n"); return; }
    Params p; memset(&p, 0, sizeof(p));
    for (int i = 0; i < 20; ++i) p.in[i] = (const float*)d_in[i];
    p.out = (float*)d_out; p.ws = (unsigned char*)d_ws;
#if MK_PER_PHASE
    for (int ph = 0; ph < N_PHASES; ++ph) { p.ph_lo = ph; p.ph_hi = ph + 1; hipLaunchKernelGGL(encoder_fwd, dim3(grid), dim3(512), LDS_BYTES, stream, p); }
#else
    p.ph_lo = 0; p.ph_hi = N_PHASES;
    hipLaunchKernelGGL(encoder_fwd, dim3(grid), dim3(512), LDS_BYTES, stream, p);
#endif
    const hipError_t le = hipPeekAtLastError();
    if (le != hipSuccess) fprintf(stderr, "kernel_launch: launch failed: %s\n", hipGetErrorName(le));
}
```
